# Optimizing an MI355X kernel written in HIP

```python
import jax
import jax.numpy as jnp
from jax import lax
import numpy as np

D_MODEL = 1024
BATCH = 1
SEQ = 16384
DEPTH = 2

D_MIX = 1024
HG_HEADS = 4
HG_KDIM = 128
HG_VDIM = 128
HG_WIDTH = HG_HEADS * HG_VDIM
HG_CHUNK = 64
SW_HEADS = 4
SW_HDIM = 64
SW_WIDTH = SW_HEADS * SW_HDIM
SW_PATTERNS = ((128, 1), (512, 4), (2048, 16))
SW_BLOCK = 128
RK_HEADS = 4
RK_HDIM = 64
RK_WIDTH = RK_HEADS * RK_HDIM
RK_DECAY_LORA = 64
RK_AAA_LORA = 64
RK_MV_LORA = 32
RK_GATE_LORA = 128
RK_GN_EPS = 64e-5
HG_IN = 4 * HG_WIDTH
SW_IN = 3 * SW_WIDTH
RK_IN = 3 * RK_WIDTH + RK_DECAY_LORA + RK_AAA_LORA + RK_GATE_LORA
N_IN = HG_IN + SW_IN + RK_IN
D_FF = 2816
CONV_W = 3
PLE_DIM = 256
NORM_EPS = 1e-6

kernel_name = 'hymba_style_hgrn2_dilated_rwkv7_hybrid'


def rmsnorm(x, g):
    xf = x.astype(jnp.float32)
    y = xf * lax.rsqrt(jnp.mean(xf * xf, axis=-1, keepdims=True) + NORM_EPS)
    return (y * g.astype(jnp.float32)).astype(x.dtype)


def hgrn2_mix(q_raw, f_raw, i_raw, g_raw, lower_bound, gnorm_g):
    f32 = jnp.float32
    B_, S_, _ = q_raw.shape
    nc = S_ // HG_CHUNK
    q = jax.nn.silu(q_raw.astype(f32))
    f = lower_bound + (1.0 - lower_bound) * jax.nn.sigmoid(f_raw.astype(f32))
    k = 1.0 - f
    log_f = jnp.log(f)

    def chunks(t):
        return t.reshape(B_, nc, HG_CHUNK, HG_HEADS, -1).transpose(1, 0, 3, 2, 4)

    causal = jnp.tril(jnp.ones((HG_CHUNK, HG_CHUNK), dtype=bool))

    def step(state, inp):
        qc, kc, vc, lfc = inp
        b = jnp.cumsum(lfc, axis=2)
        b_last = b[:, :, -1:, :]
        o_inter = jnp.einsum('bhck,bhkv->bhcv', qc * jnp.exp(b), state)
        rel = jnp.where(causal[:, :, None], b[:, :, :, None, :] - b[:, :, None, :, :], -jnp.inf)
        scores = jnp.einsum('bhik,bhjk,bhijk->bhij', qc, kc, jnp.exp(rel))
        o_intra = jnp.einsum('bhij,bhjv->bhiv', scores, vc)
        state = (jnp.exp(b_last[:, :, 0, :])[..., None] * state
                 + jnp.einsum('bhck,bhcv->bhkv', kc * jnp.exp(b_last - b), vc))
        return state, o_inter + o_intra

    s0 = jnp.zeros((B_, HG_HEADS, HG_KDIM, HG_VDIM), f32)
    _, o = lax.scan(step, s0, (chunks(q), chunks(k), chunks(i_raw.astype(f32)), chunks(log_f)))
    o = o.transpose(1, 0, 3, 2, 4).reshape(B_, S_, HG_HEADS, HG_VDIM)
    o = o * lax.rsqrt(jnp.mean(o * o, axis=-1, keepdims=True) + NORM_EPS)
    o = o.reshape(B_, S_, HG_WIDTH) * gnorm_g.astype(f32) * jax.nn.silu(g_raw.astype(f32))
    return o.astype(q_raw.dtype)


def banded_causal_attention(q, k, v, n_back):
    f32 = jnp.float32
    N, L, H, Dh = q.shape
    blk = SW_BLOCK
    nb = -(-L // blk)
    padw = ((0, 0), (0, nb * blk - L), (0, 0), (0, 0))
    qb = jnp.pad(q.astype(f32), padw).reshape(N, nb, blk, H, Dh)
    kb = jnp.pad(k.astype(f32), padw).reshape(N, nb, blk, H, Dh)
    vb = jnp.pad(v.astype(f32), padw).reshape(N, nb, blk, H, Dh)

    def with_prev(t):
        prev = jnp.pad(t, ((0, 0), (1, 0), (0, 0), (0, 0), (0, 0)))[:, :-1]
        return jnp.concatenate([prev, t], axis=2)

    kw, vw = with_prev(kb), with_prev(vb)
    s = jnp.einsum('nbqhd,nbkhd->nbhqk', qb, kw) * (Dh ** -0.5)
    qi = jnp.arange(blk)[:, None]
    kj = jnp.arange(2 * blk)[None, :]
    dist = qi - kj + blk
    kpos = jnp.arange(nb)[:, None, None] * blk + kj[None] - blk
    valid = (dist >= 0)[None] & (dist <= n_back)[None] & (kpos >= 0)
    s = jnp.where(valid[None, :, None], s, -jnp.inf)
    lse = jax.nn.logsumexp(s, axis=-1)
    prob = jnp.exp(s - lse[..., None])
    o = jnp.einsum('nbhqk,nbkhd->nbqhd', prob, vw).reshape(N, nb * blk, H, Dh)[:, :L]
    lse = lse.transpose(0, 1, 3, 2).reshape(N, nb * blk, H)[:, :L]
    return o, lse


def stride_gather(t, dil):
    B_, S_ = t.shape[:2]
    rest = t.shape[2:]
    return t.reshape((B_, S_ // dil, dil) + rest).swapaxes(1, 2).reshape((B_ * dil, S_ // dil) + rest)


def stride_scatter(t, B_, dil):
    L = t.shape[1]
    rest = t.shape[2:]
    return t.reshape((B_, dil, L) + rest).swapaxes(1, 2).reshape((B_, L * dil) + rest)


def dilated_window_mix(q_raw, k_raw, v_raw):
    B_, S_, _ = q_raw.shape
    q, k, v = (t.reshape(B_, S_, SW_HEADS, SW_HDIM) for t in (q_raw, k_raw, v_raw))
    outs, lses = [], []
    for window, dil in SW_PATTERNS:
        o, lse = banded_causal_attention(stride_gather(q, dil), stride_gather(k, dil),
                                         stride_gather(v, dil), window // dil)
        outs.append(stride_scatter(o, B_, dil))
        lses.append(stride_scatter(lse, B_, dil))
    wts = jax.nn.softmax(jnp.stack(lses, 0), axis=0)
    o = jnp.sum(wts[..., None] * jnp.stack(outs, 0), axis=0)
    return o.reshape(B_, S_, SW_WIDTH).astype(q_raw.dtype)


def rwkv7_mix(c, mu, w0, w2, a0, a2, g2, k_k, k_a, r_k, ln_w, ln_b, v_first, v_res):
    f32 = jnp.float32
    B_, S_, _ = c.shape
    cf = c.astype(f32)
    c_prev = jnp.pad(cf, ((0, 0), (1, 0), (0, 0)))[:, :-1]
    cm = cf + (c_prev - cf) * mu
    splits = [RK_WIDTH, 2 * RK_WIDTH, 3 * RK_WIDTH, 3 * RK_WIDTH + RK_DECAY_LORA,
              3 * RK_WIDTH + RK_DECAY_LORA + RK_AAA_LORA]
    r, k, v, wd, ad, gd = jnp.split(cm, splits, axis=-1)
    w = -jax.nn.softplus(-(w0 + jnp.tanh(wd) @ w2)) - 0.5
    decay = jnp.exp(-jnp.exp(w))
    a = jax.nn.sigmoid(a0 + ad @ a2)
    g = jax.nn.sigmoid(gd) @ g2
    if v_res is None:
        v_first = v
    else:
        v0, v1, v2 = v_res
        v = v + (v_first - v) * jax.nn.sigmoid(v0 + (v @ v1) @ v2)

    def heads(t):
        return t.reshape(B_, S_, RK_HEADS, RK_HDIM)

    kk = heads(k * k_k)
    kk = kk / jnp.maximum(jnp.linalg.norm(kk, axis=-1, keepdims=True), 1e-12)
    k = k * (1.0 + (a - 1.0) * k_a)
    rh, kh, vh, wh, ah = heads(r), heads(k), heads(v), heads(decay), heads(a)

    def step(state, inp):
        r_t, w_t, k_t, v_t, kk_t, a_t = inp
        sa = jnp.einsum('bhvk,bhk->bhv', state, -kk_t)
        state = (state * w_t[:, :, None, :] + sa[..., None] * (kk_t * a_t)[:, :, None, :]
                 + v_t[..., None] * k_t[:, :, None, :])
        return state, jnp.einsum('bhvk,bhk->bhv', state, r_t)

    s0 = jnp.zeros((B_, RK_HEADS, RK_HDIM, RK_HDIM), f32)
    xs = (rh.swapaxes(0, 1), wh.swapaxes(0, 1), kh.swapaxes(0, 1), vh.swapaxes(0, 1),
          kk.swapaxes(0, 1), ah.swapaxes(0, 1))
    _, y = lax.scan(step, s0, xs)
    y = y.swapaxes(0, 1)
    mean = jnp.mean(y, axis=-1, keepdims=True)
    var = jnp.mean((y - mean) ** 2, axis=-1, keepdims=True)
    y = ((y - mean) * lax.rsqrt(var + RK_GN_EPS)).reshape(B_, S_, RK_WIDTH) * ln_w + ln_b
    bonus = jnp.sum(rh * kh * r_k, axis=-1, keepdims=True) * vh
    y = (y + bonus.reshape(B_, S_, RK_WIDTH)) * g
    return y.astype(c.dtype), v_first


def conv_glu_ffn(hn, w_up, conv_w, conv_b, w_down):
    u = hn @ w_up
    S_ = u.shape[1]
    up = jnp.pad(u, ((0, 0), (CONV_W - 1, 0), (0, 0)))
    uc = conv_b + conv_w[0] * up[:, 0:S_]
    for j in range(1, CONV_W):
        uc = uc + conv_w[j] * up[:, j:j + S_]
    gate, val = jnp.split(uc, 2, axis=-1)
    return (jax.nn.silu(gate) * val) @ w_down


def setup_inputs(seed: int = 0) -> dict:
    key = jax.random.key(seed)
    ks = iter(jax.random.split(key, 40))

    def nrm(shape, scale):
        return jax.random.normal(next(ks), shape, jnp.float32) * scale

    def unif(shape, lo, hi):
        return jax.random.uniform(next(ks), shape, jnp.float32, lo, hi)

    L = DEPTH
    return {
        'x': nrm((BATCH, SEQ, D_MODEL), 1.0),
        'p': nrm((DEPTH, BATCH, SEQ, PLE_DIM), 1.0),
        'w_in': nrm((L, D_MODEL, N_IN), D_MODEL ** -0.5),
        'w_out': nrm((L, D_MIX, D_MODEL), D_MIX ** -0.5),
        'norm_mix_g': 1.0 + nrm((L, D_MODEL), 0.02),
        'norm_ffn_g': 1.0 + nrm((L, D_MODEL), 0.02),
        'norm_ple_g': 1.0 + nrm((L, D_MODEL), 0.02),
        'final_norm_g': 1.0 + nrm((D_MODEL,), 0.02),
        'hgrn_lower_bounds': nrm((L, HG_HEADS * HG_KDIM), 0.5),
        'hgrn_gnorm_g': 1.0 + nrm((L, HG_WIDTH), 0.02),
        'rwkv_mu': unif((L, RK_IN), 0.0, 1.0),
        'rwkv_w0': unif((L, RK_WIDTH), -5.0, -0.5),
        'rwkv_w2': nrm((L, RK_DECAY_LORA, RK_WIDTH), 0.1 * RK_DECAY_LORA ** -0.5),
        'rwkv_a0': nrm((L, RK_WIDTH), 0.1),
        'rwkv_a2': nrm((L, RK_AAA_LORA, RK_WIDTH), 0.1 * RK_AAA_LORA ** -0.5),
        'rwkv_g2': nrm((L, RK_GATE_LORA, RK_WIDTH), RK_GATE_LORA ** -0.5),
        'rwkv_k_k': 0.85 + nrm((L, RK_WIDTH), 0.05),
        'rwkv_k_a': 1.0 + nrm((L, RK_WIDTH), 0.05),
        'rwkv_r_k': nrm((L, RK_HEADS, RK_HDIM), 0.1),
        'rwkv_ln_w': 1.0 + nrm((L, RK_WIDTH), 0.02),
        'rwkv_ln_b': nrm((L, RK_WIDTH), 0.02),
        'rwkv_v0': 1.0 + nrm((L - 1, RK_WIDTH), 0.1),
        'rwkv_v1': nrm((L - 1, RK_WIDTH, RK_MV_LORA), 0.1 * RK_WIDTH ** -0.5),
        'rwkv_v2': nrm((L - 1, RK_MV_LORA, RK_WIDTH), 0.1 * RK_MV_LORA ** -0.5),
        'ffn_up': nrm((L, D_MODEL, 2 * D_FF), D_MODEL ** -0.5),
        'ffn_conv_w': nrm((L, CONV_W, 2 * D_FF), CONV_W ** -0.5),
        'ffn_conv_b': nrm((L, 2 * D_FF), 0.02),
        'ffn_down': nrm((L, D_FF, D_MODEL), D_FF ** -0.5),
        'ple_proj': nrm((L, PLE_DIM, D_MODEL), PLE_DIM ** -0.5),
        'ple_gate': nrm((L, D_MODEL, D_MODEL), D_MODEL ** -0.5),
    }


def reference(x, p, w_in, w_out, norm_mix_g, norm_ffn_g, norm_ple_g, final_norm_g,
              hgrn_lower_bounds, hgrn_gnorm_g, rwkv_mu, rwkv_w0, rwkv_w2, rwkv_a0, rwkv_a2,
              rwkv_g2, rwkv_k_k, rwkv_k_a, rwkv_r_k, rwkv_ln_w, rwkv_ln_b, rwkv_v0, rwkv_v1,
              rwkv_v2, ffn_up, ffn_conv_w, ffn_conv_b, ffn_down, ple_proj, ple_gate):
    lbs = jax.nn.softmax(hgrn_lower_bounds.astype(jnp.float32), axis=0)
    lbs = jnp.cumsum(lbs, axis=0) - lbs[0]
    splits = [HG_WIDTH, 2 * HG_WIDTH, 3 * HG_WIDTH, 4 * HG_WIDTH,
              HG_IN + SW_WIDTH, HG_IN + 2 * SW_WIDTH, HG_IN + 3 * SW_WIDTH]
    h = x
    v_first = None
    for l in range(DEPTH):
        z = rmsnorm(h, norm_mix_g[l]) @ w_in[l]
        a_q, a_f, a_i, a_g, b_q, b_k, b_v, c_in = jnp.split(z, splits, axis=-1)
        o_a = hgrn2_mix(a_q, a_f, a_i, a_g, lbs[l], hgrn_gnorm_g[l])
        o_b = dilated_window_mix(b_q, b_k, b_v)
        v_res = None if l == 0 else (rwkv_v0[l - 1], rwkv_v1[l - 1], rwkv_v2[l - 1])
        o_c, v_first = rwkv7_mix(c_in, rwkv_mu[l], rwkv_w0[l], rwkv_w2[l], rwkv_a0[l], rwkv_a2[l],
                                 rwkv_g2[l], rwkv_k_k[l], rwkv_k_a[l], rwkv_r_k[l], rwkv_ln_w[l],
                                 rwkv_ln_b[l], v_first, v_res)
        h = h + jnp.concatenate([o_a, o_b.astype(o_a.dtype), o_c.astype(o_a.dtype)], axis=-1) @ w_out[l]
        h = h + conv_glu_ffn(rmsnorm(h, norm_ffn_g[l]), ffn_up[l], ffn_conv_w[l], ffn_conv_b[l], ffn_down[l])
        gate = jax.nn.sigmoid(rmsnorm(h, norm_ple_g[l]) @ ple_gate[l])
        h = h + gate * (p[l] @ ple_proj[l])
    return rmsnorm(h, final_norm_g)
```

```cpp
#include <hip/hip_runtime.h>
#include <hip/hip_cooperative_groups.h>
#include <cstdio>
#include <cstdint>
namespace cg = cooperative_groups;
namespace pg8 {
#define PG8_LAS __attribute__((address_space(3)))
typedef unsigned short bf16_t;
typedef short bf16x8 __attribute__((ext_vector_type(8)));
typedef float f32x4 __attribute__((ext_vector_type(4)));
typedef unsigned u32x4 __attribute__((ext_vector_type(4)));
constexpr int BM = 256, BK = 64, HALF = 128, HTB = HALF * BK * 2  , STAGE_BYTES = 8 * HTB, NXCD = 8, WGM = 8;

__host__ __device__ __forceinline__ int lds_byte(int r, int c) { const int st = (r >> 4) * 2 + (c >> 5), rr = r & 15, cc = c & 31, ob = rr * 64 + cc * 2; return st * 1024 + (ob ^ (((ob >> 9) & 1) << 5)); }
__host__ __device__ __forceinline__ void stage_rc(int b, int& R, int& C) { const int st = b / 1024, sb = b % 1024, swz = sb ^ (((sb >> 9) & 1) << 5); R = (st >> 1) * 16 + swz / 64; C = (st & 1) * 32 + (swz % 64) / 2; }
__host__ __device__ __forceinline__ int perm32(int rho) { const int n = rho >> 4, i = rho & 15; return 8 * (i >> 2) + 4 * n + (i & 3); }

struct Unit { int pm, pn; };
struct Gemm { const bf16_t* A; const bf16_t* Bt; int M, N, K; };

struct StaticOrder {
    int nM, nN, nwg, G, c;
    __host__ __device__ void init(int M, int N, int G_, int c_) { nM = M / BM; nN = N / BM; nwg = nM * nN; G = G_; c = c_; }
    __host__ __device__ bool next(int i, Unit& u) const {
        const long L = (long)i * G + c; if (L >= nwg) return false;
        int wgid = (int)L; { const int q = nwg / NXCD, r = nwg % NXCD, xcd = wgid % NXCD, off = wgid / NXCD; wgid = (xcd < r ? xcd * (q + 1) : r * (q + 1) + (xcd - r) * q) + off; }
        const int nig = WGM * nN, gid = wgid / nig, fm = gid * WGM, gsz = (nM - fm) < WGM ? (nM - fm) : WGM;
        u.pm = fm + ((wgid % nig) % gsz); u.pn = (wgid % nig) / gsz; return true;
    }
    __device__ __forceinline__ void a_ready(const Unit&) const {}
    __device__ __forceinline__ void done(const Unit&) const {}
};
__device__ __forceinline__ unsigned cvt_pk_bf16(float lo, float hi) { unsigned r; asm volatile("v_cvt_pk_bf16_f32 %0, %1, %2" : "=v"(r) : "v"(lo), "v"(hi)); return r; }
typedef float f32x2 __attribute__((ext_vector_type(2)));
template <class Epi, class Sched, bool STAMP = false>
__device__ __forceinline__ void gemm_phase(PG8_LAS unsigned char* lds, const Gemm g, const Sched& S, const Epi& E, unsigned long long* stamps) {
    int tid_l = threadIdx.x; asm volatile("" : "+v"(tid_l)); const int tid = tid_l, wid = __builtin_amdgcn_readfirstlane(tid >> 6), lane = tid & 63, wr = wid >> 2, wc = wid & 3, fr = lane & 15, fq = lane >> 4;
    const int K = g.K, nt = K / BK;
    int ts_lo = 0, ts_hi = 0, nts = 0; const unsigned long long rt_entry = STAMP ? (unsigned long long)wall_clock64() : 0ull;
#define PG8_STAMP() do { if (STAMP && wid == 0 && nts < 64) { const unsigned long long _c = (unsigned long long)clock64(); \
        ts_lo = (lane == nts) ? (int)(unsigned)_c : ts_lo; ts_hi = (lane == nts) ? (int)(unsigned)(_c >> 32) : ts_hi; ++nts; } } while (0)
    PG8_STAMP();
    unsigned voffA[2], voffB[2];
#pragma unroll
    for (int i = 0; i < 2; ++i) { int R, C; stage_rc(tid * 16 + i * 8192, R, C); const int Rb = Epi::PERM ? ((R & ~31) + perm32(R & 31)) : R;
        voffA[i] = (unsigned)(R * K + C) * 2u; voffB[i] = (unsigned)(Rb * K + C) * 2u; }
    const size_t kstep = (size_t)(BK * 2);
    const size_t hstep = (size_t)HALF * K * 2;
    const size_t tstep = 2 * hstep;
    const unsigned ldsw = (unsigned)wid * 1024u;
    const int aoff = lds_byte(wr * 64 + fr, fq * 8), boff = lds_byte(wc * 32 + fr, fq * 8);
#define PG8_SA(b, h) (((b) * 2 + (h)) * HTB)
#define PG8_SB(b, h) ((4 + (b) * 2 + (h)) * HTB)
#define PG8_STAGE(bufoff, gbase, voff) do { _Pragma("unroll") for (int _i = 0; _i < 2; ++_i) \
        __builtin_amdgcn_global_load_lds((const unsigned*)((const char*)(gbase) + (voff)[_i]), (PG8_LAS unsigned*)(lds + (bufoff) + ldsw + _i * 8192), 16, 0, 0); } while (0)
#define PG8_LDA(dst, b, h) do { _Pragma("unroll") for (int m = 0; m < 4; ++m) _Pragma("unroll") for (int k = 0; k < 2; ++k) dst[m][k] = *(const PG8_LAS bf16x8*)(lds + PG8_SA(b, h) + aoff + m * 2048 + k * 1024); } while (0)
#define PG8_LDB(dst, b, h) do { _Pragma("unroll") for (int n = 0; n < 2; ++n) _Pragma("unroll") for (int k = 0; k < 2; ++k) dst[n][k] = *(const PG8_LAS bf16x8*)(lds + PG8_SB(b, h) + boff + n * 2048 + k * 1024); } while (0)
#define PG8_MMA(ai, bj, At, Bt) do { __builtin_amdgcn_s_setprio(1); _Pragma("unroll") for (int m = 0; m < 4; ++m) _Pragma("unroll") for (int n = 0; n < 2; ++n) _Pragma("unroll") for (int k = 0; k < 2; ++k) \
        acc[ai][bj][m][n] = __builtin_amdgcn_mfma_f32_16x16x32_bf16(Bt[n][k], At[m][k], acc[ai][bj][m][n], 0, 0, 0); __builtin_amdgcn_s_setprio(0); } while (0)
#define PG8_WAIT_V(n) asm volatile("s_waitcnt vmcnt(" #n ")" ::: "memory")
#define PG8_WAIT_L(n) asm volatile("s_waitcnt lgkmcnt(" #n ")" ::: "memory")
#define PG8_BAR __builtin_amdgcn_s_barrier()
#define PG8_SCHED __builtin_amdgcn_sched_barrier(0)
    Unit cur, nxt; int ui = 0;
    if (!S.next(0, cur)) return;
    f32x4 acc[2][2][4][2];
#pragma unroll
    for (int a = 0; a < 2; ++a)
#pragma unroll
        for (int b = 0; b < 2; ++b)
#pragma unroll
            for (int m = 0; m < 4; ++m)
#pragma unroll
                for (int n = 0; n < 2; ++n) acc[a][b][m][n] = (f32x4){0.f, 0.f, 0.f, 0.f};
    bf16x8 At[4][2], B0[2][2], B1[2][2];
    const char* cA = (const char*)g.A + (size_t)cur.pm * tstep; const char* cB = (const char*)g.Bt + (size_t)cur.pn * tstep;
    S.a_ready(cur);
    PG8_STAGE(PG8_SB(0, 0), cB, voffB); PG8_STAGE(PG8_SA(0, 0), cA, voffA); PG8_STAGE(PG8_SB(0, 1), cB + hstep, voffB); PG8_STAGE(PG8_SA(0, 1), cA + hstep, voffA);
    if (wr == 1) PG8_BAR;
    PG8_WAIT_V(4); PG8_BAR;
    PG8_STAGE(PG8_SB(1, 0), cB + kstep, voffB); PG8_STAGE(PG8_SA(1, 0), cA + kstep, voffA); PG8_STAGE(PG8_SB(1, 1), cB + hstep + kstep, voffB);
    PG8_WAIT_V(6); PG8_BAR;
    PG8_STAMP();
    for (;;) {
        const bool has_next = S.next(ui + 1, nxt);
        const char* nA = has_next ? (const char*)g.A + (size_t)nxt.pm * tstep : cA; const char* nB = has_next ? (const char*)g.Bt + (size_t)nxt.pn * tstep : cB;
        for (int t = 0; t < nt; t += 2) {
            const bool last = (t == nt - 2);
            const char* a1 = cA + (size_t)(t + 1) * kstep;
            const char* a2 = last ? nA : cA + (size_t)(t + 2) * kstep; const char* b2 = last ? nB : cB + (size_t)(t + 2) * kstep;
            const char* a3 = a2 + kstep; const char* b3 = b2 + kstep;
            if (last && has_next) S.a_ready(nxt);
            PG8_LDB(B0, 0, 0); PG8_SCHED; PG8_LDA(At, 0, 0); PG8_STAGE(PG8_SA(1, 1), a1 + hstep, voffA);
            PG8_WAIT_L(8); PG8_BAR; PG8_WAIT_L(0); PG8_MMA(0, 0, At, B0); PG8_BAR; PG8_SCHED;
            PG8_LDB(B1, 0, 1); PG8_STAGE(PG8_SB(0, 0), b2, voffB);
            PG8_BAR; PG8_WAIT_L(0); PG8_MMA(0, 1, At, B1); PG8_BAR;
            PG8_LDA(At, 0, 1); PG8_STAGE(PG8_SA(0, 0), a2, voffA);
            PG8_BAR; PG8_WAIT_L(0); PG8_MMA(1, 0, At, B0); PG8_BAR; PG8_SCHED;
            PG8_STAGE(PG8_SB(0, 1), b2 + hstep, voffB);
            PG8_WAIT_V(6); PG8_BAR; PG8_MMA(1, 1, At, B1); PG8_BAR;
            PG8_LDB(B0, 1, 0); PG8_SCHED; PG8_LDA(At, 1, 0); PG8_STAGE(PG8_SA(0, 1), a2 + hstep, voffA);
            PG8_WAIT_L(8); PG8_BAR; PG8_WAIT_L(0); PG8_MMA(0, 0, At, B0); PG8_BAR; PG8_SCHED;
            PG8_LDB(B1, 1, 1); PG8_STAGE(PG8_SB(1, 0), b3, voffB);
            PG8_BAR; PG8_WAIT_L(0); PG8_MMA(0, 1, At, B1); PG8_BAR;
            PG8_LDA(At, 1, 1); PG8_STAGE(PG8_SA(1, 0), a3, voffA);
            PG8_BAR; PG8_WAIT_L(0); PG8_MMA(1, 0, At, B0); PG8_BAR; PG8_SCHED;
            PG8_STAGE(PG8_SB(1, 1), b3 + hstep, voffB);
            PG8_WAIT_V(6); PG8_BAR; PG8_MMA(1, 1, At, B1); PG8_BAR;
        }
        PG8_STAMP();
        if constexpr (!Epi::AFTER_DRAIN) { E(acc, cur, wr, wc, fr, fq); S.done(cur); }
        PG8_STAMP();
        if (!has_next) break;
#pragma unroll
        for (int a = 0; a < 2; ++a)
#pragma unroll
            for (int b = 0; b < 2; ++b)
#pragma unroll
                for (int m = 0; m < 4; ++m)
#pragma unroll
                    for (int n = 0; n < 2; ++n) acc[a][b][m][n] = (f32x4){0.f, 0.f, 0.f, 0.f};
        cur = nxt; cA = nA; cB = nB; ++ui;
    }
    PG8_WAIT_V(0);
    if (wr == 0) PG8_BAR;
    PG8_BAR;
    if constexpr (Epi::AFTER_DRAIN) { E.fused(acc, cur, wr, wc, fr, fq, lds, wid, lane); S.done(cur); }
    PG8_STAMP();
    if (STAMP && wid == 0) { stamps[lane] = lane < nts ? (((unsigned long long)(unsigned)ts_hi << 32) | (unsigned)ts_lo) : 0ull;
        if (lane == 62) stamps[62] = rt_entry; if (lane == 63) stamps[63] = (unsigned long long)wall_clock64(); }
#undef PG8_STAMP
#undef PG8_SA
#undef PG8_SB
#undef PG8_STAGE
#undef PG8_LDA
#undef PG8_LDB
#undef PG8_MMA
#undef PG8_WAIT_V
#undef PG8_WAIT_L
#undef PG8_BAR
#undef PG8_SCHED
}
}

using pg8::bf16_t; using pg8::f32x4; using pg8::u32x4; using pg8::Unit;
typedef _Float16 h16;
typedef _Float16 h16x8 __attribute__((ext_vector_type(8)));
typedef _Float16 h16x2 __attribute__((ext_vector_type(2)));
typedef float f32x2v __attribute__((ext_vector_type(2)));

constexpr int S_ = 16384, D_ = 1024;
constexpr int NTHREADS = 512;
constexpr int LDS_BYTES = 155648;
constexpr size_t MiB = (size_t)1 << 20;
constexpr size_t OFF_HALO = 0, OFF_WT = 1 * MiB, OFF_VF = 30 * MiB, OFF_HN = 46 * MiB, OFF_BIG = 78 * MiB;
constexpr size_t OFF_ZH = OFF_BIG, OFF_ZB = OFF_BIG + 64 * MiB, OFF_ZC = OFF_BIG + 88 * MiB, OFF_RK = OFF_BIG + 120 * MiB,
                 OFF_LSE = OFF_BIG + 176 * MiB, OFF_GB = OFF_BIG + 177 * MiB;
constexpr size_t OFF_U = OFF_BIG, OFF_ACT = OFF_BIG + 88 * MiB;
constexpr size_t OFF_PB = OFF_BIG, OFF_PP = OFF_BIG + 8 * MiB;
constexpr size_t WT_IN = 0, WT_OUT = 3932160, WT_UP = 4980736, WT_DOWN = 10747904, WT_GATE = 13631488, WT_PROJ = 14680064;
constexpr size_t RKSZ = (size_t)S_ * 256;

enum { I_X = 0, I_P, I_WIN, I_WOUT, I_NMIX, I_NFFN, I_NPLE, I_NFIN, I_LB, I_GN, I_MU, I_W0, I_W2, I_A0, I_A2, I_G2, I_KK, I_KA, I_RK,
       I_LNW, I_LNB, I_V0, I_V1, I_V2, I_UP, I_CW, I_CB, I_DOWN, I_PROJ, I_GATE, N_IN };

struct Params { const float* in[30]; float* out; unsigned char* ws; };

constexpr int NPH_LAYER = 16, NPH = 33;
#ifndef PHMASK
#define PHMASK 0x1FFFF
#endif
#define PH(x) ((PHMASK >> (x)) & 1)

__device__ __forceinline__ float bf2f(unsigned short b) { return __uint_as_float(((unsigned)b) << 16); }
__device__ __forceinline__ float bflo(unsigned u) { return __uint_as_float(u << 16); }
__device__ __forceinline__ float bfhi(unsigned u) { return __uint_as_float(u & 0xffff0000u); }
__device__ __forceinline__ unsigned pk2(float lo, float hi) { return pg8::cvt_pk_bf16(lo, hi); }
__device__ __forceinline__ unsigned short f2bf(float f) { return (unsigned short)(pk2(f, 0.f) & 0xffffu); }
__device__ __forceinline__ float wave_sum(float v) {
#pragma unroll
    for (int o = 1; o < 64; o <<= 1) v += __shfl_xor(v, o);
    return v;
}
__device__ __forceinline__ float sigm(float x) { return 1.f / (1.f + __expf(-x)); }
__device__ __forceinline__ int launder(int x) { asm volatile("" : "+v"(x)); return x; }
__device__ __forceinline__ void lds_wait() { asm volatile("s_waitcnt lgkmcnt(0)" ::: "memory"); }

__device__ __forceinline__ void transpose_item(const float* __restrict__ W, int K, int N, bf16_t* __restrict__ WT, float* scr, int item, int lane) {
    const int nblk = N / 32, kb = item / nblk, nb = item % nblk, k0 = 64 * kb, n0 = 32 * nb;
#pragma unroll 8
    for (int i = 0; i < 32; ++i) { const int kk = 2 * i + (lane >> 5); scr[kk * 33 + (lane & 31)] = W[(size_t)(k0 + kk) * N + n0 + (lane & 31)]; }
    lds_wait();
    const int c = lane & 7;
#pragma unroll
    for (int j = 0; j < 4; ++j) {
        const int n = (lane >> 3) + 8 * j; const float* s = scr + (8 * c) * 33 + n;
        u32x4 o; o.x = pk2(s[0 * 33], s[1 * 33]); o.y = pk2(s[2 * 33], s[3 * 33]); o.z = pk2(s[4 * 33], s[5 * 33]); o.w = pk2(s[6 * 33], s[7 * 33]);
        *(u32x4*)(WT + (size_t)(n0 + n) * K + k0 + 8 * c) = o;
    }
    lds_wait();
}

__device__ __forceinline__ void rmsnorm_rows_bf16(const float* __restrict__ h, const float* __restrict__ g, bf16_t* __restrict__ out, int gw, int ngw, int lane) {
    for (int row = gw; row < S_; row += ngw) {
        const f32x4* xr = (const f32x4*)(h + (size_t)row * D_) + lane;
        f32x4 v[4]; float s = 0.f;
#pragma unroll
        for (int j = 0; j < 4; ++j) { v[j] = xr[64 * j]; s += (v[j].x * v[j].x + v[j].y * v[j].y) + (v[j].z * v[j].z + v[j].w * v[j].w); }
        s = wave_sum(s);
        const float r = rsqrtf(s * (1.f / 1024.f) + 1e-6f);
        unsigned long long* o8 = (unsigned long long*)(out + (size_t)row * D_) + lane;
#pragma unroll
        for (int j = 0; j < 4; ++j) {
            const f32x4 gg = ((const f32x4*)g)[lane + 64 * j];
            o8[64 * j] = (unsigned long long)pk2(v[j].x * r * gg.x, v[j].y * r * gg.y) | ((unsigned long long)pk2(v[j].z * r * gg.z, v[j].w * r * gg.w) << 32);
        }
    }
}

__device__ __forceinline__ void phase_prep(const Params& P, int layer, unsigned char* smem, int tid) {
    const int wave = tid >> 6, lane = tid & 63;
    const int gw = blockIdx.x * 8 + wave, ngw = gridDim.x * 8;
    float* scr = (float*)smem + wave * (64 * 33);
    bf16_t* WT = (bf16_t*)(P.ws + OFF_WT);
    constexpr int I0 = 16 * 120, I1 = 16 * 32, I2 = 16 * 176, I3 = 44 * 32, I4 = 16 * 32, I5 = 4 * 32;
    constexpr int NIT = I0 + I1 + I2 + I3 + I4 + I5;
    for (int it = gw; it < NIT; it += ngw) {
        int r = it;
        if (r < I0) { transpose_item(P.in[I_WIN] + (size_t)layer * 1024 * 3840, 1024, 3840, WT + WT_IN, scr, r, lane); continue; } r -= I0;
        if (r < I1) { transpose_item(P.in[I_WOUT] + (size_t)layer * 1024 * 1024, 1024, 1024, WT + WT_OUT, scr, r, lane); continue; } r -= I1;
        if (r < I2) { transpose_item(P.in[I_UP] + (size_t)layer * 1024 * 5632, 1024, 5632, WT + WT_UP, scr, r, lane); continue; } r -= I2;
        if (r < I3) { transpose_item(P.in[I_DOWN] + (size_t)layer * 2816 * 1024, 2816, 1024, WT + WT_DOWN, scr, r, lane); continue; } r -= I3;
        if (r < I4) { transpose_item(P.in[I_GATE] + (size_t)layer * 1024 * 1024, 1024, 1024, WT + WT_GATE, scr, r, lane); continue; } r -= I4;
        transpose_item(P.in[I_PROJ] + (size_t)layer * 256 * 1024, 256, 1024, WT + WT_PROJ, scr, r, lane);
    }
    const float* h = (layer == 0) ? P.in[I_X] : P.out;
    rmsnorm_rows_bf16(h, P.in[I_NMIX] + layer * 1024, (bf16_t*)(P.ws + OFF_HN), gw, ngw, lane);
}

struct EpiRoute {
    static constexpr bool PERM = true, AFTER_DRAIN = false;
    bf16_t* d0; bf16_t* d1; bf16_t* d2; int ld0, ld1, ld2, c1, c2;
    __device__ __forceinline__ void operator()(const f32x4 (&acc)[2][2][4][2], const Unit& u, int wr, int wc, int fr, int fq) const {
        int colt = u.pn * 256; bf16_t* base; int ld;
        if (colt < c1) { base = d0; ld = ld0; } else if (colt < c2) { base = d1; ld = ld1; colt -= c1; } else { base = d2; ld = ld2; colt -= c2; }
        const int row0 = u.pm * 256 + wr * 64 + fr, col0 = colt + wc * 32 + 8 * fq;
#pragma unroll
        for (int ai = 0; ai < 2; ++ai)
#pragma unroll
            for (int m = 0; m < 4; ++m) {
                bf16_t* rowp = base + (size_t)(row0 + ai * 128 + m * 16) * ld + col0;
#pragma unroll
                for (int bj = 0; bj < 2; ++bj) {
                    const f32x4 v0 = acc[ai][bj][m][0], v1 = acc[ai][bj][m][1];
                    u32x4 w; w.x = pk2(v0[0], v0[1]); w.y = pk2(v0[2], v0[3]); w.z = pk2(v1[0], v1[1]); w.w = pk2(v1[2], v1[3]);
                    *(u32x4*)(rowp + bj * 128) = w;
                }
            }
    }
};
template <int MODE  > struct EpiF32 {
    static constexpr bool PERM = false, AFTER_DRAIN = false;
    const float* hin; float* out;
    __device__ __forceinline__ void operator()(const f32x4 (&acc)[2][2][4][2], const Unit& u, int wr, int wc, int fr, int fq) const {
        const int row0 = u.pm * 256 + wr * 64 + fr, col0 = u.pn * 256 + wc * 32 + 4 * fq;
#pragma unroll
        for (int ai = 0; ai < 2; ++ai)
#pragma unroll
            for (int m = 0; m < 4; ++m) {
                const size_t ro = (size_t)(row0 + ai * 128 + m * 16) * 1024 + col0;
#pragma unroll
                for (int bj = 0; bj < 2; ++bj)
#pragma unroll
                    for (int n = 0; n < 2; ++n) {
                        const size_t off = ro + bj * 128 + n * 16;
                        const f32x4 a = acc[ai][bj][m][n];
                        if (MODE == 0) { *(f32x4*)(out + off) = *(const f32x4*)(hin + off) + a; }
                        else if (MODE == 1) { *(f32x4*)(out + off) = a; }
                        else { const f32x4 pp = *(const f32x4*)(hin + off); f32x4 hv = *(f32x4*)(out + off);
                               hv.x += sigm(a.x) * pp.x; hv.y += sigm(a.y) * pp.y; hv.z += sigm(a.z) * pp.z; hv.w += sigm(a.w) * pp.w; *(f32x4*)(out + off) = hv; }
                    }
            }
    }
};

template <class Epi> __device__ __forceinline__ void run_gemm(unsigned char* smem, const bf16_t* A, const bf16_t* Bt, int M, int N, int K, const Epi& E) {
    pg8::Gemm g; g.A = A; g.Bt = Bt; g.M = M; g.N = N; g.K = K;
    pg8::StaticOrder So; So.init(M, N, (int)gridDim.x, (int)blockIdx.x);
    pg8::gemm_phase<Epi, pg8::StaticOrder, false>((PG8_LAS unsigned char*)smem, g, So, E, nullptr);
}

__device__ __forceinline__ void rwkv_prep(const Params& P, int layer, unsigned char* smem, int tid) {
    float* cmL = (float*)smem; float* uL = cmL + 16 * 1024;
    const bf16_t* ZC = (const bf16_t*)(P.ws + OFF_ZC);
    float* VF = (float*)(P.ws + OFF_VF);
    h16* RK = (h16*)(P.ws + OFF_RK);
    const float* mu = P.in[I_MU] + layer * 1024;
    const float* w2 = P.in[I_W2] + layer * 64 * 256; const float* a2 = P.in[I_A2] + layer * 64 * 256; const float* g2 = P.in[I_G2] + layer * 128 * 256;
    const int j = tid & 255, th = tid >> 8, tb = th * 8;
    const float w0j = P.in[I_W0][layer * 256 + j], a0j = P.in[I_A0][layer * 256 + j], kkj = P.in[I_KK][layer * 256 + j], kaj = P.in[I_KA][layer * 256 + j];
    const float v0j = (layer > 0) ? P.in[I_V0][j] : 0.f;
    for (int tile = blockIdx.x; tile < S_ / 16; tile += gridDim.x) {
        const int t0 = tile * 16;
        __syncthreads();
        {
            const int c2 = tid * 2;
            const float mu0 = mu[c2], mu1 = mu[c2 + 1];
            const unsigned pu = (t0 > 0) ? *(const unsigned*)(ZC + (size_t)(t0 - 1) * 1024 + c2) : 0u;
            float p0 = bflo(pu), p1 = bfhi(pu);
#pragma unroll 4
            for (int i = 0; i < 16; ++i) {
                const unsigned cu = *(const unsigned*)(ZC + (size_t)(t0 + i) * 1024 + c2);
                const float c0 = bflo(cu), c1 = bfhi(cu);
                float m0 = c0 + (p0 - c0) * mu0, m1 = c1 + (p1 - c1) * mu1;
                if (c2 >= 768 && c2 < 832) { m0 = tanhf(m0); m1 = tanhf(m1); }
                else if (c2 >= 896) { m0 = sigm(m0); m1 = sigm(m1); }
                f32x2v mm; mm.x = m0; mm.y = m1;
                *(f32x2v*)(cmL + i * 1024 + c2) = mm;
                p0 = c0; p1 = c1;
            }
        }
        __syncthreads();
        if (layer > 0) {
            const int t = tid >> 5, m = tid & 31; float acc = 0.f;
            const float* v1 = P.in[I_V1];
            for (int c = 0; c < 256; ++c) acc += cmL[t * 1024 + 512 + c] * v1[c * 32 + m];
            uL[t * 32 + m] = acc;
        }
        __syncthreads();
        {
            float aw[8], aa[8], ag[8];
#pragma unroll
            for (int q = 0; q < 8; ++q) { aw[q] = 0.f; aa[q] = 0.f; ag[q] = 0.f; }
            for (int i = 0; i < 64; i += 4) {
                float w2v[4], a2v[4];
#pragma unroll
                for (int q = 0; q < 4; ++q) { w2v[q] = w2[(i + q) * 256 + j]; a2v[q] = a2[(i + q) * 256 + j]; }
#pragma unroll
                for (int tt = 0; tt < 8; ++tt) {
                    const f32x4 x = *(const f32x4*)(cmL + (tb + tt) * 1024 + 768 + i);
                    const f32x4 y = *(const f32x4*)(cmL + (tb + tt) * 1024 + 832 + i);
                    aw[tt] += x.x * w2v[0] + x.y * w2v[1] + x.z * w2v[2] + x.w * w2v[3];
                    aa[tt] += y.x * a2v[0] + y.y * a2v[1] + y.z * a2v[2] + y.w * a2v[3];
                }
            }
            for (int i = 0; i < 128; i += 4) {
                float g2v[4];
#pragma unroll
                for (int q = 0; q < 4; ++q) g2v[q] = g2[(i + q) * 256 + j];
#pragma unroll
                for (int tt = 0; tt < 8; ++tt) {
                    const f32x4 x = *(const f32x4*)(cmL + (tb + tt) * 1024 + 896 + i);
                    ag[tt] += x.x * g2v[0] + x.y * g2v[1] + x.z * g2v[2] + x.w * g2v[3];
                }
            }
#pragma unroll
            for (int tt = 0; tt < 8; ++tt) {
                const int t = t0 + tb + tt; const float* cr = cmL + (tb + tt) * 1024;
                const float r = cr[j], k = cr[256 + j]; float v = cr[512 + j];
                const float x = -(w0j + aw[tt]);
                const float sp = fmaxf(x, 0.f) + log1pf(__expf(-fabsf(x)));
                const float e = __expf(-sp - 0.5f);
                const float a = sigm(a0j + aa[tt]);
                if (layer == 0) { VF[(size_t)t * 256 + j] = v; }
                else {
                    float acc = v0j; const float* v2 = P.in[I_V2];
#pragma unroll 8
                    for (int m = 0; m < 32; ++m) acc += uL[(tb + tt) * 32 + m] * v2[m * 256 + j];
                    const float vf = VF[(size_t)t * 256 + j];
                    v = v + (vf - v) * sigm(acc);
                }
                float kk = k * kkj; const float ss = wave_sum(kk * kk); kk = kk / fmaxf(sqrtf(ss), 1e-12f);
                const float k2 = k * (1.f + (a - 1.f) * kaj);
                const size_t o = (size_t)t * 256 + j;
                RK[0 * RKSZ + o] = (h16)r; RK[1 * RKSZ + o] = (h16)k2; RK[2 * RKSZ + o] = (h16)v; RK[3 * RKSZ + o] = (h16)kk;
                RK[4 * RKSZ + o] = (h16)(kk * a); RK[5 * RKSZ + o] = (h16)e; RK[6 * RKSZ + o] = (h16)ag[tt];
            }
        }
    }
}

__device__ __forceinline__ void attn_partial(const Params& P, int tid) {
    const bf16_t* ZB = (const bf16_t*)(P.ws + OFF_ZB);
    bf16_t* MIX = (bf16_t*)(P.ws + OFF_HN);
    float* LSE = (float*)(P.ws + OFF_LSE);
    const int total = 3 * 4 * S_;
    for (int it = blockIdx.x * NTHREADS + tid; it < total; it += gridDim.x * NTHREADS) {
        const int t = it & (S_ - 1), h = (it >> 14) & 3, p = it >> 16;
        const int d = (p == 0) ? 1 : (p == 1 ? 4 : 16);
        const int li = t / d; const int nk = (li < 128 ? li : 128) + 1;
        float q[64], o[64];
        {
            const u32x4* qr = (const u32x4*)(ZB + (size_t)t * 768 + h * 64);
#pragma unroll
            for (int c = 0; c < 8; ++c) {
                const u32x4 x = qr[c];
                q[8 * c + 0] = bflo(x.x) * 0.125f; q[8 * c + 1] = bfhi(x.x) * 0.125f; q[8 * c + 2] = bflo(x.y) * 0.125f; q[8 * c + 3] = bfhi(x.y) * 0.125f;
                q[8 * c + 4] = bflo(x.z) * 0.125f; q[8 * c + 5] = bfhi(x.z) * 0.125f; q[8 * c + 6] = bflo(x.w) * 0.125f; q[8 * c + 7] = bfhi(x.w) * 0.125f;
            }
        }
#pragma unroll
        for (int i = 0; i < 64; ++i) o[i] = 0.f;
        float m = -1e30f, l = 0.f;
        for (int jx = 0; jx < nk; ++jx) {
            const bf16_t* kr = ZB + (size_t)(t - jx * d) * 768 + 256 + h * 64;
            float s = 0.f;
#pragma unroll
            for (int c = 0; c < 8; ++c) {
                const u32x4 x = ((const u32x4*)kr)[c];
                s += q[8 * c + 0] * bflo(x.x) + q[8 * c + 1] * bfhi(x.x) + q[8 * c + 2] * bflo(x.y) + q[8 * c + 3] * bfhi(x.y)
                   + q[8 * c + 4] * bflo(x.z) + q[8 * c + 5] * bfhi(x.z) + q[8 * c + 6] * bflo(x.w) + q[8 * c + 7] * bfhi(x.w);
            }
            if (s > m) {
                const float sc = __expf(m - s); l *= sc;
#pragma unroll
                for (int i = 0; i < 64; ++i) o[i] *= sc;
                m = s;
            }
            const float pw = __expf(s - m); l += pw;
            const bf16_t* vr = kr + 256;
#pragma unroll
            for (int c = 0; c < 8; ++c) {
                const u32x4 x = ((const u32x4*)vr)[c];
                o[8 * c + 0] += pw * bflo(x.x); o[8 * c + 1] += pw * bfhi(x.x); o[8 * c + 2] += pw * bflo(x.y); o[8 * c + 3] += pw * bfhi(x.y);
                o[8 * c + 4] += pw * bflo(x.z); o[8 * c + 5] += pw * bfhi(x.z); o[8 * c + 6] += pw * bflo(x.w); o[8 * c + 7] += pw * bfhi(x.w);
            }
        }
        const float inv = 1.f / l;
        const int slot = ((p == 0) ? 0 : (p == 1 ? 256 : 768)) + h * 64;
        u32x4* dst = (u32x4*)(MIX + (size_t)t * 1024 + slot);
#pragma unroll
        for (int c = 0; c < 8; ++c) {
            u32x4 w; w.x = pk2(o[8 * c + 0] * inv, o[8 * c + 1] * inv); w.y = pk2(o[8 * c + 2] * inv, o[8 * c + 3] * inv);
            w.z = pk2(o[8 * c + 4] * inv, o[8 * c + 5] * inv); w.w = pk2(o[8 * c + 6] * inv, o[8 * c + 7] * inv);
            dst[c] = w;
        }
        LSE[((size_t)p * S_ + t) * 4 + h] = m + __logf(l);
    }
}

__device__ __forceinline__ void attn_combine(const Params& P, int tid) {
    bf16_t* MIX = (bf16_t*)(P.ws + OFF_HN);
    const float* LSE = (const float*)(P.ws + OFF_LSE);
    const int total = S_ * 4 * 8;
    for (int it = blockIdx.x * NTHREADS + tid; it < total; it += gridDim.x * NTHREADS) {
        const int c8 = it & 7, h = (it >> 3) & 3, t = it >> 5;
        const float l0 = LSE[((size_t)0 * S_ + t) * 4 + h], l1 = LSE[((size_t)1 * S_ + t) * 4 + h], l2 = LSE[((size_t)2 * S_ + t) * 4 + h];
        const float mx = fmaxf(l0, fmaxf(l1, l2));
        float w0 = __expf(l0 - mx), w1 = __expf(l1 - mx), w2 = __expf(l2 - mx);
        const float inv = 1.f / (w0 + w1 + w2); w0 *= inv; w1 *= inv; w2 *= inv;
        const size_t rb = (size_t)t * 1024 + h * 64 + c8 * 8;
        const u32x4 a = *(const u32x4*)(MIX + rb), b = *(const u32x4*)(MIX + rb + 256), c = *(const u32x4*)(MIX + rb + 768);
        u32x4 o;
        o.x = pk2(w0 * bflo(a.x) + w1 * bflo(b.x) + w2 * bflo(c.x), w0 * bfhi(a.x) + w1 * bfhi(b.x) + w2 * bfhi(c.x));
        o.y = pk2(w0 * bflo(a.y) + w1 * bflo(b.y) + w2 * bflo(c.y), w0 * bfhi(a.y) + w1 * bfhi(b.y) + w2 * bfhi(c.y));
        o.z = pk2(w0 * bflo(a.z) + w1 * bflo(b.z) + w2 * bflo(c.z), w0 * bfhi(a.z) + w1 * bfhi(b.z) + w2 * bfhi(c.z));
        o.w = pk2(w0 * bflo(a.w) + w1 * bflo(b.w) + w2 * bflo(c.w), w0 * bfhi(a.w) + w1 * bfhi(b.w) + w2 * bfhi(c.w));
        *(u32x4*)(MIX + rb + 512) = o;
    }
}

__device__ __forceinline__ float hgrn_lb(const Params& P, int layer, int idx) {
    if (layer == 0) return 0.f;
    return sigm(P.in[I_LB][512 + idx] - P.in[I_LB][idx]);
}

__device__ __forceinline__ void hgrn_pass1(const Params& P, int layer, unsigned char* smem, int tid) {
    float* khat = (float*)smem; float* iv = khat + 64 * 128; float* tot = iv + 64 * 128;
    const bf16_t* ZH = (const bf16_t*)(P.ws + OFF_ZH);
    bf16_t* NC = (bf16_t*)(P.ws + OFF_ZC);
    float* GB = (float*)(P.ws + OFF_GB);
    const int k = tid & 127, qd = tid >> 7;
    for (int item = blockIdx.x; item < 1024; item += gridDim.x) {
        const int c = item >> 2, h = item & 3, t0 = c * 64;
        const float lbv = hgrn_lb(P, layer, h * 128 + k);
        __syncthreads();
        float fl[16], bl[16]; float run = 0.f;
#pragma unroll
        for (int i = 0; i < 16; ++i) {
            const size_t ro = (size_t)(t0 + 16 * qd + i) * 2048 + h * 128 + k;
            const float fr = bf2f(ZH[ro + 512]);
            const float f = lbv + (1.f - lbv) * sigm(fr);
            fl[i] = f; run += __logf(f); bl[i] = run;
            iv[(16 * qd + i) * 128 + k] = bf2f(ZH[ro + 1024]);
        }
        tot[qd * 128 + k] = run;
        __syncthreads();
        float pre = 0.f, all = 0.f;
#pragma unroll
        for (int q = 0; q < 4; ++q) { const float x = tot[q * 128 + k]; if (q < qd) pre += x; all += x; }
#pragma unroll
        for (int i = 0; i < 16; ++i) khat[(16 * qd + i) * 128 + k] = (1.f - fl[i]) * __expf(all - (pre + bl[i]));
        if (qd == 0) GB[(size_t)(c * 4 + h) * 128 + k] = __expf(all);
        __syncthreads();
        float acc[32];
#pragma unroll
        for (int q = 0; q < 32; ++q) acc[q] = 0.f;
        for (int jx = 0; jx < 64; ++jx) {
            const float kh = khat[jx * 128 + k];
            const f32x4* ivr = (const f32x4*)(iv + jx * 128 + 32 * qd);
#pragma unroll
            for (int q = 0; q < 8; ++q) { const f32x4 x = ivr[q]; acc[4 * q] += kh * x.x; acc[4 * q + 1] += kh * x.y; acc[4 * q + 2] += kh * x.z; acc[4 * q + 3] += kh * x.w; }
        }
        u32x4* dst = (u32x4*)(NC + ((size_t)(c * 4 + h) * 128 + k) * 128 + 32 * qd);
#pragma unroll
        for (int q = 0; q < 4; ++q) {
            u32x4 w; w.x = pk2(acc[8 * q], acc[8 * q + 1]); w.y = pk2(acc[8 * q + 2], acc[8 * q + 3]); w.z = pk2(acc[8 * q + 4], acc[8 * q + 5]); w.w = pk2(acc[8 * q + 6], acc[8 * q + 7]);
            dst[q] = w;
        }
    }
}

__device__ __forceinline__ void hgrn_scan(const Params& P, int tid) {
    bf16_t* NC = (bf16_t*)(P.ws + OFF_ZC);
    const float* GB = (const float*)(P.ws + OFF_GB);
    if (tid >= 128) return;
    for (int e = blockIdx.x * 128 + tid; e < 32768; e += gridDim.x * 128) {
        const int h = e >> 13, k = (e >> 6) & 127, v2 = e & 63;
        float s0 = 0.f, s1 = 0.f;
        for (int c0 = 0; c0 < 256; c0 += 16) {
            unsigned n[16]; float g[16];
#pragma unroll
            for (int u = 0; u < 16; ++u) {
                n[u] = *(const unsigned*)(NC + ((size_t)((c0 + u) * 4 + h) * 128 + k) * 128 + 2 * v2);
                g[u] = GB[(size_t)((c0 + u) * 4 + h) * 128 + k];
            }
#pragma unroll
            for (int u = 0; u < 16; ++u) {
                *(unsigned*)(NC + ((size_t)((c0 + u) * 4 + h) * 128 + k) * 128 + 2 * v2) = pk2(s0, s1);
                s0 = g[u] * s0 + bflo(n[u]); s1 = g[u] * s1 + bfhi(n[u]);
            }
        }
    }
}

__device__ __forceinline__ void hgrn_pass3_item(const Params& P, int layer, unsigned char* smem, int tid, int item) {
    float* bL = (float*)smem;
    float* kvL = bL + 64 * 129;
    float* qL = kvL + 64 * 129;
    float* ivL = qL + 64 * 128;
    float* scL = ivL + 64 * 128;
    float* tot = scL + 64 * 64;
    float* rinv = tot + 512;
    const bf16_t* ZH = (const bf16_t*)(P.ws + OFF_ZH);
    const bf16_t* NC = (const bf16_t*)(P.ws + OFF_ZC);
    bf16_t* MIX = (bf16_t*)(P.ws + OFF_HN);
    const int c = item >> 2, h = item & 3, t0 = c * 64;
    {
        const int k = tid & 127, qd = tid >> 7;
        const float lbv = hgrn_lb(P, layer, h * 128 + k);
        __syncthreads();
        float fl[16], bl[16]; float run = 0.f;
#pragma unroll
        for (int i = 0; i < 16; ++i) {
            const size_t ro = (size_t)(t0 + 16 * qd + i) * 2048 + h * 128 + k;
            const float qr = bf2f(ZH[ro]);
            const float fr = bf2f(ZH[ro + 512]);
            const float f = lbv + (1.f - lbv) * sigm(fr);
            fl[i] = f; run += __logf(f); bl[i] = run;
            qL[(16 * qd + i) * 128 + k] = qr * sigm(qr);
            ivL[(16 * qd + i) * 128 + k] = bf2f(ZH[ro + 1024]);
        }
        tot[qd * 128 + k] = run;
        __syncthreads();
        float pre = 0.f;
#pragma unroll
        for (int q = 0; q < 4; ++q) { const float x = tot[q * 128 + k]; if (q < qd) pre += x; }
#pragma unroll
        for (int i = 0; i < 16; ++i) { bL[(16 * qd + i) * 129 + k] = pre + bl[i]; kvL[(16 * qd + i) * 129 + k] = 1.f - fl[i]; }
        __syncthreads();
    }
    {
        const int jx = tid & 63, ig = tid >> 6;
        for (int m = 0; m < 8; ++m) {
            const int i = ig + 8 * m; float s = 0.f;
            if (jx <= i) {
                for (int k = 0; k < 128; ++k) s += qL[i * 128 + k] * kvL[jx * 129 + k] * __expf(bL[i * 129 + k] - bL[jx * 129 + k]);
            }
            scL[i * 64 + jx] = s;
        }
        __syncthreads();
    }
    {
        for (int e = tid; e < 64 * 128; e += NTHREADS) { const int i = e >> 7, k = e & 127; qL[e] *= __expf(bL[i * 129 + k]); }
        __syncthreads();
    }
    {
        const int v = tid & 127, ig = tid >> 7;
        float acc[16];
#pragma unroll
        for (int m = 0; m < 16; ++m) acc[m] = 0.f;
        const bf16_t* Sb = NC + ((size_t)(c * 4 + h) * 128) * 128 + v;
        for (int k = 0; k < 128; k += 4) {
            const float s0 = bf2f(Sb[(size_t)(k + 0) * 128]), s1 = bf2f(Sb[(size_t)(k + 1) * 128]), s2 = bf2f(Sb[(size_t)(k + 2) * 128]), s3 = bf2f(Sb[(size_t)(k + 3) * 128]);
#pragma unroll
            for (int m = 0; m < 16; ++m) { const f32x4 qv = *(const f32x4*)(qL + (ig + 4 * m) * 128 + k); acc[m] += qv.x * s0 + qv.y * s1 + qv.z * s2 + qv.w * s3; }
        }
        for (int jx = 0; jx < 64; jx += 4) {
            const float i0 = ivL[(jx + 0) * 128 + v], i1 = ivL[(jx + 1) * 128 + v], i2 = ivL[(jx + 2) * 128 + v], i3 = ivL[(jx + 3) * 128 + v];
#pragma unroll
            for (int m = 0; m < 16; ++m) { const f32x4 sc = *(const f32x4*)(scL + (ig + 4 * m) * 64 + jx); acc[m] += sc.x * i0 + sc.y * i1 + sc.z * i2 + sc.w * i3; }
        }
        float* oL = kvL;
#pragma unroll
        for (int m = 0; m < 16; ++m) oL[(ig + 4 * m) * 128 + v] = acc[m];
        __syncthreads();
        {
            const int i = tid >> 3, part = tid & 7; float ss = 0.f;
#pragma unroll
            for (int vv = 0; vv < 16; ++vv) { const float x = oL[i * 128 + part * 16 + vv]; ss += x * x; }
            ss += __shfl_xor(ss, 1); ss += __shfl_xor(ss, 2); ss += __shfl_xor(ss, 4);
            if (part == 0) rinv[i] = rsqrtf(ss * (1.f / 128.f) + 1e-6f);
        }
        __syncthreads();
        const float gn = P.in[I_GN][layer * 512 + h * 128 + v];
#pragma unroll 4
        for (int m = 0; m < 16; ++m) {
            const int i = ig + 4 * m; const size_t t = (size_t)(t0 + i);
            const float gr = bf2f(ZH[t * 2048 + 1536 + h * 128 + v]);
            const float val = oL[i * 128 + v] * rinv[i] * gn * gr * sigm(gr);
            MIX[t * 1024 + h * 128 + v] = f2bf(val);
        }
    }
}

__device__ __forceinline__ float dpp_f(float x, const int ctrl_sel) {
    const int xi = __float_as_int(x); int r;
    if (ctrl_sel == 0) r = __builtin_amdgcn_update_dpp(0, xi, 0xB1, 0xF, 0xF, true);
    else if (ctrl_sel == 1) r = __builtin_amdgcn_update_dpp(0, xi, 0x4E, 0xF, 0xF, true);
    else if (ctrl_sel == 2) r = __builtin_amdgcn_update_dpp(0, xi, 0x141, 0xF, 0xF, true);
    else r = __builtin_amdgcn_update_dpp(0, xi, 0x140, 0xF, 0xF, true);
    return __int_as_float(r);
}
__device__ __forceinline__ float sum16(float x) { x += dpp_f(x, 0); x += dpp_f(x, 1); x += dpp_f(x, 2); x += dpp_f(x, 3); return x; }

constexpr int RS_T = 32;
constexpr int RS_BUF = 5 * RS_T * 64 + RS_T * 16;
__device__ __forceinline__ void rwkv_scan_load(const h16* RK, float* buf, int ch, int h, int rg, int lt) {
    const int tok = lt >> 3, col = (lt & 7) * 8; const size_t t = (size_t)ch * RS_T + tok;
    const size_t go = t * 256 + h * 64 + col;
    const int srcs[5] = {5, 3, 4, 1, 0};
#pragma unroll
    for (int a = 0; a < 5; ++a) {
        const h16x8 hv = *(const h16x8*)(RK + (size_t)srcs[a] * RKSZ + go);
        f32x4 lo, hi;
        lo.x = (float)hv[0]; lo.y = (float)hv[1]; lo.z = (float)hv[2]; lo.w = (float)hv[3]; hi.x = (float)hv[4]; hi.y = (float)hv[5]; hi.z = (float)hv[6]; hi.w = (float)hv[7];
        if (a == 0) { lo.x = __expf(-lo.x); lo.y = __expf(-lo.y); lo.z = __expf(-lo.z); lo.w = __expf(-lo.w); hi.x = __expf(-hi.x); hi.y = __expf(-hi.y); hi.z = __expf(-hi.z); hi.w = __expf(-hi.w); }
        float* d = buf + a * (RS_T * 64) + tok * 64 + col;
        *(f32x4*)d = lo; *(f32x4*)(d + 4) = hi;
    }
    {
        const int idx = lt * 2, tk = idx >> 4, row = idx & 15;
        const h16x2 hv = *(const h16x2*)(RK + (size_t)2 * RKSZ + ((size_t)ch * RS_T + tk) * 256 + h * 64 + 16 * rg + row);
        buf[5 * RS_T * 64 + tk * 16 + row] = (float)hv[0]; buf[5 * RS_T * 64 + tk * 16 + row + 1] = (float)hv[1];
    }
}
__device__ __forceinline__ void rwkv_scan(const Params& P, unsigned char* smem, int tid) {
    const int b = blockIdx.x, h = b >> 2, rg = b & 3;
    float* L = (float*)smem;
    const h16* RK = (const h16*)(P.ws + OFF_RK);
    bf16_t* MIX = (bf16_t*)(P.ws + OFF_HN);
    const int w = tid >> 6, lane = tid & 63;
    const int row = 4 * (w & 3) + (lane >> 4), ks = lane & 15;
    __syncthreads();
    if (w >= 4) rwkv_scan_load(RK, L, 0, h, rg, tid - 256);
    __syncthreads();
    float s0 = 0.f, s1 = 0.f, s2 = 0.f, s3 = 0.f;
    constexpr int NCH = S_ / RS_T;
    for (int ch = 0; ch < NCH; ++ch) {
        float* buf = L + (ch & 1) * RS_BUF;
        if (w >= 4) { if (ch + 1 < NCH) rwkv_scan_load(RK, L + ((ch + 1) & 1) * RS_BUF, ch + 1, h, rg, tid - 256); }
        else {
#pragma unroll 4
            for (int tt = 0; tt < RS_T; ++tt) {
                const f32x4 w4 = *(const f32x4*)(buf + 0 * (RS_T * 64) + tt * 64 + 4 * ks);
                const f32x4 kk4 = *(const f32x4*)(buf + 1 * (RS_T * 64) + tt * 64 + 4 * ks);
                const f32x4 b4 = *(const f32x4*)(buf + 2 * (RS_T * 64) + tt * 64 + 4 * ks);
                const f32x4 k4 = *(const f32x4*)(buf + 3 * (RS_T * 64) + tt * 64 + 4 * ks);
                const f32x4 r4 = *(const f32x4*)(buf + 4 * (RS_T * 64) + tt * 64 + 4 * ks);
                const float vv = buf[5 * RS_T * 64 + tt * 16 + row];
                const float d = (s0 * kk4.x + s1 * kk4.y) + (s2 * kk4.z + s3 * kk4.w);
                const float sa = -sum16(d);
                s0 = s0 * w4.x + (sa * b4.x + vv * k4.x);
                s1 = s1 * w4.y + (sa * b4.y + vv * k4.y);
                s2 = s2 * w4.z + (sa * b4.z + vv * k4.z);
                s3 = s3 * w4.w + (sa * b4.w + vv * k4.w);
                const float y = sum16((s0 * r4.x + s1 * r4.y) + (s2 * r4.z + s3 * r4.w));
                if (ks == 0) MIX[((size_t)ch * RS_T + tt) * 1024 + 768 + h * 64 + 16 * rg + row] = f2bf(y);
            }
        }
        __syncthreads();
    }
}

__device__ __forceinline__ void rwkv_post(const Params& P, int layer, int tid) {
    const int wave = tid >> 6, lane = tid & 63;
    const h16* RK = (const h16*)(P.ws + OFF_RK);
    bf16_t* MIX = (bf16_t*)(P.ws + OFF_HN);
    const float* lnw = P.in[I_LNW] + layer * 256; const float* lnb = P.in[I_LNB] + layer * 256; const float* rk = P.in[I_RK] + layer * 256;
    for (int pr = blockIdx.x * 8 + wave; pr < S_ * 4; pr += gridDim.x * 8) {
        const int t = pr >> 2, h = pr & 3, col = h * 64 + lane;
        const float y = bf2f(MIX[(size_t)t * 1024 + 768 + col]);
        const float mean = wave_sum(y) * (1.f / 64.f); const float dl = y - mean;
        const float var = wave_sum(dl * dl) * (1.f / 64.f);
        const float yn = dl * rsqrtf(var + 64e-5f) * lnw[col] + lnb[col];
        const size_t o = (size_t)t * 256 + col;
        const float r = (float)RK[0 * RKSZ + o], k = (float)RK[1 * RKSZ + o], v = (float)RK[2 * RKSZ + o], g = (float)RK[6 * RKSZ + o];
        const float bonus = wave_sum(r * k * rk[col]) * v;
        MIX[(size_t)t * 1024 + 768 + col] = f2bf((yn + bonus) * g);
    }
}

__device__ __forceinline__ void conv_glu(const Params& P, int layer, int hf, int tid) {
    const bf16_t* U = (const bf16_t*)(P.ws + OFF_U);
    bf16_t* ACT = (bf16_t*)(P.ws + OFF_ACT);
    bf16_t* HALO = (bf16_t*)(P.ws + OFF_HALO);
    const float* cw = P.in[I_CW] + (size_t)layer * 3 * 5632; const float* cb = P.in[I_CB] + (size_t)layer * 5632;
    const int gt = blockIdx.x * NTHREADS + tid, nth = gridDim.x * NTHREADS;
    for (int it = gt; it < 352 * 256; it += nth) {
        const int cgp = it % 352, run = it / 352, c = cgp * 8, lt0 = run * 32;
        float wg[3][8], wv[3][8], bg[8], bv[8];
#pragma unroll
        for (int q = 0; q < 8; ++q) {
            bg[q] = cb[c + q]; bv[q] = cb[2816 + c + q];
#pragma unroll
            for (int jx = 0; jx < 3; ++jx) { wg[jx][q] = cw[jx * 5632 + c + q]; wv[jx][q] = cw[jx * 5632 + 2816 + c + q]; }
        }
        u32x4 g2, g1, v2, v1;
        if (lt0 == 0) {
            if (hf == 0) { g2 = (u32x4){0, 0, 0, 0}; g1 = g2; v2 = g2; v1 = g2; }
            else { g2 = *(const u32x4*)(HALO + c); v2 = *(const u32x4*)(HALO + 2816 + c); g1 = *(const u32x4*)(HALO + 5632 + c); v1 = *(const u32x4*)(HALO + 5632 + 2816 + c); }
        } else {
            g2 = *(const u32x4*)(U + (size_t)(lt0 - 2) * 5632 + c); v2 = *(const u32x4*)(U + (size_t)(lt0 - 2) * 5632 + 2816 + c);
            g1 = *(const u32x4*)(U + (size_t)(lt0 - 1) * 5632 + c); v1 = *(const u32x4*)(U + (size_t)(lt0 - 1) * 5632 + 2816 + c);
        }
#pragma unroll 2
        for (int i = 0; i < 32; ++i) {
            const u32x4 g0 = *(const u32x4*)(U + (size_t)(lt0 + i) * 5632 + c), v0 = *(const u32x4*)(U + (size_t)(lt0 + i) * 5632 + 2816 + c);
            float res[8];
#pragma unroll
            for (int q = 0; q < 4; ++q) {
                const unsigned a2 = g2[q], a1 = g1[q], a0 = g0[q], b2 = v2[q], b1 = v1[q], b0 = v0[q];
                const float glo = bg[2 * q] + wg[0][2 * q] * bflo(a2) + wg[1][2 * q] * bflo(a1) + wg[2][2 * q] * bflo(a0);
                const float ghi = bg[2 * q + 1] + wg[0][2 * q + 1] * bfhi(a2) + wg[1][2 * q + 1] * bfhi(a1) + wg[2][2 * q + 1] * bfhi(a0);
                const float vlo = bv[2 * q] + wv[0][2 * q] * bflo(b2) + wv[1][2 * q] * bflo(b1) + wv[2][2 * q] * bflo(b0);
                const float vhi = bv[2 * q + 1] + wv[0][2 * q + 1] * bfhi(b2) + wv[1][2 * q + 1] * bfhi(b1) + wv[2][2 * q + 1] * bfhi(b0);
                res[2 * q] = glo * sigm(glo) * vlo; res[2 * q + 1] = ghi * sigm(ghi) * vhi;
            }
            u32x4 o; o.x = pk2(res[0], res[1]); o.y = pk2(res[2], res[3]); o.z = pk2(res[4], res[5]); o.w = pk2(res[6], res[7]);
            *(u32x4*)(ACT + (size_t)(hf * 8192 + lt0 + i) * 2816 + c) = o;
            g2 = g1; g1 = g0; v2 = v1; v1 = v0;
        }
    }
    if (hf == 0) {
        for (int it = gt; it < 2 * 704; it += nth) { const int r = it / 704, cc = it % 704; *(u32x4*)(HALO + (size_t)r * 5632 + cc * 8) = *(const u32x4*)(U + (size_t)(8190 + r) * 5632 + cc * 8); }
    }
}

__device__ __forceinline__ void run_phase(const Params& P, int ph, unsigned char* smem) {
    const int tid = launder((int)threadIdx.x), wave = tid >> 6, lane = tid & 63;
    const int gw = blockIdx.x * 8 + wave, ngw = gridDim.x * 8;
    bf16_t* WT = (bf16_t*)(P.ws + OFF_WT);
    bf16_t* HN = (bf16_t*)(P.ws + OFF_HN);
    if (PH(16) && ph == 32) {
        const float* g = P.in[I_NFIN];
        for (int row = gw; row < S_; row += ngw) {
            f32x4* xr = (f32x4*)(P.out + (size_t)row * D_) + lane;
            f32x4 v[4]; float s = 0.f;
#pragma unroll
            for (int j = 0; j < 4; ++j) { v[j] = xr[64 * j]; s += (v[j].x * v[j].x + v[j].y * v[j].y) + (v[j].z * v[j].z + v[j].w * v[j].w); }
            s = wave_sum(s);
            const float r = rsqrtf(s * (1.f / 1024.f) + 1e-6f);
#pragma unroll
            for (int j = 0; j < 4; ++j) { const f32x4 gg = ((const f32x4*)g)[lane + 64 * j]; f32x4 o; o.x = v[j].x * r * gg.x; o.y = v[j].y * r * gg.y; o.z = v[j].z * r * gg.z; o.w = v[j].w * r * gg.w; xr[64 * j] = o; }
        }
        return;
    }
    const int layer = ph >> 4, sub = ph & 15;
    if (PH(0) && sub == 0) { phase_prep(P, layer, smem, tid); return; }
    if (PH(1) && (sub == 1 || sub == 9 || sub == 11)) {
        EpiRoute E; const bf16_t* A; const bf16_t* Bt; int M, N;
        if (sub == 1) { A = HN; Bt = WT + WT_IN; M = S_; N = 3840; E.d0 = (bf16_t*)(P.ws + OFF_ZH); E.ld0 = 2048; E.d1 = (bf16_t*)(P.ws + OFF_ZB); E.ld1 = 768; E.d2 = (bf16_t*)(P.ws + OFF_ZC); E.ld2 = 1024; E.c1 = 2048; E.c2 = 2816; }
        else { const int hf = (sub == 11); A = HN + (size_t)hf * 8192 * 1024; Bt = WT + WT_UP; M = 8192; N = 5632; E.d0 = (bf16_t*)(P.ws + OFF_U); E.ld0 = 5632; E.d1 = E.d0; E.ld1 = 5632; E.d2 = E.d0; E.ld2 = 5632; E.c1 = 1 << 30; E.c2 = 1 << 30; }
        run_gemm(smem, A, Bt, M, N, 1024, E); return;
    }
    if (PH(7) && (sub == 7 || sub == 13)) {
        EpiF32<0> E; const bf16_t* A; const bf16_t* Bt; int K;
        if (sub == 7) { A = HN; Bt = WT + WT_OUT; K = 1024; E.hin = (layer == 0) ? P.in[I_X] : P.out; }
        else { A = (const bf16_t*)(P.ws + OFF_ACT); Bt = WT + WT_DOWN; K = 2816; E.hin = P.out; }
        E.out = P.out;
        run_gemm(smem, A, Bt, S_, 1024, K, E); return;
    }
    if (PH(15) && sub == 15) {
        float* PP = (float*)(P.ws + OFF_PP);
        { EpiF32<1> E; E.hin = nullptr; E.out = PP; run_gemm(smem, (const bf16_t*)(P.ws + OFF_PB), WT + WT_PROJ, S_, 1024, 256, E); }
        __syncthreads();
        { EpiF32<2> E; E.hin = PP; E.out = P.out; run_gemm(smem, HN, WT + WT_GATE, S_, 1024, 1024, E); }
        return;
    }
    if (PH(2) && sub == 2) { rwkv_prep(P, layer, smem, tid); __syncthreads(); attn_partial(P, tid); return; }
    if (PH(3) && sub == 3) { hgrn_pass1(P, layer, smem, tid); attn_combine(P, tid); return; }
    if (PH(4) && sub == 4) { hgrn_scan(P, tid); return; }
    if (PH(5) && sub == 5) {
        if (blockIdx.x < 16) { rwkv_scan(P, smem, tid); }
        else { for (int item = blockIdx.x - 16; item < 1024; item += gridDim.x - 16) hgrn_pass3_item(P, layer, smem, tid, item); }
        return;
    }
    if (PH(6) && sub == 6) { rwkv_post(P, layer, tid); return; }
    if (PH(8) && sub == 8) { rmsnorm_rows_bf16(P.out, P.in[I_NFFN] + layer * 1024, HN, gw, ngw, lane); return; }
    if (PH(10) && (sub == 10 || sub == 12)) { conv_glu(P, layer, sub == 12, tid); return; }
    if (PH(14) && sub == 14) {
        rmsnorm_rows_bf16(P.out, P.in[I_NPLE] + layer * 1024, HN, gw, ngw, lane);
        const float* p = P.in[I_P] + (size_t)layer * S_ * 256; bf16_t* PB = (bf16_t*)(P.ws + OFF_PB);
        for (int it = blockIdx.x * NTHREADS + tid; it < S_ * 256 / 8; it += gridDim.x * NTHREADS) {
            const f32x4 a = ((const f32x4*)p)[2 * it], b = ((const f32x4*)p)[2 * it + 1];
            u32x4 o; o.x = pk2(a.x, a.y); o.y = pk2(a.z, a.w); o.z = pk2(b.x, b.y); o.w = pk2(b.z, b.w);
            ((u32x4*)PB)[it] = o;
        }
        return;
    }
}

#ifndef ONE_LAUNCH
#define ONE_LAUNCH 0
#endif

__global__ __launch_bounds__(512, 2) void mega(Params P, int ph_lo, int ph_hi) {
    extern __shared__ __attribute__((aligned(16))) unsigned char smem[];
    cg::grid_group grid = cg::this_grid();
    for (int ph = ph_lo; ph < ph_hi; ++ph) {
        if (ph > ph_lo) grid.sync();
        run_phase(P, ph, smem);
    }
}

extern "C" void kernel_launch(void* const* d_in, const int* in_sizes, int n_in, void* d_out, int out_size, void* d_ws, size_t ws_size, hipStream_t stream) {
    static int grid_blocks = 0;
    if (grid_blocks == 0) {
        int dev = 0, cus = 0, per_cu = 0;
        if (hipGetDevice(&dev) != hipSuccess || hipDeviceGetAttribute(&cus, hipDeviceAttributeMultiprocessorCount, dev) != hipSuccess) { fprintf(stderr, "kernel_launch: device query failed\n"); grid_blocks = -1; return; }
        if (hipFuncSetAttribute((const void*)mega, hipFuncAttributeMaxDynamicSharedMemorySize, LDS_BYTES) != hipSuccess) { fprintf(stderr, "kernel_launch: hipFuncSetAttribute failed\n"); grid_blocks = -1; return; }
        if (hipOccupancyMaxActiveBlocksPerMultiprocessor(&per_cu, (const void*)mega, NTHREADS, LDS_BYTES) != hipSuccess || per_cu < 1) { fprintf(stderr, "kernel_launch: occupancy query gave %d\n", per_cu); per_cu = 1; }
        (void)hipGetLastError();
        grid_blocks = cus * per_cu;
        if (n_in != 30 || ws_size < 256 * MiB) fprintf(stderr, "kernel_launch: unexpected n_in %d / ws_size %zu\n", n_in, ws_size);
    }
    if (grid_blocks < 0) return;
    Params P{};
    for (int i = 0; i < 30; ++i) P.in[i] = (const float*)d_in[i];
    P.out = (float*)d_out; P.ws = (unsigned char*)d_ws;
#if ONE_LAUNCH
    int lo = 0, hi = NPH;
    void* args[] = {&P, &lo, &hi};
    hipError_t e = hipLaunchCooperativeKernel((const void*)mega, dim3(grid_blocks), dim3(NTHREADS), args, LDS_BYTES, stream);
    if (e != hipSuccess) fprintf(stderr, "cooperative launch failed: %s (grid %d)\n", hipGetErrorString(e), grid_blocks);
#else
    for (int ph = 0; ph < NPH; ++ph) hipLaunchKernelGGL(mega, dim3(grid_blocks), dim3(NTHREADS), LDS_BYTES, stream, P, ph, ph + 1);
#endif
}
```

```cpp
#include <hip/hip_runtime.h>
#include <hip/hip_cooperative_groups.h>
#include <cstdio>
#include <cstdint>
namespace cg = cooperative_groups;
namespace pg8 {
#define PG8_LAS __attribute__((address_space(3)))
typedef unsigned short bf16_t;
typedef short bf16x8 __attribute__((ext_vector_type(8)));
typedef float f32x4 __attribute__((ext_vector_type(4)));
typedef unsigned u32x4 __attribute__((ext_vector_type(4)));
constexpr int BM = 256, BK = 64, HALF = 128, HTB = HALF * BK * 2  , STAGE_BYTES = 8 * HTB, NXCD = 8, WGM = 8;

__host__ __device__ __forceinline__ int lds_byte(int r, int c) { const int st = (r >> 4) * 2 + (c >> 5), rr = r & 15, cc = c & 31, ob = rr * 64 + cc * 2; return st * 1024 + (ob ^ (((ob >> 9) & 1) << 5)); }
__host__ __device__ __forceinline__ void stage_rc(int b, int& R, int& C) { const int st = b / 1024, sb = b % 1024, swz = sb ^ (((sb >> 9) & 1) << 5); R = (st >> 1) * 16 + swz / 64; C = (st & 1) * 32 + (swz % 64) / 2; }
__host__ __device__ __forceinline__ int perm32(int rho) { const int n = rho >> 4, i = rho & 15; return 8 * (i >> 2) + 4 * n + (i & 3); }

struct Unit { int pm, pn; };
struct Gemm { const bf16_t* A; const bf16_t* Bt; int M, N, K; };

struct StaticOrder {
    int nM, nN, nwg, G, c;
    __host__ __device__ void init(int M, int N, int G_, int c_) { nM = M / BM; nN = N / BM; nwg = nM * nN; G = G_; c = c_; }
    __host__ __device__ bool next(int i, Unit& u) const {
        const long L = (long)i * G + c; if (L >= nwg) return false;
        int wgid = (int)L; { const int q = nwg / NXCD, r = nwg % NXCD, xcd = wgid % NXCD, off = wgid / NXCD; wgid = (xcd < r ? xcd * (q + 1) : r * (q + 1) + (xcd - r) * q) + off; }
        const int nig = WGM * nN, gid = wgid / nig, fm = gid * WGM, gsz = (nM - fm) < WGM ? (nM - fm) : WGM;
        u.pm = fm + ((wgid % nig) % gsz); u.pn = (wgid % nig) / gsz; return true;
    }
    __device__ __forceinline__ void a_ready(const Unit&) const {}
    __device__ __forceinline__ void done(const Unit&) const {}
};
__device__ __forceinline__ unsigned cvt_pk_bf16(float lo, float hi) { unsigned r; asm volatile("v_cvt_pk_bf16_f32 %0, %1, %2" : "=v"(r) : "v"(lo), "v"(hi)); return r; }
typedef float f32x2 __attribute__((ext_vector_type(2)));
template <class Epi, class Sched, bool STAMP = false>
__device__ __forceinline__ void gemm_phase(PG8_LAS unsigned char* lds, const Gemm g, const Sched& S, const Epi& E, unsigned long long* stamps) {
    int tid_l = threadIdx.x; asm volatile("" : "+v"(tid_l)); const int tid = tid_l, wid = __builtin_amdgcn_readfirstlane(tid >> 6), lane = tid & 63, wr = wid >> 2, wc = wid & 3, fr = lane & 15, fq = lane >> 4;
    const int K = g.K, nt = K / BK;
    int ts_lo = 0, ts_hi = 0, nts = 0; const unsigned long long rt_entry = STAMP ? (unsigned long long)wall_clock64() : 0ull;
#define PG8_STAMP() do { if (STAMP && wid == 0 && nts < 64) { const unsigned long long _c = (unsigned long long)clock64(); \
        ts_lo = (lane == nts) ? (int)(unsigned)_c : ts_lo; ts_hi = (lane == nts) ? (int)(unsigned)(_c >> 32) : ts_hi; ++nts; } } while (0)
    PG8_STAMP();
    unsigned voffA[2], voffB[2];
#pragma unroll
    for (int i = 0; i < 2; ++i) { int R, C; stage_rc(tid * 16 + i * 8192, R, C); const int Rb = Epi::PERM ? ((R & ~31) + perm32(R & 31)) : R;
        voffA[i] = (unsigned)(R * K + C) * 2u; voffB[i] = (unsigned)(Rb * K + C) * 2u; }
    const size_t kstep = (size_t)(BK * 2);
    const size_t hstep = (size_t)HALF * K * 2;
    const size_t tstep = 2 * hstep;
    const unsigned ldsw = (unsigned)wid * 1024u;
    const int aoff = lds_byte(wr * 64 + fr, fq * 8), boff = lds_byte(wc * 32 + fr, fq * 8);
#define PG8_SA(b, h) (((b) * 2 + (h)) * HTB)
#define PG8_SB(b, h) ((4 + (b) * 2 + (h)) * HTB)
#define PG8_STAGE(bufoff, gbase, voff) do { _Pragma("unroll") for (int _i = 0; _i < 2; ++_i) \
        __builtin_amdgcn_global_load_lds((const unsigned*)((const char*)(gbase) + (voff)[_i]), (PG8_LAS unsigned*)(lds + (bufoff) + ldsw + _i * 8192), 16, 0, 0); } while (0)
#define PG8_LDA(dst, b, h) do { _Pragma("unroll") for (int m = 0; m < 4; ++m) _Pragma("unroll") for (int k = 0; k < 2; ++k) dst[m][k] = *(const PG8_LAS bf16x8*)(lds + PG8_SA(b, h) + aoff + m * 2048 + k * 1024); } while (0)
#define PG8_LDB(dst, b, h) do { _Pragma("unroll") for (int n = 0; n < 2; ++n) _Pragma("unroll") for (int k = 0; k < 2; ++k) dst[n][k] = *(const PG8_LAS bf16x8*)(lds + PG8_SB(b, h) + boff + n * 2048 + k * 1024); } while (0)
#define PG8_MMA(ai, bj, At, Bt) do { __builtin_amdgcn_s_setprio(1); _Pragma("unroll") for (int m = 0; m < 4; ++m) _Pragma("unroll") for (int n = 0; n < 2; ++n) _Pragma("unroll") for (int k = 0; k < 2; ++k) \
        acc[ai][bj][m][n] = __builtin_amdgcn_mfma_f32_16x16x32_bf16(Bt[n][k], At[m][k], acc[ai][bj][m][n], 0, 0, 0); __builtin_amdgcn_s_setprio(0); } while (0)
#define PG8_WAIT_V(n) asm volatile("s_waitcnt vmcnt(" #n ")" ::: "memory")
#define PG8_WAIT_L(n) asm volatile("s_waitcnt lgkmcnt(" #n ")" ::: "memory")
#define PG8_BAR __builtin_amdgcn_s_barrier()
#define PG8_SCHED __builtin_amdgcn_sched_barrier(0)
    Unit cur, nxt; int ui = 0;
    if (!S.next(0, cur)) return;
    f32x4 acc[2][2][4][2];
#pragma unroll
    for (int a = 0; a < 2; ++a)
#pragma unroll
        for (int b = 0; b < 2; ++b)
#pragma unroll
            for (int m = 0; m < 4; ++m)
#pragma unroll
                for (int n = 0; n < 2; ++n) acc[a][b][m][n] = (f32x4){0.f, 0.f, 0.f, 0.f};
    bf16x8 At[4][2], B0[2][2], B1[2][2];
    const char* cA = (const char*)g.A + (size_t)cur.pm * tstep; const char* cB = (const char*)g.Bt + (size_t)cur.pn * tstep;
    S.a_ready(cur);
    PG8_STAGE(PG8_SB(0, 0), cB, voffB); PG8_STAGE(PG8_SA(0, 0), cA, voffA); PG8_STAGE(PG8_SB(0, 1), cB + hstep, voffB); PG8_STAGE(PG8_SA(0, 1), cA + hstep, voffA);
    if (wr == 1) PG8_BAR;
    PG8_WAIT_V(4); PG8_BAR;
    PG8_STAGE(PG8_SB(1, 0), cB + kstep, voffB); PG8_STAGE(PG8_SA(1, 0), cA + kstep, voffA); PG8_STAGE(PG8_SB(1, 1), cB + hstep + kstep, voffB);
    PG8_WAIT_V(6); PG8_BAR;
    PG8_STAMP();
    for (;;) {
        const bool has_next = S.next(ui + 1, nxt);
        const char* nA = has_next ? (const char*)g.A + (size_t)nxt.pm * tstep : cA; const char* nB = has_next ? (const char*)g.Bt + (size_t)nxt.pn * tstep : cB;
        for (int t = 0; t < nt; t += 2) {
            const bool last = (t == nt - 2);
            const char* a1 = cA + (size_t)(t + 1) * kstep;
            const char* a2 = last ? nA : cA + (size_t)(t + 2) * kstep; const char* b2 = last ? nB : cB + (size_t)(t + 2) * kstep;
            const char* a3 = a2 + kstep; const char* b3 = b2 + kstep;
            if (last && has_next) S.a_ready(nxt);
            PG8_LDB(B0, 0, 0); PG8_SCHED; PG8_LDA(At, 0, 0); PG8_STAGE(PG8_SA(1, 1), a1 + hstep, voffA);
            PG8_WAIT_L(8); PG8_BAR; PG8_WAIT_L(0); PG8_MMA(0, 0, At, B0); PG8_BAR; PG8_SCHED;
            PG8_LDB(B1, 0, 1); PG8_STAGE(PG8_SB(0, 0), b2, voffB);
            PG8_BAR; PG8_WAIT_L(0); PG8_MMA(0, 1, At, B1); PG8_BAR;
            PG8_LDA(At, 0, 1); PG8_STAGE(PG8_SA(0, 0), a2, voffA);
            PG8_BAR; PG8_WAIT_L(0); PG8_MMA(1, 0, At, B0); PG8_BAR; PG8_SCHED;
            PG8_STAGE(PG8_SB(0, 1), b2 + hstep, voffB);
            PG8_WAIT_V(6); PG8_BAR; PG8_MMA(1, 1, At, B1); PG8_BAR;
            PG8_LDB(B0, 1, 0); PG8_SCHED; PG8_LDA(At, 1, 0); PG8_STAGE(PG8_SA(0, 1), a2 + hstep, voffA);
            PG8_WAIT_L(8); PG8_BAR; PG8_WAIT_L(0); PG8_MMA(0, 0, At, B0); PG8_BAR; PG8_SCHED;
            PG8_LDB(B1, 1, 1); PG8_STAGE(PG8_SB(1, 0), b3, voffB);
            PG8_BAR; PG8_WAIT_L(0); PG8_MMA(0, 1, At, B1); PG8_BAR;
            PG8_LDA(At, 1, 1); PG8_STAGE(PG8_SA(1, 0), a3, voffA);
            PG8_BAR; PG8_WAIT_L(0); PG8_MMA(1, 0, At, B0); PG8_BAR; PG8_SCHED;
            PG8_STAGE(PG8_SB(1, 1), b3 + hstep, voffB);
            PG8_WAIT_V(6); PG8_BAR; PG8_MMA(1, 1, At, B1); PG8_BAR;
        }
        PG8_STAMP();
        if constexpr (!Epi::AFTER_DRAIN) { E(acc, cur, wr, wc, fr, fq); S.done(cur); }
        PG8_STAMP();
        if (!has_next) break;
#pragma unroll
        for (int a = 0; a < 2; ++a)
#pragma unroll
            for (int b = 0; b < 2; ++b)
#pragma unroll
                for (int m = 0; m < 4; ++m)
#pragma unroll
                    for (int n = 0; n < 2; ++n) acc[a][b][m][n] = (f32x4){0.f, 0.f, 0.f, 0.f};
        cur = nxt; cA = nA; cB = nB; ++ui;
    }
    PG8_WAIT_V(0);
    if (wr == 0) PG8_BAR;
    PG8_BAR;
    if constexpr (Epi::AFTER_DRAIN) { E.fused(acc, cur, wr, wc, fr, fq, lds, wid, lane); S.done(cur); }
    PG8_STAMP();
    if (STAMP && wid == 0) { stamps[lane] = lane < nts ? (((unsigned long long)(unsigned)ts_hi << 32) | (unsigned)ts_lo) : 0ull;
        if (lane == 62) stamps[62] = rt_entry; if (lane == 63) stamps[63] = (unsigned long long)wall_clock64(); }
#undef PG8_STAMP
#undef PG8_SA
#undef PG8_SB
#undef PG8_STAGE
#undef PG8_LDA
#undef PG8_LDB
#undef PG8_MMA
#undef PG8_WAIT_V
#undef PG8_WAIT_L
#undef PG8_BAR
#undef PG8_SCHED
}
}

using pg8::bf16_t; using pg8::f32x4; using pg8::u32x4; using pg8::Unit;
typedef _Float16 h16;
typedef _Float16 h16x8 __attribute__((ext_vector_type(8)));
typedef _Float16 h16x2 __attribute__((ext_vector_type(2)));
typedef _Float16 h16x4 __attribute__((ext_vector_type(4)));
typedef float f32x2v __attribute__((ext_vector_type(2)));

constexpr int S_ = 16384, D_ = 1024;
constexpr int NTHREADS = 512;
constexpr int LDS_BYTES = 155648;
constexpr size_t MiB = (size_t)1 << 20;
constexpr size_t OFF_HALO = 0, OFF_WT = 1 * MiB, OFF_VF = 30 * MiB, OFF_LX = 38 * MiB, OFF_S0 = 42 * MiB, OFF_HN = 46 * MiB, OFF_BIG = 78 * MiB;
constexpr size_t OFF_ZH = OFF_BIG, OFF_ZB = OFF_BIG + 64 * MiB, OFF_ZC = OFF_BIG + 88 * MiB, OFF_RK = OFF_BIG + 120 * MiB,
                 OFF_LSE = OFF_BIG + 176 * MiB, OFF_GB = OFF_BIG + 177 * MiB;
constexpr size_t OFF_U = OFF_BIG, OFF_ACT = OFF_BIG + 88 * MiB;
constexpr size_t OFF_PB = OFF_BIG, OFF_PP = OFF_BIG + 8 * MiB;
constexpr size_t OFF_SSQ = OFF_BIG + 80 * MiB;
constexpr size_t WT_IN = 0, WT_OUT = 3932160, WT_UP = 4980736, WT_DOWN = 10747904, WT_GATE = 13631488, WT_PROJ = 14680064,
                 WT_W2 = 14942208, WT_A2 = 14958592, WT_G2 = 14974976, WT_V1 = 15007744;
constexpr size_t RKSZ = (size_t)S_ * 256;

enum { I_X = 0, I_P, I_WIN, I_WOUT, I_NMIX, I_NFFN, I_NPLE, I_NFIN, I_LB, I_GN, I_MU, I_W0, I_W2, I_A0, I_A2, I_G2, I_KK, I_KA, I_RK,
       I_LNW, I_LNB, I_V0, I_V1, I_V2, I_UP, I_CW, I_CB, I_DOWN, I_PROJ, I_GATE, N_IN };

struct Params { const float* in[30]; float* out; unsigned char* ws; };

constexpr int NPH_LAYER = 16, NPH = 33;
#ifndef PHMASK
#define PHMASK 0x1FFFF
#endif
#define PH(x) ((PHMASK >> (x)) & 1)

__device__ __forceinline__ float bf2f(unsigned short b) { return __uint_as_float(((unsigned)b) << 16); }
__device__ __forceinline__ float bflo(unsigned u) { return __uint_as_float(u << 16); }
__device__ __forceinline__ float bfhi(unsigned u) { return __uint_as_float(u & 0xffff0000u); }
__device__ __forceinline__ unsigned pk2(float lo, float hi) { return pg8::cvt_pk_bf16(lo, hi); }
__device__ __forceinline__ unsigned pk2_sw(float lo, float hi) { unsigned a = __float_as_uint(lo), b = __float_as_uint(hi); a += 0x7fffu + ((a >> 16) & 1u); b += 0x7fffu + ((b >> 16) & 1u); return (a >> 16) | (b & 0xffff0000u); }
__device__ __forceinline__ unsigned short f2bf(float f) { return (unsigned short)(pk2(f, 0.f) & 0xffffu); }
__device__ __forceinline__ float wave_sum(float v) {
#pragma unroll
    for (int o = 1; o < 64; o <<= 1) v += __shfl_xor(v, o);
    return v;
}
__device__ __forceinline__ float sigm(float x) { return __builtin_amdgcn_rcpf(1.f + __expf(-x)); }
__device__ __forceinline__ int launder(int x) { asm volatile("" : "+v"(x)); return x; }
__device__ __forceinline__ void lds_wait() { asm volatile("s_waitcnt lgkmcnt(0)" ::: "memory"); }

__device__ __forceinline__ void transpose_item(const float* __restrict__ W, int K, int N, bf16_t* __restrict__ WT, float* scr, int item, int lane, bool perm_up = false, const float* __restrict__ kscale = nullptr) {
    const int nblk = N / 32, kb = item / nblk, nb = item % nblk, k0 = 64 * kb, n0 = 32 * nb;
    const int d0 = !perm_up ? n0 : ((n0 < 2816) ? (256 * (n0 >> 7) + (n0 & 127)) : (256 * ((n0 - 2816) >> 7) + 128 + ((n0 - 2816) & 127)));
#pragma unroll 8
    for (int i = 0; i < 32; ++i) { const int kk = 2 * i + (lane >> 5); float x = W[(size_t)(k0 + kk) * N + n0 + (lane & 31)]; if (kscale) x *= kscale[k0 + kk]; scr[kk * 33 + (lane & 31)] = x; }
    lds_wait();
    const int c = lane & 7;
#pragma unroll
    for (int j = 0; j < 4; ++j) {
        const int n = (lane >> 3) + 8 * j; const float* s = scr + (8 * c) * 33 + n;
        u32x4 o; o.x = pk2(s[0 * 33], s[1 * 33]); o.y = pk2(s[2 * 33], s[3 * 33]); o.z = pk2(s[4 * 33], s[5 * 33]); o.w = pk2(s[6 * 33], s[7 * 33]);
        *(u32x4*)(WT + (size_t)(d0 + n) * K + k0 + 8 * c) = o;
    }
    lds_wait();
}

__device__ __forceinline__ void rmsnorm_rows_bf16(const float* __restrict__ h, const float* __restrict__ g, bf16_t* __restrict__ out, int gw, int ngw, int lane) {
    f32x4 gg[4];
#pragma unroll
    for (int j = 0; j < 4; ++j) gg[j] = ((const f32x4*)g)[lane + 64 * j];
    for (int row = gw; row < S_; row += 2 * ngw) {
        const f32x4* xa = (const f32x4*)(h + (size_t)row * D_) + lane;
        const f32x4* xb = (const f32x4*)(h + (size_t)(row + ngw) * D_) + lane;
        f32x4 va[4], vb[4]; float sa = 0.f, sb = 0.f;
#pragma unroll
        for (int j = 0; j < 4; ++j) { va[j] = xa[64 * j]; vb[j] = xb[64 * j]; }
#pragma unroll
        for (int j = 0; j < 4; ++j) { sa += (va[j].x * va[j].x + va[j].y * va[j].y) + (va[j].z * va[j].z + va[j].w * va[j].w); sb += (vb[j].x * vb[j].x + vb[j].y * vb[j].y) + (vb[j].z * vb[j].z + vb[j].w * vb[j].w); }
#pragma unroll
        for (int o = 1; o < 64; o <<= 1) { sa += __shfl_xor(sa, o); sb += __shfl_xor(sb, o); }
        const float ra = rsqrtf(sa * (1.f / 1024.f) + 1e-6f), rb = rsqrtf(sb * (1.f / 1024.f) + 1e-6f);
        unsigned long long* oa = (unsigned long long*)(out + (size_t)row * D_) + lane;
        unsigned long long* ob = (unsigned long long*)(out + (size_t)(row + ngw) * D_) + lane;
#pragma unroll
        for (int j = 0; j < 4; ++j) {
            oa[64 * j] = (unsigned long long)pk2(va[j].x * ra * gg[j].x, va[j].y * ra * gg[j].y) | ((unsigned long long)pk2(va[j].z * ra * gg[j].z, va[j].w * ra * gg[j].w) << 32);
            ob[64 * j] = (unsigned long long)pk2(vb[j].x * rb * gg[j].x, vb[j].y * rb * gg[j].y) | ((unsigned long long)pk2(vb[j].z * rb * gg[j].z, vb[j].w * rb * gg[j].w) << 32);
        }
    }
}

__device__ __forceinline__ void phase_prep(const Params& P, int layer, unsigned char* smem, int tid) {
    const int wave = tid >> 6, lane = tid & 63;
    const int gw = blockIdx.x * 8 + wave, ngw = gridDim.x * 8;
    float* scr = (float*)smem + wave * (64 * 33);
    bf16_t* WT = (bf16_t*)(P.ws + OFF_WT);
    constexpr int I0 = 16 * 120, I1 = 16 * 32, I2 = 16 * 176, I3 = 44 * 32, I4 = 16 * 32, I5 = 4 * 32, I6 = 8, I7 = 8, I8 = 16, I9 = 4;
    constexpr int NIT = I0 + I1 + I2 + I3 + I4 + I5 + I6 + I7 + I8 + I9;
    for (int it = gw; it < NIT; it += ngw) {
        int r = it;
        if (r < I0) { transpose_item(P.in[I_WIN] + (size_t)layer * 1024 * 3840, 1024, 3840, WT + WT_IN, scr, r, lane); continue; } r -= I0;
        if (r < I1) { transpose_item(P.in[I_WOUT] + (size_t)layer * 1024 * 1024, 1024, 1024, WT + WT_OUT, scr, r, lane); continue; } r -= I1;
        if (r < I2) { transpose_item(P.in[I_UP] + (size_t)layer * 1024 * 5632, 1024, 5632, WT + WT_UP, scr, r, lane, true); continue; } r -= I2;
        if (r < I3) { transpose_item(P.in[I_DOWN] + (size_t)layer * 2816 * 1024, 2816, 1024, WT + WT_DOWN, scr, r, lane); continue; } r -= I3;
        if (r < I4) { transpose_item(P.in[I_GATE] + (size_t)layer * 1024 * 1024, 1024, 1024, WT + WT_GATE, scr, r, lane, false, P.in[I_NPLE] + layer * 1024); continue; } r -= I4;
        if (r < I5) { transpose_item(P.in[I_PROJ] + (size_t)layer * 256 * 1024, 256, 1024, WT + WT_PROJ, scr, r, lane); continue; } r -= I5;
        if (r < I6) { transpose_item(P.in[I_W2] + (size_t)layer * 64 * 256, 64, 256, WT + WT_W2, scr, r, lane); continue; } r -= I6;
        if (r < I7) { transpose_item(P.in[I_A2] + (size_t)layer * 64 * 256, 64, 256, WT + WT_A2, scr, r, lane); continue; } r -= I7;
        if (r < I8) { transpose_item(P.in[I_G2] + (size_t)layer * 128 * 256, 128, 256, WT + WT_G2, scr, r, lane); continue; } r -= I8;
        transpose_item(P.in[I_V1], 256, 32, WT + WT_V1, scr, r, lane);
    }
    const float* h = (layer == 0) ? P.in[I_X] : P.out;
    rmsnorm_rows_bf16(h, P.in[I_NMIX] + layer * 1024, (bf16_t*)(P.ws + OFF_HN), gw, ngw, lane);
}

struct EpiRoute {
    static constexpr bool PERM = true, AFTER_DRAIN = false;
    bf16_t* d0; bf16_t* d1; bf16_t* d2; int ld0, ld1, ld2, c1, c2;
    __device__ __forceinline__ void operator()(const f32x4 (&acc)[2][2][4][2], const Unit& u, int wr, int wc, int fr, int fq) const {
        int colt = u.pn * 256; bf16_t* base; int ld;
        if (colt < c1) { base = d0; ld = ld0; } else if (colt < c2) { base = d1; ld = ld1; colt -= c1; } else { base = d2; ld = ld2; colt -= c2; }
        const int row0 = u.pm * 256 + wr * 64 + fr, col0 = colt + wc * 32 + 8 * fq;
#pragma unroll
        for (int ai = 0; ai < 2; ++ai)
#pragma unroll
            for (int m = 0; m < 4; ++m) {
                bf16_t* rowp = base + (size_t)(row0 + ai * 128 + m * 16) * ld + col0;
#pragma unroll
                for (int bj = 0; bj < 2; ++bj) {
                    const f32x4 v0 = acc[ai][bj][m][0], v1 = acc[ai][bj][m][1];
                    u32x4 w; w.x = pk2(v0[0], v0[1]); w.y = pk2(v0[2], v0[3]); w.z = pk2(v1[0], v1[1]); w.w = pk2(v1[2], v1[3]);
                    *(u32x4*)(rowp + bj * 128) = w;
                }
            }
    }
};
template <int MODE  > struct EpiF32 {
    static constexpr bool PERM = false, AFTER_DRAIN = false;
    const float* hin; float* out; bf16_t* hb; float* ssq;
    __device__ __forceinline__ void operator()(const f32x4 (&acc)[2][2][4][2], const Unit& u, int wr, int wc, int fr, int fq) const {
        const int row0 = u.pm * 256 + wr * 64 + fr, col0 = u.pn * 256 + wc * 32 + 4 * fq;
#pragma unroll
        for (int ai = 0; ai < 2; ++ai)
#pragma unroll
            for (int m = 0; m < 4; ++m) {
                const int row = row0 + ai * 128 + m * 16;
                const size_t ro = (size_t)row * 1024 + col0;
                float sq = 0.f, rs = 1.f;
                if (MODE == 4) rs = rsqrtf(ssq[row] * (1.f / 1024.f) + 1e-6f);
#pragma unroll
                for (int bj = 0; bj < 2; ++bj)
#pragma unroll
                    for (int n = 0; n < 2; ++n) {
                        const size_t off = ro + bj * 128 + n * 16;
                        const f32x4 a = acc[ai][bj][m][n];
                        if (MODE == 0) { *(f32x4*)(out + off) = *(const f32x4*)(hin + off) + a; }
                        else if (MODE == 1) { *(f32x4*)(out + off) = a; }
                        else if (MODE == 3) {
                            const f32x4 o = *(const f32x4*)(hin + off) + a; *(f32x4*)(out + off) = o;
                            sq += (o.x * o.x + o.y * o.y) + (o.z * o.z + o.w * o.w);
                            *(unsigned long long*)(hb + off) = (unsigned long long)pk2(o.x, o.y) | ((unsigned long long)pk2(o.z, o.w) << 32);
                        }
                        else { const f32x4 pp = *(const f32x4*)(hin + off); f32x4 hv = *(f32x4*)(out + off);
                               hv.x += sigm(a.x * rs) * pp.x; hv.y += sigm(a.y * rs) * pp.y; hv.z += sigm(a.z * rs) * pp.z; hv.w += sigm(a.w * rs) * pp.w; *(f32x4*)(out + off) = hv; }
                    }
                if (MODE == 3) { sq += __shfl_xor(sq, 16); sq += __shfl_xor(sq, 32); if (fq == 0) atomicAdd(ssq + row, sq); }
            }
    }
};

__device__ __forceinline__ float dpp_ror1(float x) { return __int_as_float(__builtin_amdgcn_update_dpp(0, __float_as_int(x), 0x121, 0xF, 0xF, true)); }
__device__ __forceinline__ float dpp_ror2(float x) { return __int_as_float(__builtin_amdgcn_update_dpp(0, __float_as_int(x), 0x122, 0xF, 0xF, true)); }
__device__ __forceinline__ unsigned long long pk4(float a, float b, float c, float d) { return (unsigned long long)pk2_sw(a, b) | ((unsigned long long)pk2_sw(c, d) << 32); }
struct EpiConv {
    static constexpr bool PERM = true, AFTER_DRAIN = false;
    bf16_t* act; bf16_t* hl; bf16_t* hf; const float* cw; const float* cb;
    __device__ __forceinline__ void operator()(const f32x4 (&acc)[2][2][4][2], const Unit& u, int wr, int wc, int fr, int fq) const {
        const int cg0 = 128 * u.pn + 32 * wc + 8 * fq;
#pragma unroll
        for (int n = 0; n < 2; ++n) {
            const int cg = cg0 + 4 * n;
            const f32x4 bg = *(const f32x4*)(cb + cg), bv = *(const f32x4*)(cb + 2816 + cg);
            const f32x4 g0 = *(const f32x4*)(cw + cg), g1 = *(const f32x4*)(cw + 5632 + cg), g2 = *(const f32x4*)(cw + 11264 + cg);
            const f32x4 v0 = *(const f32x4*)(cw + 2816 + cg), v1 = *(const f32x4*)(cw + 5632 + 2816 + cg), v2 = *(const f32x4*)(cw + 11264 + 2816 + cg);
#pragma unroll
            for (int ai = 0; ai < 2; ++ai) {
                const int rbase = 256 * u.pm + 128 * ai + 64 * wr, grp = rbase >> 6;
#pragma unroll
                for (int m = 0; m < 4; ++m) {
                    const f32x4 xg = acc[ai][0][m][n], xv = acc[ai][1][m][n];
                    const f32x4 yg = acc[ai][0][m > 0 ? m - 1 : 0][n], yv = acc[ai][1][m > 0 ? m - 1 : 0][n];
                    f32x4 gt, vl;
#pragma unroll
                    for (int e = 0; e < 4; ++e) {
                        const float u1 = dpp_ror1((fr == 15) ? yg[e] : xg[e]), u2 = dpp_ror2((fr >= 14) ? yg[e] : xg[e]);
                        gt[e] = bg[e] + g0[e] * u2 + g1[e] * u1 + g2[e] * xg[e];
                    }
#pragma unroll
                    for (int e = 0; e < 4; ++e) {
                        const float u1 = dpp_ror1((fr == 15) ? yv[e] : xv[e]), u2 = dpp_ror2((fr >= 14) ? yv[e] : xv[e]);
                        vl[e] = bv[e] + v0[e] * u2 + v1[e] * u1 + v2[e] * xv[e];
                    }
                    const size_t r = (size_t)(rbase + 16 * m + fr);
                    if (m > 0 || fr >= 2)
                        *(unsigned long long*)(act + r * 2816 + cg) = (unsigned long long)pk2(gt[0] * sigm(gt[0]) * vl[0], gt[1] * sigm(gt[1]) * vl[1]) | ((unsigned long long)pk2(gt[2] * sigm(gt[2]) * vl[2], gt[3] * sigm(gt[3]) * vl[3]) << 32);
                    if (m == 0 && fr < 2) {
                        bf16_t* d = hf + (size_t)(grp * 2 + fr) * 5632 + cg;
                        *(unsigned long long*)d = pk4(xg[0], xg[1], xg[2], xg[3]); *(unsigned long long*)(d + 2816) = pk4(xv[0], xv[1], xv[2], xv[3]);
                    }
                    if (m == 3 && fr >= 14) {
                        bf16_t* d = hl + (size_t)(grp * 2 + (fr - 14)) * 5632 + cg;
                        *(unsigned long long*)d = pk4(xg[0], xg[1], xg[2], xg[3]); *(unsigned long long*)(d + 2816) = pk4(xv[0], xv[1], xv[2], xv[3]);
                    }
                }
            }
        }
    }
};
__device__ __forceinline__ void conv_fixup(const Params& P, int layer, int tid) {
    const bf16_t* hl = (const bf16_t*)(P.ws + OFF_U); const bf16_t* hf = (const bf16_t*)(P.ws + OFF_U + 8 * MiB);
    bf16_t* ACT = (bf16_t*)(P.ws + OFF_ACT);
    const float* cw = P.in[I_CW] + (size_t)layer * 3 * 5632; const float* cb = P.in[I_CB] + (size_t)layer * 5632;
    for (int it = blockIdx.x * NTHREADS + tid; it < 256 * 2 * 352; it += gridDim.x * NTHREADS) {
        const int cgp = it % 352, rs = it / 352, j = rs >> 1, sidx = rs & 1, c = cgp * 8;
        u32x4 a2[2], a1[2], a0[2];
#pragma unroll
        for (int q = 0; q < 2; ++q) {
            const int off = q * 2816 + c;
            const u32x4 z = (u32x4){0u, 0u, 0u, 0u};
            const u32x4 l0 = (j > 0) ? *(const u32x4*)(hl + (size_t)((j - 1) * 2 + 0) * 5632 + off) : z;
            const u32x4 l1 = (j > 0) ? *(const u32x4*)(hl + (size_t)((j - 1) * 2 + 1) * 5632 + off) : z;
            const u32x4 f0 = *(const u32x4*)(hf + (size_t)(j * 2 + 0) * 5632 + off), f1 = *(const u32x4*)(hf + (size_t)(j * 2 + 1) * 5632 + off);
            if (sidx == 0) { a2[q] = l0; a1[q] = l1; a0[q] = f0; } else { a2[q] = l1; a1[q] = f0; a0[q] = f1; }
        }
        float res[8];
#pragma unroll
        for (int q = 0; q < 4; ++q) {
#pragma unroll
            for (int hh = 0; hh < 2; ++hh) {
                const int cc = c + 2 * q + hh;
                const float ug2 = hh ? bfhi(a2[0][q]) : bflo(a2[0][q]), ug1 = hh ? bfhi(a1[0][q]) : bflo(a1[0][q]), ug0 = hh ? bfhi(a0[0][q]) : bflo(a0[0][q]);
                const float uv2 = hh ? bfhi(a2[1][q]) : bflo(a2[1][q]), uv1 = hh ? bfhi(a1[1][q]) : bflo(a1[1][q]), uv0 = hh ? bfhi(a0[1][q]) : bflo(a0[1][q]);
                const float gt = cb[cc] + cw[cc] * ug2 + cw[5632 + cc] * ug1 + cw[11264 + cc] * ug0;
                const float vl = cb[2816 + cc] + cw[2816 + cc] * uv2 + cw[5632 + 2816 + cc] * uv1 + cw[11264 + 2816 + cc] * uv0;
                res[2 * q + hh] = gt * sigm(gt) * vl;
            }
        }
        u32x4 o; o.x = pk2(res[0], res[1]); o.y = pk2(res[2], res[3]); o.z = pk2(res[4], res[5]); o.w = pk2(res[6], res[7]);
        *(u32x4*)(ACT + (size_t)(64 * j + sidx) * 2816 + c) = o;
    }
}

template <class Epi> __device__ __forceinline__ void run_gemm(unsigned char* smem, const bf16_t* A, const bf16_t* Bt, int M, int N, int K, const Epi& E) {
    pg8::Gemm g; g.A = A; g.Bt = Bt; g.M = M; g.N = N; g.K = K;
    pg8::StaticOrder So; So.init(M, N, (int)gridDim.x, (int)blockIdx.x);
    pg8::gemm_phase<Epi, pg8::StaticOrder, false>((PG8_LAS unsigned char*)smem, g, So, E, nullptr);
}

constexpr int CMS = 1028;
__device__ __forceinline__ pg8::bf16x8 lds_f32x8_to_bf16(const float* p) {
    const f32x4 a = *(const f32x4*)p, b = *(const f32x4*)(p + 4);
    u32x4 w; w.x = pk2(a.x, a.y); w.y = pk2(a.z, a.w); w.z = pk2(b.x, b.y); w.w = pk2(b.z, b.w);
    return __builtin_bit_cast(pg8::bf16x8, w);
}
__device__ __forceinline__ void rwkv_prep(const Params& P, int layer, unsigned char* smem, int tid) {
    using pg8::bf16x8;
    float* cmL = (float*)smem;
    float* loraL = cmL + 16 * CMS;
    float* uL = loraL + 16 * 768;
    const bf16_t* ZC = (const bf16_t*)(P.ws + OFF_ZC);
    const bf16_t* WT = (const bf16_t*)(P.ws + OFF_WT);
    h16* VF = (h16*)(P.ws + OFF_VF);
    h16* RK = (h16*)(P.ws + OFF_RK);
    const float* mu = P.in[I_MU] + layer * 1024;
    const int j = tid & 255, th = tid >> 8, tb = th * 8;
    const int w = tid >> 6, lane = tid & 63, lr = lane & 15, lq = lane >> 4;
    const float w0j = P.in[I_W0][layer * 256 + j], a0j = P.in[I_A0][layer * 256 + j], kkj = P.in[I_KK][layer * 256 + j], kaj = P.in[I_KA][layer * 256 + j];
    const float v0j = (layer > 0) ? P.in[I_V0][j] : 0.f;
    float v2c[32];
#pragma unroll
    for (int m = 0; m < 32; ++m) v2c[m] = (layer > 0) ? P.in[I_V2][m * 256 + j] : 0.f;
    const int c2 = tid * 2;
    const float mu0 = mu[c2], mu1 = mu[c2 + 1];
    for (int tile = blockIdx.x; tile < S_ / 16; tile += gridDim.x) {
        const int t0 = tile * 16;
        __syncthreads();
        {
            unsigned cu[17];
            cu[0] = (t0 > 0) ? *(const unsigned*)(ZC + (size_t)(t0 - 1) * 1024 + c2) : 0u;
#pragma unroll
            for (int i = 0; i < 16; ++i) cu[i + 1] = *(const unsigned*)(ZC + (size_t)(t0 + i) * 1024 + c2);
#pragma unroll
            for (int i = 0; i < 16; ++i) {
                const float p0 = bflo(cu[i]), p1 = bfhi(cu[i]), c0 = bflo(cu[i + 1]), c1 = bfhi(cu[i + 1]);
                float m0 = c0 + (p0 - c0) * mu0, m1 = c1 + (p1 - c1) * mu1;
                if (c2 >= 768 && c2 < 832) { m0 = tanhf(m0); m1 = tanhf(m1); }
                else if (c2 >= 896) { m0 = sigm(m0); m1 = sigm(m1); }
                f32x2v mm; mm.x = m0; mm.y = m1;
                *(f32x2v*)(cmL + i * CMS + c2) = mm;
            }
        }
        __syncthreads();
        {
#pragma unroll 2
            for (int i = 0; i < 6; ++i) {
                const int nt = 6 * w + i, seg = nt >> 4, n0 = (nt & 15) * 16;
                const int cmoff = (seg == 0) ? 768 : (seg == 1 ? 832 : 896);
                f32x4 acc = (f32x4){0.f, 0.f, 0.f, 0.f};
                if (seg == 2) {
                    const bf16_t* Wp = WT + WT_G2 + (size_t)(n0 + lr) * 128 + 8 * lq;
                    bf16x8 bq[4];
#pragma unroll
                    for (int ks = 0; ks < 4; ++ks) bq[ks] = *(const bf16x8*)(Wp + 32 * ks);
#pragma unroll
                    for (int ks = 0; ks < 4; ++ks) acc = __builtin_amdgcn_mfma_f32_16x16x32_bf16(lds_f32x8_to_bf16(cmL + lr * CMS + cmoff + 32 * ks + 8 * lq), bq[ks], acc, 0, 0, 0);
                } else {
                    const bf16_t* Wp = WT + ((seg == 0) ? WT_W2 : WT_A2) + (size_t)(n0 + lr) * 64 + 8 * lq;
                    bf16x8 bq[2];
#pragma unroll
                    for (int ks = 0; ks < 2; ++ks) bq[ks] = *(const bf16x8*)(Wp + 32 * ks);
#pragma unroll
                    for (int ks = 0; ks < 2; ++ks) acc = __builtin_amdgcn_mfma_f32_16x16x32_bf16(lds_f32x8_to_bf16(cmL + lr * CMS + cmoff + 32 * ks + 8 * lq), bq[ks], acc, 0, 0, 0);
                }
#pragma unroll
                for (int e = 0; e < 4; ++e) loraL[(4 * lq + e) * 768 + seg * 256 + n0 + lr] = acc[e];
            }
            if (layer > 0 && w < 2) {
                f32x4 acc = (f32x4){0.f, 0.f, 0.f, 0.f};
                const bf16_t* Vp = WT + WT_V1 + (size_t)(16 * w + lr) * 256 + 8 * lq;
#pragma unroll
                for (int ks = 0; ks < 8; ++ks) {
                    const bf16x8 b = *(const bf16x8*)(Vp + 32 * ks);
                    const bf16x8 a = lds_f32x8_to_bf16(cmL + lr * CMS + 512 + 32 * ks + 8 * lq);
                    acc = __builtin_amdgcn_mfma_f32_16x16x32_bf16(a, b, acc, 0, 0, 0);
                }
#pragma unroll
                for (int e = 0; e < 4; ++e) uL[(4 * lq + e) * 32 + 16 * w + lr] = acc[e];
            }
        }
        __syncthreads();
#pragma unroll
        for (int tt = 0; tt < 8; ++tt) {
            const int t = t0 + tb + tt; const float* cr = cmL + (tb + tt) * CMS; const float* lo = loraL + (tb + tt) * 768;
            const float r = cr[j], k = cr[256 + j]; float v = cr[512 + j];
            const float x = -(w0j + lo[j]);
            const float sp = fmaxf(x, 0.f) + log1pf(__expf(-fabsf(x)));
            const float e = __expf(-sp - 0.5f);
            const float a = sigm(a0j + lo[256 + j]);
            const float g = lo[512 + j];
            if (layer == 0) { VF[(size_t)t * 256 + j] = (h16)v; }
            else {
                float acc = v0j;
#pragma unroll
                for (int m = 0; m < 32; ++m) acc += uL[(tb + tt) * 32 + m] * v2c[m];
                const float vf = (float)VF[(size_t)t * 256 + j];
                v = v + (vf - v) * sigm(acc);
            }
            float kk = k * kkj; const float ss = wave_sum(kk * kk); kk = kk / fmaxf(sqrtf(ss), 1e-12f);
            const float k2 = k * (1.f + (a - 1.f) * kaj);
            const size_t o = (size_t)t * 256 + j;
            RK[0 * RKSZ + o] = (h16)r; RK[1 * RKSZ + o] = (h16)k2; RK[2 * RKSZ + o] = (h16)v; RK[3 * RKSZ + o] = (h16)kk;
            RK[4 * RKSZ + o] = (h16)(kk * a); RK[5 * RKSZ + o] = (h16)e; RK[6 * RKSZ + o] = (h16)g;
        }
    }
}

constexpr int AT_VS = 280;
__device__ __forceinline__ void attn_partial(const Params& P, unsigned char* smem, int tid) {
    using pg8::bf16x8;
    const bf16_t* ZB = (const bf16_t*)(P.ws + OFF_ZB);
    bf16_t* MIX = (bf16_t*)(P.ws + OFF_HN);
    float* LSE = (float*)(P.ws + OFF_LSE);
    bf16_t* Vt = (bf16_t*)smem;
    const int w = tid >> 6, lane = tid & 63, lr = lane & 15, lq = lane >> 4;
    const bool xord = (gridDim.x == 256);
    for (int it0 = xord ? 0 : (int)blockIdx.x; it0 < (xord ? 6 : 1536); it0 += xord ? 1 : (int)gridDim.x) {
        const int item = xord ? ((int)(blockIdx.x & 7) * 192 + (int)(blockIdx.x >> 3) + 32 * it0) : it0;
        const int p = item >> 9, rem = item & 511, h = rem & 3, rest = rem >> 2;
        const int d = (p == 0) ? 1 : (p == 1 ? 4 : 16);
        const int nqb = 128 / d, r = rest / nqb, qb = rest % nqb;
        const int L0 = qb * 128, l0 = L0 + 16 * w;
        __syncthreads();
        {
            const int kl = tid & 255, hf = tid >> 8, kidx = L0 - 128 + kl;
            u32x4 x[4];
            if (kidx >= 0) {
                const u32x4* src = (const u32x4*)(ZB + (size_t)(kidx * d + r) * 768 + 512 + h * 64 + 32 * hf);
#pragma unroll
                for (int c = 0; c < 4; ++c) x[c] = src[c];
            } else {
#pragma unroll
                for (int c = 0; c < 4; ++c) x[c] = (u32x4){0u, 0u, 0u, 0u};
            }
#pragma unroll
            for (int c = 0; c < 4; ++c)
#pragma unroll
                for (int e = 0; e < 4; ++e) {
                    const unsigned u = x[c][e];
                    Vt[(32 * hf + 8 * c + 2 * e) * AT_VS + kl] = (bf16_t)(u & 0xffffu);
                    Vt[(32 * hf + 8 * c + 2 * e + 1) * AT_VS + kl] = (bf16_t)(u >> 16);
                }
            *(unsigned*)(Vt + (tid >> 3) * AT_VS + 256 + (tid & 7) * 2) = 0u;
        }
        __syncthreads();
        const size_t qtok = (size_t)((l0 + lr) * d + r);
        bf16x8 qf[2];
#pragma unroll
        for (int ks = 0; ks < 2; ++ks) qf[ks] = *(const bf16x8*)(ZB + qtok * 768 + h * 64 + 32 * ks + 8 * lq);
        f32x4 sc[9];
#pragma unroll
        for (int kt = 0; kt < 9; ++kt) {
            const int kbase = l0 - 128 + 16 * kt;
            sc[kt] = (f32x4){0.f, 0.f, 0.f, 0.f};
            if (kbase >= 0) {
                const bf16_t* kp = ZB + (size_t)((kbase + lr) * d + r) * 768 + 256 + h * 64 + 8 * lq;
                const bf16x8 a0 = *(const bf16x8*)kp, a1 = *(const bf16x8*)(kp + 32);
                sc[kt] = __builtin_amdgcn_mfma_f32_16x16x32_bf16(a0, qf[0], sc[kt], 0, 0, 0);
                sc[kt] = __builtin_amdgcn_mfma_f32_16x16x32_bf16(a1, qf[1], sc[kt], 0, 0, 0);
            }
        }
        const int qidx = l0 + lr;
        float m = -1e30f;
#pragma unroll
        for (int kt = 0; kt < 9; ++kt)
#pragma unroll
            for (int e = 0; e < 4; ++e) {
                const int kidx = l0 - 128 + 16 * kt + 4 * lq + e;
                const bool valid = (kidx >= 0) && (kidx <= qidx) && (kidx >= qidx - 128);
                const float sv = valid ? sc[kt][e] * 0.125f : -1e30f;
                sc[kt][e] = sv; m = fmaxf(m, sv);
            }
        m = fmaxf(m, __shfl_xor(m, 16)); m = fmaxf(m, __shfl_xor(m, 32));
        float sum = 0.f;
#pragma unroll
        for (int kt = 0; kt < 9; ++kt)
#pragma unroll
            for (int e = 0; e < 4; ++e) {
                const float sv = sc[kt][e];
                const float pv = (sv > -1e29f) ? __expf(sv - m) : 0.f;
                sc[kt][e] = pv; sum += pv;
            }
        sum += __shfl_xor(sum, 16); sum += __shfl_xor(sum, 32);
        f32x4 acc[4];
#pragma unroll
        for (int n = 0; n < 4; ++n) acc[n] = (f32x4){0.f, 0.f, 0.f, 0.f};
#pragma unroll
        for (int s5 = 0; s5 < 5; ++s5) {
            u32x4 pw;
            pw.x = pk2(sc[2 * s5][0], sc[2 * s5][1]); pw.y = pk2(sc[2 * s5][2], sc[2 * s5][3]);
            if (s5 < 4) { pw.z = pk2(sc[2 * s5 + 1][0], sc[2 * s5 + 1][1]); pw.w = pk2(sc[2 * s5 + 1][2], sc[2 * s5 + 1][3]); } else { pw.z = 0u; pw.w = 0u; }
            const bf16x8 pf = __builtin_bit_cast(bf16x8, pw);
#pragma unroll
            for (int n = 0; n < 4; ++n) {
                const bf16_t* vp = Vt + (16 * n + lr) * AT_VS + 16 * w + 32 * s5 + 4 * lq;
                const f32x2v lo = *(const f32x2v*)vp, hi = *(const f32x2v*)(vp + 16);
                f32x4 vv; vv.x = lo.x; vv.y = lo.y; vv.z = hi.x; vv.w = hi.y;
                const bf16x8 vf = __builtin_bit_cast(bf16x8, vv);
                acc[n] = __builtin_amdgcn_mfma_f32_16x16x32_bf16(vf, pf, acc[n], 0, 0, 0);
            }
        }
        const float inv = 1.f / sum;
        const int slot = ((p == 0) ? 0 : (p == 1 ? 256 : 768)) + h * 64;
        bf16_t* orow = MIX + qtok * 1024 + slot + 4 * lq;
#pragma unroll
        for (int n = 0; n < 4; ++n) {
            const unsigned long long o8 = (unsigned long long)pk2(acc[n][0] * inv, acc[n][1] * inv) | ((unsigned long long)pk2(acc[n][2] * inv, acc[n][3] * inv) << 32);
            *(unsigned long long*)(orow + 16 * n) = o8;
        }
        if (lq == 0) LSE[((size_t)p * S_ + qtok) * 4 + h] = m + __logf(sum);
    }
}

__device__ __forceinline__ void attn_combine(const Params& P, int tid) {
    bf16_t* MIX = (bf16_t*)(P.ws + OFF_HN);
    const float* LSE = (const float*)(P.ws + OFF_LSE);
    const int total = S_ * 4 * 8;
    for (int it = blockIdx.x * NTHREADS + tid; it < total; it += gridDim.x * NTHREADS) {
        const int c8 = it & 7, h = (it >> 3) & 3, t = it >> 5;
        const float l0 = LSE[((size_t)0 * S_ + t) * 4 + h], l1 = LSE[((size_t)1 * S_ + t) * 4 + h], l2 = LSE[((size_t)2 * S_ + t) * 4 + h];
        const float mx = fmaxf(l0, fmaxf(l1, l2));
        float w0 = __expf(l0 - mx), w1 = __expf(l1 - mx), w2 = __expf(l2 - mx);
        const float inv = 1.f / (w0 + w1 + w2); w0 *= inv; w1 *= inv; w2 *= inv;
        const size_t rb = (size_t)t * 1024 + h * 64 + c8 * 8;
        const u32x4 a = *(const u32x4*)(MIX + rb), b = *(const u32x4*)(MIX + rb + 256), c = *(const u32x4*)(MIX + rb + 768);
        u32x4 o;
        o.x = pk2(w0 * bflo(a.x) + w1 * bflo(b.x) + w2 * bflo(c.x), w0 * bfhi(a.x) + w1 * bfhi(b.x) + w2 * bfhi(c.x));
        o.y = pk2(w0 * bflo(a.y) + w1 * bflo(b.y) + w2 * bflo(c.y), w0 * bfhi(a.y) + w1 * bfhi(b.y) + w2 * bfhi(c.y));
        o.z = pk2(w0 * bflo(a.z) + w1 * bflo(b.z) + w2 * bflo(c.z), w0 * bfhi(a.z) + w1 * bfhi(b.z) + w2 * bfhi(c.z));
        o.w = pk2(w0 * bflo(a.w) + w1 * bflo(b.w) + w2 * bflo(c.w), w0 * bfhi(a.w) + w1 * bfhi(b.w) + w2 * bfhi(c.w));
        *(u32x4*)(MIX + rb + 512) = o;
    }
}

__device__ __forceinline__ float hgrn_lb(const Params& P, int layer, int idx) {
    if (layer == 0) return 0.f;
    return sigm(P.in[I_LB][512 + idx] - P.in[I_LB][idx]);
}

__device__ __forceinline__ void hgrn_pass1(const Params& P, int layer, unsigned char* smem, int tid) {
    using pg8::bf16x8;
    bf16_t* Vt = (bf16_t*)smem;
    bf16_t* KhT = Vt + 128 * 72;
    float* tot = (float*)(KhT + 128 * 72);
    bf16_t* Rf = (bf16_t*)(tot + 512);
    bf16_t* Ri = Rf + 64 * 128;
    const bf16_t* ZH = (const bf16_t*)(P.ws + OFF_ZH);
    bf16_t* NC = (bf16_t*)(P.ws + OFF_ZC);
    float* GB = (float*)(P.ws + OFF_GB);
    const int k = tid & 127, qd = tid >> 7;
    const int w = tid >> 6, lane = tid & 63, lr = lane & 15, lq = lane >> 4;
    for (int item = blockIdx.x; item < 1024; item += gridDim.x) {
        const int c = item >> 2, h = item & 3, t0 = c * 64;
        const float lbv = hgrn_lb(P, layer, h * 128 + k);
        __syncthreads();
        {
            u32x4 rv[4];
#pragma unroll
            for (int e = 0; e < 4; ++e) { const int ch = tid + 512 * (e & 1), row = ch >> 4, c8 = (ch & 15) * 8;
                rv[e] = *(const u32x4*)(ZH + (size_t)(t0 + row) * 2048 + ((e < 2) ? 512 : 1024) + h * 128 + c8); }
#pragma unroll
            for (int e = 0; e < 4; ++e) { const int ch = tid + 512 * (e & 1), row = ch >> 4, c8 = (ch & 15) * 8;
                *(u32x4*)(((e < 2) ? Rf : Ri) + row * 128 + c8) = rv[e]; }
        }
        __syncthreads();
        float fl[16], bl[16]; float run = 0.f;
#pragma unroll
        for (int i = 0; i < 16; ++i) {
            const float fr = bf2f(Rf[(16 * qd + i) * 128 + k]);
            const float f = lbv + (1.f - lbv) * sigm(fr);
            fl[i] = f; run += __logf(f); bl[i] = run;
            Vt[k * 72 + 16 * qd + i] = Ri[(16 * qd + i) * 128 + k];
        }
        tot[qd * 128 + k] = run;
        __syncthreads();
        float pre = 0.f, all = 0.f;
#pragma unroll
        for (int q = 0; q < 4; ++q) { const float x = tot[q * 128 + k]; if (q < qd) pre += x; all += x; }
        {
            float kh[16];
#pragma unroll
            for (int i = 0; i < 16; ++i) kh[i] = (1.f - fl[i]) * __expf(all - (pre + bl[i]));
            u32x4 w0, w1;
            w0.x = pk2(kh[0], kh[1]); w0.y = pk2(kh[2], kh[3]); w0.z = pk2(kh[4], kh[5]); w0.w = pk2(kh[6], kh[7]);
            w1.x = pk2(kh[8], kh[9]); w1.y = pk2(kh[10], kh[11]); w1.z = pk2(kh[12], kh[13]); w1.w = pk2(kh[14], kh[15]);
            *(u32x4*)(KhT + k * 72 + 16 * qd) = w0; *(u32x4*)(KhT + k * 72 + 16 * qd + 8) = w1;
        }
        if (qd == 0) GB[(size_t)(c * 4 + h) * 128 + k] = __expf(all);
        __syncthreads();
        bf16x8 af[2];
#pragma unroll
        for (int ks = 0; ks < 2; ++ks) af[ks] = *(const bf16x8*)(KhT + (16 * w + lr) * 72 + 32 * ks + 8 * lq);
#pragma unroll
        for (int vt = 0; vt < 8; ++vt) {
            f32x4 acc = (f32x4){0.f, 0.f, 0.f, 0.f};
#pragma unroll
            for (int ks = 0; ks < 2; ++ks) {
                const bf16x8 b = *(const bf16x8*)(Vt + (16 * vt + lr) * 72 + 32 * ks + 8 * lq);
                acc = __builtin_amdgcn_mfma_f32_16x16x32_bf16(af[ks], b, acc, 0, 0, 0);
            }
            *(unsigned long long*)(NC + ((size_t)(c * 4 + h) * 128 + 16 * vt + lr) * 128 + 16 * w + 4 * lq) = (unsigned long long)pk2_sw(acc[0], acc[1]) | ((unsigned long long)pk2_sw(acc[2], acc[3]) << 32);
        }
    }
}

__device__ __forceinline__ void hgrn_scan(const Params& P, int tid) {
    bf16_t* NC = (bf16_t*)(P.ws + OFF_ZC);
    const float* GB = (const float*)(P.ws + OFF_GB);
    if (tid >= 128) return;
    for (int e = blockIdx.x * 128 + tid; e < 32768; e += gridDim.x * 128) {
        const int h = e >> 13, vr = (e >> 6) & 127, k2 = e & 63;
        float s0 = 0.f, s1 = 0.f;
        for (int c0 = 0; c0 < 256; c0 += 32) {
            unsigned n[32]; f32x2v g[32];
#pragma unroll
            for (int u = 0; u < 32; ++u) {
                n[u] = *(const unsigned*)(NC + ((size_t)((c0 + u) * 4 + h) * 128 + vr) * 128 + 2 * k2);
                g[u] = *(const f32x2v*)(GB + (size_t)((c0 + u) * 4 + h) * 128 + 2 * k2);
            }
#pragma unroll
            for (int u = 0; u < 32; ++u) {
                *(unsigned*)(NC + ((size_t)((c0 + u) * 4 + h) * 128 + vr) * 128 + 2 * k2) = pk2(s0, s1);
                s0 = g[u].x * s0 + bflo(n[u]); s1 = g[u].y * s1 + bfhi(n[u]);
            }
        }
    }
}

constexpr int H3_QS = 136, H3_VS = 72;
__device__ __forceinline__ void hgrn_pass3_item(const Params& P, int layer, unsigned char* smem, int tid, int item) {
    using pg8::bf16x8;
    bf16_t* Qt = (bf16_t*)smem;
    bf16_t* Kt = Qt + 64 * H3_QS;
    bf16_t* Qh = Kt + 64 * H3_QS;
    bf16_t* Vt = Qh + 64 * H3_QS;
    float* tot = (float*)(Vt + 128 * H3_VS);
    float* ssq = tot + 512;
    bf16_t* Rq = (bf16_t*)(ssq + 128);
    const bf16_t* ZH = (const bf16_t*)(P.ws + OFF_ZH);
    const bf16_t* NC = (const bf16_t*)(P.ws + OFF_ZC);
    bf16_t* MIX = (bf16_t*)(P.ws + OFF_HN);
    const int c = item >> 2, h = item & 3, t0 = c * 64;
    const int w3 = tid >> 6, lr3 = tid & 15, lq3 = (tid & 63) >> 4;
    bf16x8 sfr[4][4]; unsigned long long graw[4];
    {
        const int k = tid & 127, qd = tid >> 7;
        const float lbv = hgrn_lb(P, layer, h * 128 + k);
        __syncthreads();
        {
            u32x4 rv[6];
#pragma unroll
            for (int e = 0; e < 6; ++e) { const int ch = tid + 512 * (e & 1), row = ch >> 4, c8 = (ch & 15) * 8;
                rv[e] = *(const u32x4*)(ZH + (size_t)(t0 + row) * 2048 + 512 * (e >> 1) + h * 128 + c8); }
#pragma unroll
            for (int e = 0; e < 6; ++e) { const int ch = tid + 512 * (e & 1), row = ch >> 4, c8 = (ch & 15) * 8;
                *(u32x4*)(Rq + (e >> 1) * (64 * 128) + row * 128 + c8) = rv[e]; }
        }
        __syncthreads();
        const bf16_t* Rf = Rq + 64 * 128; const bf16_t* Ri = Rf + 64 * 128;
        float fl[16], bl[16], qv[16]; float run = 0.f;
#pragma unroll
        for (int i = 0; i < 16; ++i) {
            const float qr = bf2f(Rq[(16 * qd + i) * 128 + k]);
            const float fr = bf2f(Rf[(16 * qd + i) * 128 + k]);
            const float f = lbv + (1.f - lbv) * sigm(fr);
            fl[i] = f; run += __logf(f); bl[i] = run; qv[i] = qr * sigm(qr);
            Vt[k * H3_VS + 16 * qd + i] = Ri[(16 * qd + i) * 128 + k];
        }
        tot[qd * 128 + k] = run;
        __syncthreads();
        float pre = 0.f;
#pragma unroll
        for (int q = 0; q < 4; ++q) { const float x = tot[q * 128 + k]; if (q < qd) pre += x; }
        const float rho = tot[k] + tot[128 + k];
#pragma unroll
        for (int i = 0; i < 16; ++i) {
            const float b = pre + bl[i]; const int row = 16 * qd + i;
            Qt[row * H3_QS + k] = f2bf(qv[i] * __expf(b - rho));
            Kt[row * H3_QS + k] = f2bf((1.f - fl[i]) * __expf(rho - b));
            Qh[row * H3_QS + k] = f2bf(qv[i] * __expf(b));
        }
#pragma unroll
        for (int vt = 0; vt < 4; ++vt) {
            const bf16_t* Sr = NC + ((size_t)(c * 4 + h) * 128 + 64 * (w3 >> 2) + 16 * vt + lr3) * 128 + 8 * lq3;
#pragma unroll
            for (int ks = 0; ks < 4; ++ks) sfr[vt][ks] = *(const bf16x8*)(Sr + 32 * ks);
            graw[vt] = *(const unsigned long long*)(ZH + (size_t)(t0 + 16 * (w3 & 3) + lr3) * 2048 + 1536 + h * 128 + 64 * (w3 >> 2) + 16 * vt + 4 * lq3);
        }
        __syncthreads();
    }
    const int w = tid >> 6, lane = tid & 63, lr = lane & 15, lq = lane >> 4, ti = w & 3, vh = w >> 2;
    f32x4 sc[4];
#pragma unroll
    for (int jt = 0; jt < 4; ++jt) {
        sc[jt] = (f32x4){0.f, 0.f, 0.f, 0.f};
        if (jt <= ti) {
#pragma unroll
            for (int ks = 0; ks < 4; ++ks) {
                const bf16x8 a = *(const bf16x8*)(Kt + (16 * jt + lr) * H3_QS + 32 * ks + 8 * lq);
                const bf16x8 b = *(const bf16x8*)(Qt + (16 * ti + lr) * H3_QS + 32 * ks + 8 * lq);
                sc[jt] = __builtin_amdgcn_mfma_f32_16x16x32_bf16(a, b, sc[jt], 0, 0, 0);
            }
            if (jt == ti) {
#pragma unroll
                for (int e = 0; e < 4; ++e) if (4 * lq + e > lr) sc[jt][e] = 0.f;
            }
        }
    }
    bf16x8 pf[2];
#pragma unroll
    for (int s2 = 0; s2 < 2; ++s2) {
        u32x4 pw; pw.x = pk2_sw(sc[2 * s2][0], sc[2 * s2][1]); pw.y = pk2_sw(sc[2 * s2][2], sc[2 * s2][3]); pw.z = pk2_sw(sc[2 * s2 + 1][0], sc[2 * s2 + 1][1]); pw.w = pk2_sw(sc[2 * s2 + 1][2], sc[2 * s2 + 1][3]);
        pf[s2] = __builtin_bit_cast(bf16x8, pw);
    }
    bf16x8 qh[4];
#pragma unroll
    for (int ks = 0; ks < 4; ++ks) qh[ks] = *(const bf16x8*)(Qh + (16 * ti + lr) * H3_QS + 32 * ks + 8 * lq);
    f32x4 acc[4]; float ss = 0.f;
#pragma unroll
    for (int vt = 0; vt < 4; ++vt) {
        const int v0 = 64 * vh + 16 * vt;
        acc[vt] = (f32x4){0.f, 0.f, 0.f, 0.f};
#pragma unroll
        for (int ks = 0; ks < 4; ++ks) acc[vt] = __builtin_amdgcn_mfma_f32_16x16x32_bf16(sfr[vt][ks], qh[ks], acc[vt], 0, 0, 0);
#pragma unroll
        for (int s2 = 0; s2 < 2; ++s2) {
            const bf16_t* vp = Vt + (v0 + lr) * H3_VS + 32 * s2 + 4 * lq;
            const f32x2v lo = *(const f32x2v*)vp, hi = *(const f32x2v*)(vp + 16);
            f32x4 vv; vv.x = lo.x; vv.y = lo.y; vv.z = hi.x; vv.w = hi.y;
            acc[vt] = __builtin_amdgcn_mfma_f32_16x16x32_bf16(__builtin_bit_cast(bf16x8, vv), pf[s2], acc[vt], 0, 0, 0);
        }
        ss += (acc[vt][0] * acc[vt][0] + acc[vt][1] * acc[vt][1]) + (acc[vt][2] * acc[vt][2] + acc[vt][3] * acc[vt][3]);
    }
    ss += __shfl_xor(ss, 16); ss += __shfl_xor(ss, 32);
    if (lq == 0) ssq[vh * 64 + 16 * ti + lr] = ss;
    __syncthreads();
    const float rinv = rsqrtf((ssq[16 * ti + lr] + ssq[64 + 16 * ti + lr]) * (1.f / 128.f) + 1e-6f);
    const size_t t = (size_t)(t0 + 16 * ti + lr);
#pragma unroll
    for (int vt = 0; vt < 4; ++vt) {
        const int v = 64 * vh + 16 * vt + 4 * lq;
        const f32x4 gn = *(const f32x4*)(P.in[I_GN] + layer * 512 + h * 128 + v);
        const unsigned long long gr8 = graw[vt];
        const float g0 = bflo((unsigned)gr8), g1 = bfhi((unsigned)gr8), g2 = bflo((unsigned)(gr8 >> 32)), g3 = bfhi((unsigned)(gr8 >> 32));
        const float o0 = acc[vt][0] * rinv * gn.x * g0 * sigm(g0), o1 = acc[vt][1] * rinv * gn.y * g1 * sigm(g1);
        const float o2 = acc[vt][2] * rinv * gn.z * g2 * sigm(g2), o3 = acc[vt][3] * rinv * gn.w * g3 * sigm(g3);
        *(unsigned long long*)(MIX + t * 1024 + h * 128 + v) = (unsigned long long)pk2(o0, o1) | ((unsigned long long)pk2(o2, o3) << 32);
    }
}

__device__ __forceinline__ float dpp_f(float x, const int ctrl_sel) {
    const int xi = __float_as_int(x); int r;
    if (ctrl_sel == 0) r = __builtin_amdgcn_update_dpp(0, xi, 0xB1, 0xF, 0xF, true);
    else if (ctrl_sel == 1) r = __builtin_amdgcn_update_dpp(0, xi, 0x4E, 0xF, 0xF, true);
    else if (ctrl_sel == 2) r = __builtin_amdgcn_update_dpp(0, xi, 0x141, 0xF, 0xF, true);
    else r = __builtin_amdgcn_update_dpp(0, xi, 0x140, 0xF, 0xF, true);
    return __int_as_float(r);
}
__device__ __forceinline__ float sum16(float x) { x += dpp_f(x, 0); x += dpp_f(x, 1); x += dpp_f(x, 2); x += dpp_f(x, 3); return x; }

constexpr int RS_T = 32;
constexpr int RS_BUF = 5 * RS_T * 64 + RS_T * 32;
constexpr int RS_G = 32, RS_LS = S_ / RS_G, RS_CPS = RS_LS / RS_T;
__device__ __forceinline__ void rwkv_scan_load(const h16* RK, float* buf, int ch, int h, int vrg, int lt) {
    const int tok = lt >> 3, col = (lt & 7) * 8; const size_t t = (size_t)ch * RS_T + tok;
    const size_t go = t * 256 + h * 64 + col;
    const h16x8 hv0 = *(const h16x8*)(RK + (size_t)5 * RKSZ + go);
    const h16x8 hv1 = *(const h16x8*)(RK + (size_t)3 * RKSZ + go);
    const h16x8 hv2 = *(const h16x8*)(RK + (size_t)4 * RKSZ + go);
    const h16x8 hv3 = *(const h16x8*)(RK + (size_t)1 * RKSZ + go);
    const h16x8 hv4 = *(const h16x8*)(RK + (size_t)0 * RKSZ + go);
    h16x4 vh; vh[0] = (h16)0.f; vh[1] = (h16)0.f; vh[2] = (h16)0.f; vh[3] = (h16)0.f;
    if (vrg >= 0) vh = *(const h16x4*)(RK + (size_t)2 * RKSZ + t * 256 + h * 64 + 32 * vrg + 4 * (lt & 7));
    const h16x8 hvs[5] = {hv0, hv1, hv2, hv3, hv4};
#pragma unroll
    for (int a = 0; a < 5; ++a) {
        const h16x8 hv = hvs[a];
        f32x4 lo, hi;
        lo.x = (float)hv[0]; lo.y = (float)hv[1]; lo.z = (float)hv[2]; lo.w = (float)hv[3]; hi.x = (float)hv[4]; hi.y = (float)hv[5]; hi.z = (float)hv[6]; hi.w = (float)hv[7];
        if (a == 0) { lo.x = __expf(-lo.x); lo.y = __expf(-lo.y); lo.z = __expf(-lo.z); lo.w = __expf(-lo.w); hi.x = __expf(-hi.x); hi.y = __expf(-hi.y); hi.z = __expf(-hi.z); hi.w = __expf(-hi.w); }
        float* d = buf + a * (RS_T * 64) + tok * 64 + col;
        *(f32x4*)d = lo; *(f32x4*)(d + 4) = hi;
    }
    f32x4 vf; vf.x = (float)vh[0]; vf.y = (float)vh[1]; vf.z = (float)vh[2]; vf.w = (float)vh[3];
    *(f32x4*)(buf + 5 * RS_T * 64 + tok * 32 + 4 * (lt & 7)) = vf;
}
template <bool PASS_A> __device__ __forceinline__ void rwkv_seg_job(const Params& P, unsigned char* smem, int tid, int g, int h, int rgx, bool chain_only = false) {
    float* L = (float*)smem;
    float* srow = L + 2 * RS_BUF;
    const h16* RK = (const h16*)(P.ws + OFF_RK);
    float* LX = (float*)(P.ws + OFF_LX);
    bf16_t* MIX = (bf16_t*)(P.ws + OFF_HN);
    const int w = tid >> 6, lane = tid & 63;
    const int row = 8 * (w & 3) + 2 * (lane >> 4), ks = lane & 15;
    const bool ident = PASS_A && (rgx >= 2);
    const int vrg = ident ? -1 : rgx;
    const int ch0 = g * RS_CPS;
    __syncthreads();
    f32x4 sA = (f32x4){0.f, 0.f, 0.f, 0.f}, sB = sA;
    if (PASS_A) {
        if (ident) {
            const int ra = 32 * (rgx - 2) + row, rb = ra + 1;
            sA.x = (4 * ks + 0 == ra) ? 1.f : 0.f; sA.y = (4 * ks + 1 == ra) ? 1.f : 0.f; sA.z = (4 * ks + 2 == ra) ? 1.f : 0.f; sA.w = (4 * ks + 3 == ra) ? 1.f : 0.f;
            sB.x = (4 * ks + 0 == rb) ? 1.f : 0.f; sB.y = (4 * ks + 1 == rb) ? 1.f : 0.f; sB.z = (4 * ks + 2 == rb) ? 1.f : 0.f; sB.w = (4 * ks + 3 == rb) ? 1.f : 0.f;
        }
    } else {
        float* Xl = L;
        float* sr = srow + row * 64;
        const int lt = tid - 256;
        float* S0 = (float*)(P.ws + OFF_S0);
        if (!chain_only && g > 0 && w < 4) { const float* Sb = S0 + ((size_t)(g * 4 + h) * 64 + 32 * rgx + row) * 64 + 4 * ks; sA = *(const f32x4*)Sb; sB = *(const f32x4*)(Sb + 64); }
        const int gend = chain_only ? g : 0;
        float* srC = L + 8 * 4096 + row * 64;
        const int nrounds = (gend + 3) >> 2;
        if (gend > 0 && w >= 4) {
            f32x4 xr[4][4];
#pragma unroll
            for (int q = 0; q < 4; ++q)
#pragma unroll
                for (int e = 0; e < 4; ++e)
                    xr[q][e] = (q < gend) ? *(const f32x4*)(LX + ((size_t)(q * 4 + h) * 128 + 64) * 64 + (size_t)(lt + 256 * e) * 4) : (f32x4){0.f, 0.f, 0.f, 0.f};
#pragma unroll
            for (int q = 0; q < 4; ++q)
#pragma unroll
                for (int e = 0; e < 4; ++e) *(f32x4*)(Xl + q * 4096 + (lt + 256 * e) * 4) = xr[q][e];
        }
        if (gend > 0) __syncthreads();
        for (int r = 0; r < nrounds; ++r) {
            const int g0 = 4 * r, nb = (gend - g0 < 4) ? (gend - g0) : 4;
            float* Xc = Xl + (r & 1) * (4 * 4096);
            if (w >= 4) {
                if (r + 1 < nrounds) {
                    float* Xn = Xl + ((r + 1) & 1) * (4 * 4096); const int gn = g0 + 4, nn = (gend - gn < 4) ? (gend - gn) : 4;
                    f32x4 xr[4][4];
#pragma unroll
                    for (int q = 0; q < 4; ++q)
#pragma unroll
                        for (int e = 0; e < 4; ++e)
                            xr[q][e] = (q < nn) ? *(const f32x4*)(LX + ((size_t)((gn + q) * 4 + h) * 128 + 64) * 64 + (size_t)(lt + 256 * e) * 4) : (f32x4){0.f, 0.f, 0.f, 0.f};
#pragma unroll
                    for (int q = 0; q < 4; ++q)
#pragma unroll
                        for (int e = 0; e < 4; ++e) *(f32x4*)(Xn + q * 4096 + (lt + 256 * e) * 4) = xr[q][e];
                }
            } else {
                for (int q = 0; q < nb; ++q) {
                    const float* Xb = Xc + q * 4096 + 4 * ks;
                    const float* Lb = LX + ((size_t)((g0 + q) * 4 + h) * 128 + 32 * rgx + row) * 64 + 4 * ks;
                    f32x4 nA = *(const f32x4*)Lb, nB = *(const f32x4*)(Lb + 64);
                    *(f32x4*)(srC + 4 * ks) = sA; *(f32x4*)(srC + 64 + 4 * ks) = sB;
                    lds_wait();
#pragma unroll 8
                    for (int kp = 0; kp < 64; ++kp) {
                        const float ska = srC[kp], skb = srC[64 + kp]; const f32x4 xv = *(const f32x4*)(Xb + kp * 64);
                        nA.x += ska * xv.x; nA.y += ska * xv.y; nA.z += ska * xv.z; nA.w += ska * xv.w;
                        nB.x += skb * xv.x; nB.y += skb * xv.y; nB.z += skb * xv.z; nB.w += skb * xv.w;
                    }
                    lds_wait();
                    sA = nA; sB = nB;
                    float* dst = S0 + ((size_t)((g0 + q + 1) * 4 + h) * 64 + 32 * rgx + row) * 64 + 4 * ks;
                    *(f32x4*)dst = sA; *(f32x4*)(dst + 64) = sB;
                }
            }
            __syncthreads();
        }
        if (chain_only) return;
    }
    if (w >= 4) rwkv_scan_load(RK, L, ch0, h, vrg, tid - 256);
    __syncthreads();
    for (int cc = 0; cc < RS_CPS; ++cc) {
        const int ch = ch0 + cc;
        float* buf = L + (cc & 1) * RS_BUF;
        if (w >= 4) { if (cc + 1 < RS_CPS) rwkv_scan_load(RK, L + ((cc + 1) & 1) * RS_BUF, ch + 1, h, vrg, tid - 256); }
        else {
            const unsigned abase = (unsigned)(size_t)(PG8_LAS float*)buf + 16u * (unsigned)ks;
            const unsigned vbase = (unsigned)(size_t)(PG8_LAS float*)buf + (unsigned)(5 * RS_T * 64 + row) * 4u;
            f32x4 w4n, kk4n, b4n, k4n, r4n = (f32x4){0.f, 0.f, 0.f, 0.f}; f32x2v vvn;
#define RS_LD(tn) do { const unsigned _a = abase + (unsigned)(tn) * 256u; \
                asm volatile("ds_read_b128 %0, %1" : "=v"(w4n) : "v"(_a) : "memory"); \
                asm volatile("ds_read_b128 %0, %1 offset:8192" : "=v"(kk4n) : "v"(_a) : "memory"); \
                asm volatile("ds_read_b128 %0, %1 offset:16384" : "=v"(b4n) : "v"(_a) : "memory"); \
                asm volatile("ds_read_b128 %0, %1 offset:24576" : "=v"(k4n) : "v"(_a) : "memory"); \
                if (!PASS_A) asm volatile("ds_read_b128 %0, %1 offset:32768" : "=v"(r4n) : "v"(_a) : "memory"); \
                { const unsigned _v = vbase + (unsigned)(tn) * 128u; asm volatile("ds_read_b64 %0, %1" : "=v"(vvn) : "v"(_v) : "memory"); } } while (0)
            RS_LD(0);
            float ykA = 0.f, ykB = 0.f;
#pragma unroll 4
            for (int tt = 0; tt < RS_T; ++tt) {
                if (PASS_A) asm volatile("s_waitcnt lgkmcnt(0)" : "+v"(w4n), "+v"(kk4n), "+v"(b4n), "+v"(k4n), "+v"(vvn), "+v"(sA), "+v"(sB) :: "memory");
                else asm volatile("s_waitcnt lgkmcnt(0)" : "+v"(w4n), "+v"(kk4n), "+v"(b4n), "+v"(k4n), "+v"(r4n), "+v"(vvn), "+v"(sA), "+v"(sB) :: "memory");
                const f32x4 w4 = w4n, kk4 = kk4n, b4 = b4n, k4 = k4n, r4 = r4n; const f32x2v vv = vvn;
                const int tn = (tt + 1 < RS_T) ? tt + 1 : tt;
                RS_LD(tn);
                const float dA = (sA.x * kk4.x + sA.y * kk4.y) + (sA.z * kk4.z + sA.w * kk4.w);
                const float dB = (sB.x * kk4.x + sB.y * kk4.y) + (sB.z * kk4.z + sB.w * kk4.w);
                const float saA = -sum16(dA), saB = -sum16(dB);
                sA.x = sA.x * w4.x + (saA * b4.x + vv.x * k4.x); sA.y = sA.y * w4.y + (saA * b4.y + vv.x * k4.y);
                sA.z = sA.z * w4.z + (saA * b4.z + vv.x * k4.z); sA.w = sA.w * w4.w + (saA * b4.w + vv.x * k4.w);
                sB.x = sB.x * w4.x + (saB * b4.x + vv.y * k4.x); sB.y = sB.y * w4.y + (saB * b4.y + vv.y * k4.y);
                sB.z = sB.z * w4.z + (saB * b4.z + vv.y * k4.z); sB.w = sB.w * w4.w + (saB * b4.w + vv.y * k4.w);
                if (!PASS_A) {
                    const float yA = sum16((sA.x * r4.x + sA.y * r4.y) + (sA.z * r4.z + sA.w * r4.w));
                    const float yB = sum16((sB.x * r4.x + sB.y * r4.y) + (sB.z * r4.z + sB.w * r4.w));
                    ykA = (ks == (tt & 15)) ? yA : ykA; ykB = (ks == (tt & 15)) ? yB : ykB;
                    if ((tt & 15) == 15) *(unsigned*)(MIX + ((size_t)ch * RS_T + (tt - 15) + ks) * 1024 + 768 + h * 64 + 32 * rgx + row) = pk2(ykA, ykB);
                }
            }
            asm volatile("s_waitcnt lgkmcnt(0)" ::: "memory");
#undef RS_LD
        }
        __syncthreads();
    }
    if (PASS_A && w < 4) {
        float* dst = LX + ((size_t)(g * 4 + h) * 128 + 32 * rgx + row) * 64 + 4 * ks;
        *(f32x4*)dst = sA; *(f32x4*)(dst + 64) = sB;
    }
}

__device__ __forceinline__ void rwkv_post(const Params& P, int layer, int tid) {
    const int wave = tid >> 6, lane = tid & 63;
    const h16* RK = (const h16*)(P.ws + OFF_RK);
    bf16_t* MIX = (bf16_t*)(P.ws + OFF_HN);
    const float* lnw = P.in[I_LNW] + layer * 256; const float* lnb = P.in[I_LNB] + layer * 256; const float* rk = P.in[I_RK] + layer * 256;
    float lw[4], lb[4], rkk[4];
#pragma unroll
    for (int hh = 0; hh < 4; ++hh) { lw[hh] = lnw[hh * 64 + lane]; lb[hh] = lnb[hh * 64 + lane]; rkk[hh] = rk[hh * 64 + lane]; }
    for (int t = blockIdx.x * 8 + wave; t < S_; t += gridDim.x * 8) {
        float y[4], r[4], k[4], v[4], g[4];
#pragma unroll
        for (int hh = 0; hh < 4; ++hh) {
            const int col = hh * 64 + lane; const size_t o = (size_t)t * 256 + col;
            y[hh] = bf2f(MIX[(size_t)t * 1024 + 768 + col]);
            r[hh] = (float)RK[0 * RKSZ + o]; k[hh] = (float)RK[1 * RKSZ + o]; v[hh] = (float)RK[2 * RKSZ + o]; g[hh] = (float)RK[6 * RKSZ + o];
        }
        float m[4], q[4];
#pragma unroll
        for (int hh = 0; hh < 4; ++hh) { m[hh] = y[hh]; q[hh] = r[hh] * k[hh] * rkk[hh]; }
#pragma unroll
        for (int o = 1; o < 64; o <<= 1) {
#pragma unroll
            for (int hh = 0; hh < 4; ++hh) { m[hh] += __shfl_xor(m[hh], o); q[hh] += __shfl_xor(q[hh], o); }
        }
        float dl[4], var[4];
#pragma unroll
        for (int hh = 0; hh < 4; ++hh) { dl[hh] = y[hh] - m[hh] * (1.f / 64.f); var[hh] = dl[hh] * dl[hh]; }
#pragma unroll
        for (int o = 1; o < 64; o <<= 1) {
#pragma unroll
            for (int hh = 0; hh < 4; ++hh) var[hh] += __shfl_xor(var[hh], o);
        }
#pragma unroll
        for (int hh = 0; hh < 4; ++hh) {
            const float yn = dl[hh] * rsqrtf(var[hh] * (1.f / 64.f) + 64e-5f) * lw[hh] + lb[hh];
            MIX[(size_t)t * 1024 + 768 + hh * 64 + lane] = f2bf((yn + q[hh] * v[hh]) * g[hh]);
        }
    }
}

__device__ __forceinline__ void conv_glu(const Params& P, int layer, int hf, int tid) {
    const bf16_t* U = (const bf16_t*)(P.ws + OFF_U);
    bf16_t* ACT = (bf16_t*)(P.ws + OFF_ACT);
    bf16_t* HALO = (bf16_t*)(P.ws + OFF_HALO);
    const float* cw = P.in[I_CW] + (size_t)layer * 3 * 5632; const float* cb = P.in[I_CB] + (size_t)layer * 5632;
    const int gt = blockIdx.x * NTHREADS + tid, nth = gridDim.x * NTHREADS;
    for (int it = gt; it < 352 * 256; it += nth) {
        const int cgp = it % 352, run = it / 352, c = cgp * 8, lt0 = run * 32;
        float wg[3][8], wv[3][8], bg[8], bv[8];
#pragma unroll
        for (int q = 0; q < 8; ++q) {
            bg[q] = cb[c + q]; bv[q] = cb[2816 + c + q];
#pragma unroll
            for (int jx = 0; jx < 3; ++jx) { wg[jx][q] = cw[jx * 5632 + c + q]; wv[jx][q] = cw[jx * 5632 + 2816 + c + q]; }
        }
        u32x4 g2, g1, v2, v1;
        if (lt0 == 0) {
            if (hf == 0) { g2 = (u32x4){0, 0, 0, 0}; g1 = g2; v2 = g2; v1 = g2; }
            else { g2 = *(const u32x4*)(HALO + c); v2 = *(const u32x4*)(HALO + 2816 + c); g1 = *(const u32x4*)(HALO + 5632 + c); v1 = *(const u32x4*)(HALO + 5632 + 2816 + c); }
        } else {
            g2 = *(const u32x4*)(U + (size_t)(lt0 - 2) * 5632 + c); v2 = *(const u32x4*)(U + (size_t)(lt0 - 2) * 5632 + 2816 + c);
            g1 = *(const u32x4*)(U + (size_t)(lt0 - 1) * 5632 + c); v1 = *(const u32x4*)(U + (size_t)(lt0 - 1) * 5632 + 2816 + c);
        }
        for (int i0 = 0; i0 < 32; i0 += 4) {
            u32x4 gl[4], vl[4];
#pragma unroll
            for (int u = 0; u < 4; ++u) { gl[u] = *(const u32x4*)(U + (size_t)(lt0 + i0 + u) * 5632 + c); vl[u] = *(const u32x4*)(U + (size_t)(lt0 + i0 + u) * 5632 + 2816 + c); }
#pragma unroll
            for (int u = 0; u < 4; ++u) {
                const u32x4 g0 = gl[u], v0 = vl[u];
                float res[8];
#pragma unroll
                for (int q = 0; q < 4; ++q) {
                    const unsigned a2 = g2[q], a1 = g1[q], a0 = g0[q], b2 = v2[q], b1 = v1[q], b0 = v0[q];
                    const float glo = bg[2 * q] + wg[0][2 * q] * bflo(a2) + wg[1][2 * q] * bflo(a1) + wg[2][2 * q] * bflo(a0);
                    const float ghi = bg[2 * q + 1] + wg[0][2 * q + 1] * bfhi(a2) + wg[1][2 * q + 1] * bfhi(a1) + wg[2][2 * q + 1] * bfhi(a0);
                    const float vlo = bv[2 * q] + wv[0][2 * q] * bflo(b2) + wv[1][2 * q] * bflo(b1) + wv[2][2 * q] * bflo(b0);
                    const float vhi = bv[2 * q + 1] + wv[0][2 * q + 1] * bfhi(b2) + wv[1][2 * q + 1] * bfhi(b1) + wv[2][2 * q + 1] * bfhi(b0);
                    res[2 * q] = glo * sigm(glo) * vlo; res[2 * q + 1] = ghi * sigm(ghi) * vhi;
                }
                u32x4 o; o.x = pk2(res[0], res[1]); o.y = pk2(res[2], res[3]); o.z = pk2(res[4], res[5]); o.w = pk2(res[6], res[7]);
                *(u32x4*)(ACT + (size_t)(hf * 8192 + lt0 + i0 + u) * 2816 + c) = o;
                g2 = g1; g1 = g0; v2 = v1; v1 = v0;
            }
        }
    }
    if (hf == 0) {
        for (int it = gt; it < 2 * 704; it += nth) { const int r = it / 704, cc = it % 704; *(u32x4*)(HALO + (size_t)r * 5632 + cc * 8) = *(const u32x4*)(U + (size_t)(8190 + r) * 5632 + cc * 8); }
    }
}

__device__ __forceinline__ void run_phase(const Params& P, int ph, unsigned char* smem, int part) {
    const int tid = launder((int)threadIdx.x), wave = tid >> 6, lane = tid & 63;
    const int gw = blockIdx.x * 8 + wave, ngw = gridDim.x * 8;
    bf16_t* WT = (bf16_t*)(P.ws + OFF_WT);
    bf16_t* HN = (bf16_t*)(P.ws + OFF_HN);
    if (PH(16) && ph == 32) {
        const float* g = P.in[I_NFIN];
        for (int row = gw; row < S_; row += ngw) {
            f32x4* xr = (f32x4*)(P.out + (size_t)row * D_) + lane;
            f32x4 v[4]; float s = 0.f;
#pragma unroll
            for (int j = 0; j < 4; ++j) { v[j] = xr[64 * j]; s += (v[j].x * v[j].x + v[j].y * v[j].y) + (v[j].z * v[j].z + v[j].w * v[j].w); }
            s = wave_sum(s);
            const float r = rsqrtf(s * (1.f / 1024.f) + 1e-6f);
#pragma unroll
            for (int j = 0; j < 4; ++j) { const f32x4 gg = ((const f32x4*)g)[lane + 64 * j]; f32x4 o; o.x = v[j].x * r * gg.x; o.y = v[j].y * r * gg.y; o.z = v[j].z * r * gg.z; o.w = v[j].w * r * gg.w; xr[64 * j] = o; }
        }
        return;
    }
    const int layer = ph >> 4, sub = ph & 15;
    if (PH(0) && sub == 0) { phase_prep(P, layer, smem, tid); return; }
    if (PH(1) && sub == 9) {
        EpiConv E; E.act = (bf16_t*)(P.ws + OFF_ACT); E.hl = (bf16_t*)(P.ws + OFF_U); E.hf = (bf16_t*)(P.ws + OFF_U + 8 * MiB);
        E.cw = P.in[I_CW] + (size_t)layer * 3 * 5632; E.cb = P.in[I_CB] + (size_t)layer * 5632;
        run_gemm(smem, HN, WT + WT_UP, S_, 5632, 1024, E); return;
    }
    if (PH(1) && sub == 10) {
        conv_fixup(P, layer, tid);
        float* SSQ = (float*)(P.ws + OFF_SSQ);
        for (int it = blockIdx.x * NTHREADS + tid; it < S_; it += gridDim.x * NTHREADS) SSQ[it] = 0.f;
        return;
    }
    if (PH(1) && sub == 1) {
        EpiRoute E; const bf16_t* A; const bf16_t* Bt; int M, N;
        if (sub == 1) { A = HN; Bt = WT + WT_IN; M = S_; N = 3840; E.d0 = (bf16_t*)(P.ws + OFF_ZH); E.ld0 = 2048; E.d1 = (bf16_t*)(P.ws + OFF_ZB); E.ld1 = 768; E.d2 = (bf16_t*)(P.ws + OFF_ZC); E.ld2 = 1024; E.c1 = 2048; E.c2 = 2816; }
        else { const int hf = (sub == 11); A = HN + (size_t)hf * 8192 * 1024; Bt = WT + WT_UP; M = 8192; N = 5632; E.d0 = (bf16_t*)(P.ws + OFF_U); E.ld0 = 5632; E.d1 = E.d0; E.ld1 = 5632; E.d2 = E.d0; E.ld2 = 5632; E.c1 = 1 << 30; E.c2 = 1 << 30; }
        run_gemm(smem, A, Bt, M, N, 1024, E); return;
    }
    if (PH(7) && sub == 13) {
        EpiF32<3> E; E.hin = P.out; E.out = P.out; E.hb = HN; E.ssq = (float*)(P.ws + OFF_SSQ);
        run_gemm(smem, (const bf16_t*)(P.ws + OFF_ACT), WT + WT_DOWN, S_, 1024, 2816, E);
        const float* p = P.in[I_P] + (size_t)layer * S_ * 256; bf16_t* PB = (bf16_t*)(P.ws + OFF_PB);
        for (int it = blockIdx.x * NTHREADS + tid; it < S_ * 256 / 8; it += gridDim.x * NTHREADS) {
            const f32x4 a = ((const f32x4*)p)[2 * it], b = ((const f32x4*)p)[2 * it + 1];
            u32x4 o; o.x = pk2(a.x, a.y); o.y = pk2(a.z, a.w); o.z = pk2(b.x, b.y); o.w = pk2(b.z, b.w);
            ((u32x4*)PB)[it] = o;
        }
        return;
    }
    if (PH(7) && sub == 7) {
        EpiF32<0> E; const bf16_t* A; const bf16_t* Bt; int K;
        if (sub == 7) { A = HN; Bt = WT + WT_OUT; K = 1024; E.hin = (layer == 0) ? P.in[I_X] : P.out; }
        else { A = (const bf16_t*)(P.ws + OFF_ACT); Bt = WT + WT_DOWN; K = 2816; E.hin = P.out; }
        E.out = P.out;
        run_gemm(smem, A, Bt, S_, 1024, K, E); return;
    }
    if (PH(15) && sub == 15) {
        float* PP = (float*)(P.ws + OFF_PP);
        { EpiF32<1> E; E.hin = nullptr; E.out = PP; E.hb = nullptr; E.ssq = nullptr; run_gemm(smem, (const bf16_t*)(P.ws + OFF_PB), WT + WT_PROJ, S_, 1024, 256, E); }
        __syncthreads();
        { EpiF32<4> E; E.hin = PP; E.out = P.out; E.hb = nullptr; E.ssq = (float*)(P.ws + OFF_SSQ); run_gemm(smem, HN, WT + WT_GATE, S_, 1024, 1024, E); }
        return;
    }
    if (PH(2) && sub == 2) { rwkv_prep(P, layer, smem, tid); __syncthreads(); attn_partial(P, smem, tid); return; }
    if (PH(3) && sub == 3) {
        hgrn_pass1(P, layer, smem, tid); attn_combine(P, tid);
        for (int job = blockIdx.x; job < RS_G * 16; job += gridDim.x) rwkv_seg_job<true>(P, smem, tid, job >> 4, (job >> 2) & 3, job & 3);
        return;
    }
    if (PH(4) && sub == 4) { hgrn_scan(P, tid); return; }
    if (PH(5) && sub == 5) {
        if (part == 0 && blockIdx.x >= 8) { for (int item = blockIdx.x - 8; item < 1024; item += gridDim.x - 8) hgrn_pass3_item(P, layer, smem, tid, item); return; }
        const bool co = (part == 0);
        for (int job = blockIdx.x; job < (co ? 8 : RS_G * 8); job += gridDim.x)
            rwkv_seg_job<false>(P, smem, tid, co ? RS_G - 1 : (job >> 3), co ? (job >> 1) : ((job >> 1) & 3), job & 1, co);
        return;
    }
    if (PH(6) && sub == 6) { rwkv_post(P, layer, tid); return; }
    if (PH(8) && sub == 8) { rmsnorm_rows_bf16(P.out, P.in[I_NFFN] + layer * 1024, HN, gw, ngw, lane); return; }
    if (PH(14) && sub == 14) {
        rmsnorm_rows_bf16(P.out, P.in[I_NPLE] + layer * 1024, HN, gw, ngw, lane);
        const float* p = P.in[I_P] + (size_t)layer * S_ * 256; bf16_t* PB = (bf16_t*)(P.ws + OFF_PB);
        for (int it = blockIdx.x * NTHREADS + tid; it < S_ * 256 / 8; it += gridDim.x * NTHREADS) {
            const f32x4 a = ((const f32x4*)p)[2 * it], b = ((const f32x4*)p)[2 * it + 1];
            u32x4 o; o.x = pk2(a.x, a.y); o.y = pk2(a.z, a.w); o.z = pk2(b.x, b.y); o.w = pk2(b.z, b.w);
            ((u32x4*)PB)[it] = o;
        }
        return;
    }
}

#define XB_TMO      128
#define XB_XCNT(j)  (256  + 64 * (j))
#define XB_XSUB(j)  (1280 + 64 * (j))
#define XB_XGEN(j)  (2304 + 64 * (j))
#define XB_TOP      3328
#define XB_TOPGEN   3392
#define XCD_BAR_WORDS 3456
#define XB_SPIN_CAP (1u << 18)
#define XB_LAS __attribute__((address_space(3)))

__device__ __forceinline__ unsigned xb_ld(unsigned* p)              { return __hip_atomic_load(p, __ATOMIC_RELAXED, __HIP_MEMORY_SCOPE_AGENT); }
__device__ __forceinline__ unsigned xb_add(unsigned* p, unsigned v) { return __hip_atomic_fetch_add(p, v, __ATOMIC_RELAXED, __HIP_MEMORY_SCOPE_AGENT); }
__device__ __forceinline__ unsigned xb_xcc_id() { return (unsigned)__builtin_amdgcn_s_getreg((3 << 11) | 20) & 0xFu; }
#define XB_SPIN(cond, bar) do { unsigned _sp = 0; while (cond) { __builtin_amdgcn_s_sleep(1); \
    if ((++_sp & 255u) == 0u) { if (xb_ld(&(bar)[XB_TMO])) break; if (_sp > XB_SPIN_CAP) { atomicAdd(&(bar)[XB_TMO], 1u); break; } } } } while (0)
struct XcdBarrier {
    unsigned* bar; unsigned x;
    volatile XB_LAS unsigned* st;
};

__device__ __forceinline__ XcdBarrier xcd_barrier_post(unsigned* bar, volatile XB_LAS unsigned* st) {
    XcdBarrier b; b.bar = bar; b.x = xb_xcc_id(); b.st = st;
    if (threadIdx.x == 0) (void)xb_add(&bar[XB_XCNT(b.x)], 1u);
    return b;
}
__device__ __forceinline__ void xcd_barrier_complete(unsigned* bar, unsigned x, unsigned& nloc, unsigned& nx) {
    const unsigned G = gridDim.x * gridDim.y * gridDim.z;
    unsigned sum, cnt, mine, sp = 0u;
    for (;;) {
        sum = 0u; cnt = 0u; mine = 0u;
#pragma unroll
        for (unsigned j = 0; j < 16; ++j) { const unsigned c = xb_ld(&bar[XB_XCNT(j)]); sum += c; cnt += (c > 0u) ? 1u : 0u; mine = (j == x) ? c : mine; }
        if (sum == G) break;
        __builtin_amdgcn_s_sleep(1);
        if ((++sp & 255u) == 0u) { if (xb_ld(&bar[XB_TMO])) break; if (sp > XB_SPIN_CAP) { atomicAdd(&bar[XB_TMO], 1u); break; } }
    }
    nloc = mine > 0u ? mine : 1u; nx = cnt > 0u ? cnt : 1u;
}

__device__ __forceinline__ void xcd_barrier(const XcdBarrier& b) {
    asm volatile("s_waitcnt vmcnt(0)" ::: "memory");
    __syncthreads();
    if (threadIdx.x == 0) {
        unsigned* bar = b.bar;
        __builtin_amdgcn_s_waitcnt(0);
        unsigned nloc = b.st[0], nx = b.st[1];
        if (nloc == 0u) { xcd_barrier_complete(bar, b.x, nloc, nx); b.st[0] = nloc; b.st[1] = nx; }
        const unsigned old = xb_add(&bar[XB_XSUB(b.x)], 1u);
        const unsigned gen = old / nloc;
        if (old + 1u == (gen + 1u) * nloc) {
            __builtin_amdgcn_fence(__ATOMIC_RELEASE, "agent");
            asm volatile("s_waitcnt vmcnt(0)" ::: "memory");
            const unsigned og = xb_add(&bar[XB_TOP], 1u);
            const unsigned tg = og / nx;
            if (og + 1u == (tg + 1u) * nx) xb_add(&bar[XB_TOPGEN], 1u);
            else XB_SPIN(xb_ld(&bar[XB_TOPGEN]) == tg, bar);
            __builtin_amdgcn_fence(__ATOMIC_ACQUIRE, "agent");
            xb_add(&bar[XB_XGEN(b.x)], 1u);
            asm volatile("s_waitcnt vmcnt(0)" ::: "memory");
        } else {
            XB_SPIN(xb_ld(&bar[XB_XGEN(b.x)]) == gen, bar);
            __builtin_amdgcn_fence(__ATOMIC_ACQUIRE, "agent");
            asm volatile("s_waitcnt vmcnt(0)" ::: "memory");
        }
    }
    __syncthreads();
}

constexpr size_t OFF_BAR = 65536;

#ifndef ONE_LAUNCH
#define ONE_LAUNCH 1
#endif

__global__ __launch_bounds__(512, 2) void mega(Params P, int ph_lo, int ph_hi) {
    extern __shared__ __attribute__((aligned(16))) unsigned char smem[];
    cg::grid_group grid = cg::this_grid();
    if (ph_hi == 0x7fffffff) grid.sync();
    volatile XB_LAS unsigned* st = (volatile XB_LAS unsigned*)(smem + LDS_BYTES - 16);
    if (threadIdx.x == 0) { st[0] = 0u; st[1] = 0u; }
    __syncthreads();
    XcdBarrier xb = xcd_barrier_post((unsigned*)(P.ws + OFF_BAR), st);
#ifdef EXTRA_SYNCS
    for (int i = 0; i < EXTRA_SYNCS; ++i) xcd_barrier(xb);
#endif
    for (int ph = ph_lo; ph < ph_hi; ++ph) {
        if (ph < 32 && ((ph & 15) == 11 || (ph & 15) == 12 || (ph & 15) == 14)) continue;
        if (ph > ph_lo) xcd_barrier(xb);
        const int nparts = (ph < 32 && (ph & 15) == 5) ? 2 : 1;
        for (int part = 0; part < nparts; ++part) { if (part) xcd_barrier(xb); run_phase(P, ph, smem, part); }
#ifdef REP_MASK
        if (ph < 32 && ((REP_MASK >> (ph & 15)) & 1)) { xcd_barrier(xb); run_phase(P, ph, smem, 0); }
#endif
    }
}

extern "C" void kernel_launch(void* const* d_in, const int* in_sizes, int n_in, void* d_out, int out_size, void* d_ws, size_t ws_size, hipStream_t stream) {
    static int grid_blocks = 0;
    if (grid_blocks == 0) {
        int dev = 0, cus = 0, per_cu = 0;
        if (hipGetDevice(&dev) != hipSuccess || hipDeviceGetAttribute(&cus, hipDeviceAttributeMultiprocessorCount, dev) != hipSuccess) { fprintf(stderr, "kernel_launch: device query failed\n"); grid_blocks = -1; return; }
        if (hipFuncSetAttribute((const void*)mega, hipFuncAttributeMaxDynamicSharedMemorySize, LDS_BYTES) != hipSuccess) { fprintf(stderr, "kernel_launch: hipFuncSetAttribute failed\n"); grid_blocks = -1; return; }
        if (hipOccupancyMaxActiveBlocksPerMultiprocessor(&per_cu, (const void*)mega, NTHREADS, LDS_BYTES) != hipSuccess || per_cu < 1) { fprintf(stderr, "kernel_launch: occupancy query gave %d\n", per_cu); per_cu = 1; }
        (void)hipGetLastError();
        grid_blocks = cus * per_cu;
        if (n_in != 30 || ws_size < 256 * MiB) fprintf(stderr, "kernel_launch: unexpected n_in %d / ws_size %zu\n", n_in, ws_size);
    }
    if (grid_blocks < 0) return;
    Params P{};
    for (int i = 0; i < 30; ++i) P.in[i] = (const float*)d_in[i];
    P.out = (float*)d_out; P.ws = (unsigned char*)d_ws;
#if ONE_LAUNCH
    if (hipMemsetAsync((char*)d_ws + OFF_BAR, 0, XCD_BAR_WORDS * sizeof(unsigned), stream) != hipSuccess) { fprintf(stderr, "kernel_launch: memset of the barrier words failed\n"); return; }
    int lo = 0, hi = NPH;
    void* args[] = {&P, &lo, &hi};
    hipError_t e = hipLaunchCooperativeKernel((const void*)mega, dim3(grid_blocks), dim3(NTHREADS), args, LDS_BYTES, stream);
    if (e != hipSuccess) fprintf(stderr, "cooperative launch failed: %s (grid %d)\n", hipGetErrorString(e), grid_blocks);
#else
    for (int ph = 0; ph < NPH; ++ph) hipLaunchKernelGGL(mega, dim3(grid_blocks), dim3(NTHREADS), LDS_BYTES, stream, P, ph, ph + 1);
#endif
}
```

```cpp
#include <hip/hip_runtime.h>
#include <hip/hip_cooperative_groups.h>
#include <cstdio>
#include <cstdint>
namespace cg = cooperative_groups;
namespace pg8 {
#define PG8_LAS __attribute__((address_space(3)))
typedef unsigned short bf16_t;
typedef short bf16x8 __attribute__((ext_vector_type(8)));
typedef float f32x4 __attribute__((ext_vector_type(4)));
typedef unsigned u32x4 __attribute__((ext_vector_type(4)));
constexpr int BM = 256, BK = 64, HALF = 128, HTB = HALF * BK * 2  , STAGE_BYTES = 8 * HTB, NXCD = 8, WGM = 8;

__host__ __device__ __forceinline__ int lds_byte(int r, int c) { const int st = (r >> 4) * 2 + (c >> 5), rr = r & 15, cc = c & 31, ob = rr * 64 + cc * 2; return st * 1024 + (ob ^ (((ob >> 9) & 1) << 5)); }
__host__ __device__ __forceinline__ void stage_rc(int b, int& R, int& C) { const int st = b / 1024, sb = b % 1024, swz = sb ^ (((sb >> 9) & 1) << 5); R = (st >> 1) * 16 + swz / 64; C = (st & 1) * 32 + (swz % 64) / 2; }
__host__ __device__ __forceinline__ int perm32(int rho) { const int n = rho >> 4, i = rho & 15; return 8 * (i >> 2) + 4 * n + (i & 3); }

struct Unit { int pm, pn; };
struct Gemm { const bf16_t* A; const bf16_t* Bt; int M, N, K; };

struct StaticOrder {
    int nM, nN, nwg, G, c;
    __host__ __device__ void init(int M, int N, int G_, int c_) { nM = M / BM; nN = N / BM; nwg = nM * nN; G = G_; c = c_; }
    __host__ __device__ bool next(int i, Unit& u) const {
        const long L = (long)i * G + c; if (L >= nwg) return false;
        int wgid = (int)L; { const int q = nwg / NXCD, r = nwg % NXCD, xcd = wgid % NXCD, off = wgid / NXCD; wgid = (xcd < r ? xcd * (q + 1) : r * (q + 1) + (xcd - r) * q) + off; }
        const int nig = WGM * nN, gid = wgid / nig, fm = gid * WGM, gsz = (nM - fm) < WGM ? (nM - fm) : WGM;
        u.pm = fm + ((wgid % nig) % gsz); u.pn = (wgid % nig) / gsz; return true;
    }
    __device__ __forceinline__ void a_ready(const Unit&) const {}
    __device__ __forceinline__ void done(const Unit&) const {}
};
__device__ __forceinline__ unsigned cvt_pk_bf16(float lo, float hi) { unsigned r; asm volatile("v_cvt_pk_bf16_f32 %0, %1, %2" : "=v"(r) : "v"(lo), "v"(hi)); return r; }
typedef float f32x2 __attribute__((ext_vector_type(2)));
template <class Epi, class Sched, bool STAMP = false>
__device__ __forceinline__ void gemm_phase(PG8_LAS unsigned char* lds, const Gemm g, const Sched& S, const Epi& E, unsigned long long* stamps) {
    int tid_l = threadIdx.x; asm volatile("" : "+v"(tid_l)); const int tid = tid_l, wid = __builtin_amdgcn_readfirstlane(tid >> 6), lane = tid & 63, wr = wid >> 2, wc = wid & 3, fr = lane & 15, fq = lane >> 4;
    const int K = g.K, nt = K / BK;
    int ts_lo = 0, ts_hi = 0, nts = 0; const unsigned long long rt_entry = STAMP ? (unsigned long long)wall_clock64() : 0ull;
#define PG8_STAMP() do { if (STAMP && wid == 0 && nts < 64) { const unsigned long long _c = (unsigned long long)clock64(); \
        ts_lo = (lane == nts) ? (int)(unsigned)_c : ts_lo; ts_hi = (lane == nts) ? (int)(unsigned)(_c >> 32) : ts_hi; ++nts; } } while (0)
    PG8_STAMP();
    unsigned voffA[2], voffB[2];
#pragma unroll
    for (int i = 0; i < 2; ++i) { int R, C; stage_rc(tid * 16 + i * 8192, R, C); const int Rb = Epi::PERM ? ((R & ~31) + perm32(R & 31)) : R;
        voffA[i] = (unsigned)(R * K + C) * 2u; voffB[i] = (unsigned)(Rb * K + C) * 2u; }
    const size_t kstep = (size_t)(BK * 2);
    const size_t hstep = (size_t)HALF * K * 2;
    const size_t tstep = 2 * hstep;
    const unsigned ldsw = (unsigned)wid * 1024u;
    const int aoff = lds_byte(wr * 64 + fr, fq * 8), boff = lds_byte(wc * 32 + fr, fq * 8);
#define PG8_SA(b, h) (((b) * 2 + (h)) * HTB)
#define PG8_SB(b, h) ((4 + (b) * 2 + (h)) * HTB)
#define PG8_STAGE(bufoff, gbase, voff) do { _Pragma("unroll") for (int _i = 0; _i < 2; ++_i) \
        __builtin_amdgcn_global_load_lds((const unsigned*)((const char*)(gbase) + (voff)[_i]), (PG8_LAS unsigned*)(lds + (bufoff) + ldsw + _i * 8192), 16, 0, 0); } while (0)
#define PG8_LDA(dst, b, h) do { _Pragma("unroll") for (int m = 0; m < 4; ++m) _Pragma("unroll") for (int k = 0; k < 2; ++k) dst[m][k] = *(const PG8_LAS bf16x8*)(lds + PG8_SA(b, h) + aoff + m * 2048 + k * 1024); } while (0)
#define PG8_LDB(dst, b, h) do { _Pragma("unroll") for (int n = 0; n < 2; ++n) _Pragma("unroll") for (int k = 0; k < 2; ++k) dst[n][k] = *(const PG8_LAS bf16x8*)(lds + PG8_SB(b, h) + boff + n * 2048 + k * 1024); } while (0)
#define PG8_MMA(ai, bj, At, Bt) do { __builtin_amdgcn_s_setprio(1); _Pragma("unroll") for (int m = 0; m < 4; ++m) _Pragma("unroll") for (int n = 0; n < 2; ++n) _Pragma("unroll") for (int k = 0; k < 2; ++k) \
        acc[ai][bj][m][n] = __builtin_amdgcn_mfma_f32_16x16x32_bf16(Bt[n][k], At[m][k], acc[ai][bj][m][n], 0, 0, 0); __builtin_amdgcn_s_setprio(0); } while (0)
#define PG8_WAIT_V(n) asm volatile("s_waitcnt vmcnt(" #n ")" ::: "memory")
#define PG8_WAIT_L(n) asm volatile("s_waitcnt lgkmcnt(" #n ")" ::: "memory")
#define PG8_BAR __builtin_amdgcn_s_barrier()
#define PG8_SCHED __builtin_amdgcn_sched_barrier(0)
    Unit cur, nxt; int ui = 0;
    if (!S.next(0, cur)) return;
    f32x4 acc[2][2][4][2];
#pragma unroll
    for (int a = 0; a < 2; ++a)
#pragma unroll
        for (int b = 0; b < 2; ++b)
#pragma unroll
            for (int m = 0; m < 4; ++m)
#pragma unroll
                for (int n = 0; n < 2; ++n) acc[a][b][m][n] = (f32x4){0.f, 0.f, 0.f, 0.f};
    bf16x8 At[4][2], B0[2][2], B1[2][2];
    const char* cA = (const char*)g.A + (size_t)cur.pm * tstep; const char* cB = (const char*)g.Bt + (size_t)cur.pn * tstep;
    S.a_ready(cur);
    PG8_STAGE(PG8_SB(0, 0), cB, voffB); PG8_STAGE(PG8_SA(0, 0), cA, voffA); PG8_STAGE(PG8_SB(0, 1), cB + hstep, voffB); PG8_STAGE(PG8_SA(0, 1), cA + hstep, voffA);
    if (wr == 1) PG8_BAR;
    PG8_WAIT_V(4); PG8_BAR;
    PG8_STAGE(PG8_SB(1, 0), cB + kstep, voffB); PG8_STAGE(PG8_SA(1, 0), cA + kstep, voffA); PG8_STAGE(PG8_SB(1, 1), cB + hstep + kstep, voffB);
    PG8_WAIT_V(6); PG8_BAR;
    PG8_STAMP();
    for (;;) {
        const bool has_next = S.next(ui + 1, nxt);
        const char* nA = has_next ? (const char*)g.A + (size_t)nxt.pm * tstep : cA; const char* nB = has_next ? (const char*)g.Bt + (size_t)nxt.pn * tstep : cB;
        for (int t = 0; t < nt; t += 2) {
            const bool last = (t == nt - 2);
            const char* a1 = cA + (size_t)(t + 1) * kstep;
            const char* a2 = last ? nA : cA + (size_t)(t + 2) * kstep; const char* b2 = last ? nB : cB + (size_t)(t + 2) * kstep;
            const char* a3 = a2 + kstep; const char* b3 = b2 + kstep;
            if (last && has_next) S.a_ready(nxt);
            PG8_LDB(B0, 0, 0); PG8_SCHED; PG8_LDA(At, 0, 0); PG8_STAGE(PG8_SA(1, 1), a1 + hstep, voffA);
            PG8_WAIT_L(8); PG8_BAR; PG8_WAIT_L(0); PG8_MMA(0, 0, At, B0); PG8_BAR; PG8_SCHED;
            PG8_LDB(B1, 0, 1); PG8_STAGE(PG8_SB(0, 0), b2, voffB);
            PG8_BAR; PG8_WAIT_L(0); PG8_MMA(0, 1, At, B1); PG8_BAR;
            PG8_LDA(At, 0, 1); PG8_STAGE(PG8_SA(0, 0), a2, voffA);
            PG8_BAR; PG8_WAIT_L(0); PG8_MMA(1, 0, At, B0); PG8_BAR; PG8_SCHED;
            PG8_STAGE(PG8_SB(0, 1), b2 + hstep, voffB);
            PG8_WAIT_V(6); PG8_BAR; PG8_MMA(1, 1, At, B1); PG8_BAR;
            PG8_LDB(B0, 1, 0); PG8_SCHED; PG8_LDA(At, 1, 0); PG8_STAGE(PG8_SA(0, 1), a2 + hstep, voffA);
            PG8_WAIT_L(8); PG8_BAR; PG8_WAIT_L(0); PG8_MMA(0, 0, At, B0); PG8_BAR; PG8_SCHED;
            PG8_LDB(B1, 1, 1); PG8_STAGE(PG8_SB(1, 0), b3, voffB);
            PG8_BAR; PG8_WAIT_L(0); PG8_MMA(0, 1, At, B1); PG8_BAR;
            PG8_LDA(At, 1, 1); PG8_STAGE(PG8_SA(1, 0), a3, voffA);
            PG8_BAR; PG8_WAIT_L(0); PG8_MMA(1, 0, At, B0); PG8_BAR; PG8_SCHED;
            PG8_STAGE(PG8_SB(1, 1), b3 + hstep, voffB);
            PG8_WAIT_V(6); PG8_BAR; PG8_MMA(1, 1, At, B1); PG8_BAR;
        }
        PG8_STAMP();
        if constexpr (!Epi::AFTER_DRAIN) { E(acc, cur, wr, wc, fr, fq); S.done(cur); }
        PG8_STAMP();
        if (!has_next) break;
#pragma unroll
        for (int a = 0; a < 2; ++a)
#pragma unroll
            for (int b = 0; b < 2; ++b)
#pragma unroll
                for (int m = 0; m < 4; ++m)
#pragma unroll
                    for (int n = 0; n < 2; ++n) acc[a][b][m][n] = (f32x4){0.f, 0.f, 0.f, 0.f};
        cur = nxt; cA = nA; cB = nB; ++ui;
    }
    PG8_WAIT_V(0);
    if (wr == 0) PG8_BAR;
    PG8_BAR;
    if constexpr (Epi::AFTER_DRAIN) { E.fused(acc, cur, wr, wc, fr, fq, lds, wid, lane); S.done(cur); }
    PG8_STAMP();
    if (STAMP && wid == 0) { stamps[lane] = lane < nts ? (((unsigned long long)(unsigned)ts_hi << 32) | (unsigned)ts_lo) : 0ull;
        if (lane == 62) stamps[62] = rt_entry; if (lane == 63) stamps[63] = (unsigned long long)wall_clock64(); }
#undef PG8_STAMP
#undef PG8_SA
#undef PG8_SB
#undef PG8_STAGE
#undef PG8_LDA
#undef PG8_LDB
#undef PG8_MMA
#undef PG8_WAIT_V
#undef PG8_WAIT_L
#undef PG8_BAR
#undef PG8_SCHED
}
}

using pg8::bf16_t; using pg8::f32x4; using pg8::u32x4; using pg8::Unit;
typedef _Float16 h16;
typedef _Float16 h16x8 __attribute__((ext_vector_type(8)));
typedef _Float16 h16x2 __attribute__((ext_vector_type(2)));
typedef _Float16 h16x4 __attribute__((ext_vector_type(4)));
typedef float f32x2v __attribute__((ext_vector_type(2)));

constexpr int S_ = 16384, D_ = 1024;
constexpr int NTHREADS = 512;
constexpr int LDS_BYTES = 155648;
constexpr size_t MiB = (size_t)1 << 20;
constexpr size_t OFF_HALO = 0, OFF_WT = 1 * MiB, OFF_VF = 30 * MiB, OFF_LX = 38 * MiB, OFF_S0 = 42 * MiB, OFF_HN = 46 * MiB, OFF_BIG = 78 * MiB;
constexpr size_t OFF_ZH = OFF_BIG, OFF_ZB = OFF_BIG + 64 * MiB, OFF_ZC = OFF_BIG + 88 * MiB, OFF_RK = OFF_BIG + 120 * MiB,
                 OFF_LSE = OFF_BIG + 176 * MiB, OFF_GB = OFF_BIG + 177 * MiB;
constexpr size_t OFF_U = OFF_BIG, OFF_ACT = OFF_BIG + 88 * MiB;
constexpr size_t OFF_PB = OFF_BIG, OFF_PP = OFF_BIG + 8 * MiB;
constexpr size_t OFF_SSQ = OFF_BIG + 80 * MiB;
constexpr size_t WT_IN = 0, WT_OUT = 3932160, WT_UP = 4980736, WT_DOWN = 10747904, WT_GATE = 13631488, WT_PROJ = 14680064,
                 WT_W2 = 14942208, WT_A2 = 14958592, WT_G2 = 14974976, WT_V1 = 15007744;
constexpr size_t RKSZ = (size_t)S_ * 256;

enum { I_X = 0, I_P, I_WIN, I_WOUT, I_NMIX, I_NFFN, I_NPLE, I_NFIN, I_LB, I_GN, I_MU, I_W0, I_W2, I_A0, I_A2, I_G2, I_KK, I_KA, I_RK,
       I_LNW, I_LNB, I_V0, I_V1, I_V2, I_UP, I_CW, I_CB, I_DOWN, I_PROJ, I_GATE, N_IN };

struct Params { const float* in[30]; float* out; unsigned char* ws; };

constexpr int NPH_LAYER = 16, NPH = 33;
#ifndef PHMASK
#define PHMASK 0x1FFFF
#endif
#define PH(x) ((PHMASK >> (x)) & 1)

__device__ __forceinline__ float bf2f(unsigned short b) { return __uint_as_float(((unsigned)b) << 16); }
__device__ __forceinline__ float bflo(unsigned u) { return __uint_as_float(u << 16); }
__device__ __forceinline__ float bfhi(unsigned u) { return __uint_as_float(u & 0xffff0000u); }
__device__ __forceinline__ unsigned pk2(float lo, float hi) { return pg8::cvt_pk_bf16(lo, hi); }
__device__ __forceinline__ unsigned pk2_sw(float lo, float hi) { unsigned a = __float_as_uint(lo), b = __float_as_uint(hi); a += 0x7fffu + ((a >> 16) & 1u); b += 0x7fffu + ((b >> 16) & 1u); return (a >> 16) | (b & 0xffff0000u); }
__device__ __forceinline__ unsigned short f2bf(float f) { return (unsigned short)(pk2(f, 0.f) & 0xffffu); }
__device__ __forceinline__ float wave_sum(float v) {
#pragma unroll
    for (int o = 1; o < 64; o <<= 1) v += __shfl_xor(v, o);
    return v;
}
__device__ __forceinline__ float sigm(float x) { return __builtin_amdgcn_rcpf(1.f + __expf(-x)); }
__device__ __forceinline__ int launder(int x) { asm volatile("" : "+v"(x)); return x; }
__device__ __forceinline__ void lds_wait() { asm volatile("s_waitcnt lgkmcnt(0)" ::: "memory"); }

__device__ __forceinline__ void transpose_item(const float* __restrict__ W, int K, int N, bf16_t* __restrict__ WT, float* scr, int item, int lane, bool perm_up = false, const float* __restrict__ kscale = nullptr) {
    const int nblk = N / 32, kb = item / nblk, nb = item % nblk, k0 = 64 * kb, n0 = 32 * nb;
    const int d0 = !perm_up ? n0 : ((n0 < 2816) ? (256 * (n0 >> 7) + (n0 & 127)) : (256 * ((n0 - 2816) >> 7) + 128 + ((n0 - 2816) & 127)));
#pragma unroll 8
    for (int i = 0; i < 32; ++i) { const int kk = 2 * i + (lane >> 5); float x = W[(size_t)(k0 + kk) * N + n0 + (lane & 31)]; if (kscale) x *= kscale[k0 + kk]; scr[kk * 33 + (lane & 31)] = x; }
    lds_wait();
    const int c = lane & 7;
#pragma unroll
    for (int j = 0; j < 4; ++j) {
        const int n = (lane >> 3) + 8 * j; const float* s = scr + (8 * c) * 33 + n;
        u32x4 o; o.x = pk2(s[0 * 33], s[1 * 33]); o.y = pk2(s[2 * 33], s[3 * 33]); o.z = pk2(s[4 * 33], s[5 * 33]); o.w = pk2(s[6 * 33], s[7 * 33]);
        *(u32x4*)(WT + (size_t)(d0 + n) * K + k0 + 8 * c) = o;
    }
    lds_wait();
}

__device__ __forceinline__ void rmsnorm_rows_bf16(const float* __restrict__ h, const float* __restrict__ g, bf16_t* __restrict__ out, int gw, int ngw, int lane) {
    f32x4 gg[4];
#pragma unroll
    for (int j = 0; j < 4; ++j) gg[j] = ((const f32x4*)g)[lane + 64 * j];
    for (int row = gw; row < S_; row += 2 * ngw) {
        const f32x4* xa = (const f32x4*)(h + (size_t)row * D_) + lane;
        const f32x4* xb = (const f32x4*)(h + (size_t)(row + ngw) * D_) + lane;
        f32x4 va[4], vb[4]; float sa = 0.f, sb = 0.f;
#pragma unroll
        for (int j = 0; j < 4; ++j) { va[j] = xa[64 * j]; vb[j] = xb[64 * j]; }
#pragma unroll
        for (int j = 0; j < 4; ++j) { sa += (va[j].x * va[j].x + va[j].y * va[j].y) + (va[j].z * va[j].z + va[j].w * va[j].w); sb += (vb[j].x * vb[j].x + vb[j].y * vb[j].y) + (vb[j].z * vb[j].z + vb[j].w * vb[j].w); }
#pragma unroll
        for (int o = 1; o < 64; o <<= 1) { sa += __shfl_xor(sa, o); sb += __shfl_xor(sb, o); }
        const float ra = rsqrtf(sa * (1.f / 1024.f) + 1e-6f), rb = rsqrtf(sb * (1.f / 1024.f) + 1e-6f);
        unsigned long long* oa = (unsigned long long*)(out + (size_t)row * D_) + lane;
        unsigned long long* ob = (unsigned long long*)(out + (size_t)(row + ngw) * D_) + lane;
#pragma unroll
        for (int j = 0; j < 4; ++j) {
            oa[64 * j] = (unsigned long long)pk2(va[j].x * ra * gg[j].x, va[j].y * ra * gg[j].y) | ((unsigned long long)pk2(va[j].z * ra * gg[j].z, va[j].w * ra * gg[j].w) << 32);
            ob[64 * j] = (unsigned long long)pk2(vb[j].x * rb * gg[j].x, vb[j].y * rb * gg[j].y) | ((unsigned long long)pk2(vb[j].z * rb * gg[j].z, vb[j].w * rb * gg[j].w) << 32);
        }
    }
}

__device__ __forceinline__ void phase_prep(const Params& P, int layer, unsigned char* smem, int tid) {
    const int wave = tid >> 6, lane = tid & 63;
    const int gw = blockIdx.x * 8 + wave, ngw = gridDim.x * 8;
    float* scr = (float*)smem + wave * (64 * 33);
    bf16_t* WT = (bf16_t*)(P.ws + OFF_WT);
    constexpr int I0 = 16 * 120, I1 = 16 * 32, I2 = 16 * 176, I3 = 44 * 32, I4 = 16 * 32, I5 = 4 * 32, I6 = 8, I7 = 8, I8 = 16, I9 = 4;
    constexpr int NIT = I0 + I1 + I2 + I3 + I4 + I5 + I6 + I7 + I8 + I9;
    for (int it = gw; it < NIT; it += ngw) {
        int r = it;
        if (r < I0) { transpose_item(P.in[I_WIN] + (size_t)layer * 1024 * 3840, 1024, 3840, WT + WT_IN, scr, r, lane); continue; } r -= I0;
        if (r < I1) { transpose_item(P.in[I_WOUT] + (size_t)layer * 1024 * 1024, 1024, 1024, WT + WT_OUT, scr, r, lane); continue; } r -= I1;
        if (r < I2) { transpose_item(P.in[I_UP] + (size_t)layer * 1024 * 5632, 1024, 5632, WT + WT_UP, scr, r, lane, true); continue; } r -= I2;
        if (r < I3) { transpose_item(P.in[I_DOWN] + (size_t)layer * 2816 * 1024, 2816, 1024, WT + WT_DOWN, scr, r, lane); continue; } r -= I3;
        if (r < I4) { transpose_item(P.in[I_GATE] + (size_t)layer * 1024 * 1024, 1024, 1024, WT + WT_GATE, scr, r, lane, false, P.in[I_NPLE] + layer * 1024); continue; } r -= I4;
        if (r < I5) { transpose_item(P.in[I_PROJ] + (size_t)layer * 256 * 1024, 256, 1024, WT + WT_PROJ, scr, r, lane); continue; } r -= I5;
        if (r < I6) { transpose_item(P.in[I_W2] + (size_t)layer * 64 * 256, 64, 256, WT + WT_W2, scr, r, lane); continue; } r -= I6;
        if (r < I7) { transpose_item(P.in[I_A2] + (size_t)layer * 64 * 256, 64, 256, WT + WT_A2, scr, r, lane); continue; } r -= I7;
        if (r < I8) { transpose_item(P.in[I_G2] + (size_t)layer * 128 * 256, 128, 256, WT + WT_G2, scr, r, lane); continue; } r -= I8;
        transpose_item(P.in[I_V1], 256, 32, WT + WT_V1, scr, r, lane);
    }
    const float* h = (layer == 0) ? P.in[I_X] : P.out;
    rmsnorm_rows_bf16(h, P.in[I_NMIX] + layer * 1024, (bf16_t*)(P.ws + OFF_HN), gw, ngw, lane);
}

struct EpiRoute {
    static constexpr bool PERM = true, AFTER_DRAIN = false;
    bf16_t* d0; bf16_t* d1; bf16_t* d2; int ld0, ld1, ld2, c1, c2;
    __device__ __forceinline__ void operator()(const f32x4 (&acc)[2][2][4][2], const Unit& u, int wr, int wc, int fr, int fq) const {
        int colt = u.pn * 256; bf16_t* base; int ld;
        if (colt < c1) { base = d0; ld = ld0; } else if (colt < c2) { base = d1; ld = ld1; colt -= c1; } else { base = d2; ld = ld2; colt -= c2; }
        const int row0 = u.pm * 256 + wr * 64 + fr, col0 = colt + wc * 32 + 8 * fq;
#pragma unroll
        for (int ai = 0; ai < 2; ++ai)
#pragma unroll
            for (int m = 0; m < 4; ++m) {
                bf16_t* rowp = base + (size_t)(row0 + ai * 128 + m * 16) * ld + col0;
#pragma unroll
                for (int bj = 0; bj < 2; ++bj) {
                    const f32x4 v0 = acc[ai][bj][m][0], v1 = acc[ai][bj][m][1];
                    u32x4 w; w.x = pk2(v0[0], v0[1]); w.y = pk2(v0[2], v0[3]); w.z = pk2(v1[0], v1[1]); w.w = pk2(v1[2], v1[3]);
                    *(u32x4*)(rowp + bj * 128) = w;
                }
            }
    }
};
template <int MODE  > struct EpiF32 {
    static constexpr bool PERM = false, AFTER_DRAIN = false;
    const float* hin; float* out; bf16_t* hb; float* ssq;
    __device__ __forceinline__ void operator()(const f32x4 (&acc)[2][2][4][2], const Unit& u, int wr, int wc, int fr, int fq) const {
        const int row0 = u.pm * 256 + wr * 64 + fr, col0 = u.pn * 256 + wc * 32 + 4 * fq;
#pragma unroll
        for (int ai = 0; ai < 2; ++ai)
#pragma unroll
            for (int m = 0; m < 4; ++m) {
                const int row = row0 + ai * 128 + m * 16;
                const size_t ro = (size_t)row * 1024 + col0;
                float sq = 0.f, rs = 1.f;
                if (MODE == 4) rs = rsqrtf(ssq[row] * (1.f / 1024.f) + 1e-6f);
#pragma unroll
                for (int bj = 0; bj < 2; ++bj)
#pragma unroll
                    for (int n = 0; n < 2; ++n) {
                        const size_t off = ro + bj * 128 + n * 16;
                        const f32x4 a = acc[ai][bj][m][n];
                        if (MODE == 0) { *(f32x4*)(out + off) = *(const f32x4*)(hin + off) + a; }
                        else if (MODE == 1) { *(f32x4*)(out + off) = a; }
                        else if (MODE == 3) {
                            const f32x4 o = *(const f32x4*)(hin + off) + a; *(f32x4*)(out + off) = o;
                            sq += (o.x * o.x + o.y * o.y) + (o.z * o.z + o.w * o.w);
                            *(unsigned long long*)(hb + off) = (unsigned long long)pk2(o.x, o.y) | ((unsigned long long)pk2(o.z, o.w) << 32);
                        }
                        else { const f32x4 pp = *(const f32x4*)(hin + off); f32x4 hv = *(f32x4*)(out + off);
                               hv.x += sigm(a.x * rs) * pp.x; hv.y += sigm(a.y * rs) * pp.y; hv.z += sigm(a.z * rs) * pp.z; hv.w += sigm(a.w * rs) * pp.w; *(f32x4*)(out + off) = hv; }
                    }
                if (MODE == 3) { sq += __shfl_xor(sq, 16); sq += __shfl_xor(sq, 32); if (fq == 0) atomicAdd(ssq + row, sq); }
            }
    }
};

__device__ __forceinline__ float dpp_ror1(float x) { return __int_as_float(__builtin_amdgcn_update_dpp(0, __float_as_int(x), 0x121, 0xF, 0xF, true)); }
__device__ __forceinline__ float dpp_ror2(float x) { return __int_as_float(__builtin_amdgcn_update_dpp(0, __float_as_int(x), 0x122, 0xF, 0xF, true)); }
__device__ __forceinline__ unsigned long long pk4(float a, float b, float c, float d) { return (unsigned long long)pk2_sw(a, b) | ((unsigned long long)pk2_sw(c, d) << 32); }
struct EpiConv {
    static constexpr bool PERM = true, AFTER_DRAIN = false;
    bf16_t* act; bf16_t* hl; bf16_t* hf; const float* cw; const float* cb;
    __device__ __forceinline__ void operator()(const f32x4 (&acc)[2][2][4][2], const Unit& u, int wr, int wc, int fr, int fq) const {
        const int cg0 = 128 * u.pn + 32 * wc + 8 * fq;
#pragma unroll
        for (int n = 0; n < 2; ++n) {
            const int cg = cg0 + 4 * n;
            const f32x4 bg = *(const f32x4*)(cb + cg), bv = *(const f32x4*)(cb + 2816 + cg);
            const f32x4 g0 = *(const f32x4*)(cw + cg), g1 = *(const f32x4*)(cw + 5632 + cg), g2 = *(const f32x4*)(cw + 11264 + cg);
            const f32x4 v0 = *(const f32x4*)(cw + 2816 + cg), v1 = *(const f32x4*)(cw + 5632 + 2816 + cg), v2 = *(const f32x4*)(cw + 11264 + 2816 + cg);
#pragma unroll
            for (int ai = 0; ai < 2; ++ai) {
                const int rbase = 256 * u.pm + 128 * ai + 64 * wr, grp = rbase >> 6;
#pragma unroll
                for (int m = 0; m < 4; ++m) {
                    const f32x4 xg = acc[ai][0][m][n], xv = acc[ai][1][m][n];
                    const f32x4 yg = acc[ai][0][m > 0 ? m - 1 : 0][n], yv = acc[ai][1][m > 0 ? m - 1 : 0][n];
                    f32x4 gt, vl;
#pragma unroll
                    for (int e = 0; e < 4; ++e) {
                        const float u1 = dpp_ror1((fr == 15) ? yg[e] : xg[e]), u2 = dpp_ror2((fr >= 14) ? yg[e] : xg[e]);
                        gt[e] = bg[e] + g0[e] * u2 + g1[e] * u1 + g2[e] * xg[e];
                    }
#pragma unroll
                    for (int e = 0; e < 4; ++e) {
                        const float u1 = dpp_ror1((fr == 15) ? yv[e] : xv[e]), u2 = dpp_ror2((fr >= 14) ? yv[e] : xv[e]);
                        vl[e] = bv[e] + v0[e] * u2 + v1[e] * u1 + v2[e] * xv[e];
                    }
                    const size_t r = (size_t)(rbase + 16 * m + fr);
                    if (m > 0 || fr >= 2)
                        *(unsigned long long*)(act + r * 2816 + cg) = (unsigned long long)pk2(gt[0] * sigm(gt[0]) * vl[0], gt[1] * sigm(gt[1]) * vl[1]) | ((unsigned long long)pk2(gt[2] * sigm(gt[2]) * vl[2], gt[3] * sigm(gt[3]) * vl[3]) << 32);
                    if (m == 0 && fr < 2) {
                        bf16_t* d = hf + (size_t)(grp * 2 + fr) * 5632 + cg;
                        *(unsigned long long*)d = pk4(xg[0], xg[1], xg[2], xg[3]); *(unsigned long long*)(d + 2816) = pk4(xv[0], xv[1], xv[2], xv[3]);
                    }
                    if (m == 3 && fr >= 14) {
                        bf16_t* d = hl + (size_t)(grp * 2 + (fr - 14)) * 5632 + cg;
                        *(unsigned long long*)d = pk4(xg[0], xg[1], xg[2], xg[3]); *(unsigned long long*)(d + 2816) = pk4(xv[0], xv[1], xv[2], xv[3]);
                    }
                }
            }
        }
    }
};
__device__ __forceinline__ void conv_fixup(const Params& P, int layer, int tid) {
    const bf16_t* hl = (const bf16_t*)(P.ws + OFF_U); const bf16_t* hf = (const bf16_t*)(P.ws + OFF_U + 8 * MiB);
    bf16_t* ACT = (bf16_t*)(P.ws + OFF_ACT);
    const float* cw = P.in[I_CW] + (size_t)layer * 3 * 5632; const float* cb = P.in[I_CB] + (size_t)layer * 5632;
    for (int it = blockIdx.x * NTHREADS + tid; it < 256 * 2 * 352; it += gridDim.x * NTHREADS) {
        const int cgp = it % 352, rs = it / 352, j = rs >> 1, sidx = rs & 1, c = cgp * 8;
        u32x4 a2[2], a1[2], a0[2];
#pragma unroll
        for (int q = 0; q < 2; ++q) {
            const int off = q * 2816 + c;
            const u32x4 z = (u32x4){0u, 0u, 0u, 0u};
            const u32x4 l0 = (j > 0) ? *(const u32x4*)(hl + (size_t)((j - 1) * 2 + 0) * 5632 + off) : z;
            const u32x4 l1 = (j > 0) ? *(const u32x4*)(hl + (size_t)((j - 1) * 2 + 1) * 5632 + off) : z;
            const u32x4 f0 = *(const u32x4*)(hf + (size_t)(j * 2 + 0) * 5632 + off), f1 = *(const u32x4*)(hf + (size_t)(j * 2 + 1) * 5632 + off);
            if (sidx == 0) { a2[q] = l0; a1[q] = l1; a0[q] = f0; } else { a2[q] = l1; a1[q] = f0; a0[q] = f1; }
        }
        float res[8];
#pragma unroll
        for (int q = 0; q < 4; ++q) {
#pragma unroll
            for (int hh = 0; hh < 2; ++hh) {
                const int cc = c + 2 * q + hh;
                const float ug2 = hh ? bfhi(a2[0][q]) : bflo(a2[0][q]), ug1 = hh ? bfhi(a1[0][q]) : bflo(a1[0][q]), ug0 = hh ? bfhi(a0[0][q]) : bflo(a0[0][q]);
                const float uv2 = hh ? bfhi(a2[1][q]) : bflo(a2[1][q]), uv1 = hh ? bfhi(a1[1][q]) : bflo(a1[1][q]), uv0 = hh ? bfhi(a0[1][q]) : bflo(a0[1][q]);
                const float gt = cb[cc] + cw[cc] * ug2 + cw[5632 + cc] * ug1 + cw[11264 + cc] * ug0;
                const float vl = cb[2816 + cc] + cw[2816 + cc] * uv2 + cw[5632 + 2816 + cc] * uv1 + cw[11264 + 2816 + cc] * uv0;
                res[2 * q + hh] = gt * sigm(gt) * vl;
            }
        }
        u32x4 o; o.x = pk2(res[0], res[1]); o.y = pk2(res[2], res[3]); o.z = pk2(res[4], res[5]); o.w = pk2(res[6], res[7]);
        *(u32x4*)(ACT + (size_t)(64 * j + sidx) * 2816 + c) = o;
    }
}

template <class Epi> __device__ __forceinline__ void run_gemm(unsigned char* smem, const bf16_t* A, const bf16_t* Bt, int M, int N, int K, const Epi& E) {
    pg8::Gemm g; g.A = A; g.Bt = Bt; g.M = M; g.N = N; g.K = K;
    pg8::StaticOrder So; So.init(M, N, (int)gridDim.x, (int)blockIdx.x);
    pg8::gemm_phase<Epi, pg8::StaticOrder, false>((PG8_LAS unsigned char*)smem, g, So, E, nullptr);
}

constexpr int CMS = 1028;
__device__ __forceinline__ pg8::bf16x8 lds_f32x8_to_bf16(const float* p) {
    const f32x4 a = *(const f32x4*)p, b = *(const f32x4*)(p + 4);
    u32x4 w; w.x = pk2(a.x, a.y); w.y = pk2(a.z, a.w); w.z = pk2(b.x, b.y); w.w = pk2(b.z, b.w);
    return __builtin_bit_cast(pg8::bf16x8, w);
}
__device__ __forceinline__ void rwkv_prep(const Params& P, int layer, unsigned char* smem, int tid) {
    using pg8::bf16x8;
    float* cmL = (float*)smem;
    float* loraL = cmL + 16 * CMS;
    float* uL = loraL + 16 * 768;
    const bf16_t* ZC = (const bf16_t*)(P.ws + OFF_ZC);
    const bf16_t* WT = (const bf16_t*)(P.ws + OFF_WT);
    h16* VF = (h16*)(P.ws + OFF_VF);
    h16* RK = (h16*)(P.ws + OFF_RK);
    const float* mu = P.in[I_MU] + layer * 1024;
    const int j = tid & 255, th = tid >> 8, tb = th * 8;
    const int w = tid >> 6, lane = tid & 63, lr = lane & 15, lq = lane >> 4;
    const float w0j = P.in[I_W0][layer * 256 + j], a0j = P.in[I_A0][layer * 256 + j], kkj = P.in[I_KK][layer * 256 + j], kaj = P.in[I_KA][layer * 256 + j];
    const float v0j = (layer > 0) ? P.in[I_V0][j] : 0.f;
    float v2c[32];
#pragma unroll
    for (int m = 0; m < 32; ++m) v2c[m] = (layer > 0) ? P.in[I_V2][m * 256 + j] : 0.f;
    const int c2 = tid * 2;
    const float mu0 = mu[c2], mu1 = mu[c2 + 1];
    for (int tile = blockIdx.x; tile < S_ / 16; tile += gridDim.x) {
        const int t0 = tile * 16;
        __syncthreads();
        {
            unsigned cu[17];
            cu[0] = (t0 > 0) ? *(const unsigned*)(ZC + (size_t)(t0 - 1) * 1024 + c2) : 0u;
#pragma unroll
            for (int i = 0; i < 16; ++i) cu[i + 1] = *(const unsigned*)(ZC + (size_t)(t0 + i) * 1024 + c2);
#pragma unroll
            for (int i = 0; i < 16; ++i) {
                const float p0 = bflo(cu[i]), p1 = bfhi(cu[i]), c0 = bflo(cu[i + 1]), c1 = bfhi(cu[i + 1]);
                float m0 = c0 + (p0 - c0) * mu0, m1 = c1 + (p1 - c1) * mu1;
                if (c2 >= 768 && c2 < 832) { m0 = tanhf(m0); m1 = tanhf(m1); }
                else if (c2 >= 896) { m0 = sigm(m0); m1 = sigm(m1); }
                f32x2v mm; mm.x = m0; mm.y = m1;
                *(f32x2v*)(cmL + i * CMS + c2) = mm;
            }
        }
        __syncthreads();
        {
#pragma unroll 2
            for (int i = 0; i < 6; ++i) {
                const int nt = 6 * w + i, seg = nt >> 4, n0 = (nt & 15) * 16;
                const int cmoff = (seg == 0) ? 768 : (seg == 1 ? 832 : 896);
                f32x4 acc = (f32x4){0.f, 0.f, 0.f, 0.f};
                if (seg == 2) {
                    const bf16_t* Wp = WT + WT_G2 + (size_t)(n0 + lr) * 128 + 8 * lq;
                    bf16x8 bq[4];
#pragma unroll
                    for (int ks = 0; ks < 4; ++ks) bq[ks] = *(const bf16x8*)(Wp + 32 * ks);
#pragma unroll
                    for (int ks = 0; ks < 4; ++ks) acc = __builtin_amdgcn_mfma_f32_16x16x32_bf16(lds_f32x8_to_bf16(cmL + lr * CMS + cmoff + 32 * ks + 8 * lq), bq[ks], acc, 0, 0, 0);
                } else {
                    const bf16_t* Wp = WT + ((seg == 0) ? WT_W2 : WT_A2) + (size_t)(n0 + lr) * 64 + 8 * lq;
                    bf16x8 bq[2];
#pragma unroll
                    for (int ks = 0; ks < 2; ++ks) bq[ks] = *(const bf16x8*)(Wp + 32 * ks);
#pragma unroll
                    for (int ks = 0; ks < 2; ++ks) acc = __builtin_amdgcn_mfma_f32_16x16x32_bf16(lds_f32x8_to_bf16(cmL + lr * CMS + cmoff + 32 * ks + 8 * lq), bq[ks], acc, 0, 0, 0);
                }
#pragma unroll
                for (int e = 0; e < 4; ++e) loraL[(4 * lq + e) * 768 + seg * 256 + n0 + lr] = acc[e];
            }
            if (layer > 0 && w < 2) {
                f32x4 acc = (f32x4){0.f, 0.f, 0.f, 0.f};
                const bf16_t* Vp = WT + WT_V1 + (size_t)(16 * w + lr) * 256 + 8 * lq;
#pragma unroll
                for (int ks = 0; ks < 8; ++ks) {
                    const bf16x8 b = *(const bf16x8*)(Vp + 32 * ks);
                    const bf16x8 a = lds_f32x8_to_bf16(cmL + lr * CMS + 512 + 32 * ks + 8 * lq);
                    acc = __builtin_amdgcn_mfma_f32_16x16x32_bf16(a, b, acc, 0, 0, 0);
                }
#pragma unroll
                for (int e = 0; e < 4; ++e) uL[(4 * lq + e) * 32 + 16 * w + lr] = acc[e];
            }
        }
        __syncthreads();
#pragma unroll
        for (int tt = 0; tt < 8; ++tt) {
            const int t = t0 + tb + tt; const float* cr = cmL + (tb + tt) * CMS; const float* lo = loraL + (tb + tt) * 768;
            const float r = cr[j], k = cr[256 + j]; float v = cr[512 + j];
            const float x = -(w0j + lo[j]);
            const float sp = fmaxf(x, 0.f) + log1pf(__expf(-fabsf(x)));
            const float e = __expf(-sp - 0.5f);
            const float a = sigm(a0j + lo[256 + j]);
            const float g = lo[512 + j];
            if (layer == 0) { VF[(size_t)t * 256 + j] = (h16)v; }
            else {
                float acc = v0j;
#pragma unroll
                for (int m = 0; m < 32; ++m) acc += uL[(tb + tt) * 32 + m] * v2c[m];
                const float vf = (float)VF[(size_t)t * 256 + j];
                v = v + (vf - v) * sigm(acc);
            }
            float kk = k * kkj; const float ss = wave_sum(kk * kk); kk = kk / fmaxf(sqrtf(ss), 1e-12f);
            const float k2 = k * (1.f + (a - 1.f) * kaj);
            const size_t o = (size_t)t * 256 + j;
            RK[0 * RKSZ + o] = (h16)r; RK[1 * RKSZ + o] = (h16)k2; RK[2 * RKSZ + o] = (h16)v; RK[3 * RKSZ + o] = (h16)kk;
            RK[4 * RKSZ + o] = (h16)(kk * a); RK[5 * RKSZ + o] = (h16)e; RK[6 * RKSZ + o] = (h16)g;
        }
    }
}

constexpr int AT_VS = 280;
__device__ __forceinline__ void attn_partial(const Params& P, unsigned char* smem, int tid) {
    using pg8::bf16x8;
    const bf16_t* ZB = (const bf16_t*)(P.ws + OFF_ZB);
    bf16_t* MIX = (bf16_t*)(P.ws + OFF_HN);
    float* LSE = (float*)(P.ws + OFF_LSE);
    bf16_t* Vt = (bf16_t*)smem;
    const int w = tid >> 6, lane = tid & 63, lr = lane & 15, lq = lane >> 4;
    for (int item = blockIdx.x; item < 1536; item += gridDim.x) {
        const int p = item >> 9, rem = item & 511, h = rem & 3, rest = rem >> 2;
        const int d = (p == 0) ? 1 : (p == 1 ? 4 : 16);
        const int nqb = 128 / d, r = rest / nqb, qb = rest % nqb;
        const int L0 = qb * 128, l0 = L0 + 16 * w;
        __syncthreads();
        {
            const int kl = tid & 255, hf = tid >> 8, kidx = L0 - 128 + kl;
            u32x4 x[4];
            if (kidx >= 0) {
                const u32x4* src = (const u32x4*)(ZB + (size_t)(kidx * d + r) * 768 + 512 + h * 64 + 32 * hf);
#pragma unroll
                for (int c = 0; c < 4; ++c) x[c] = src[c];
            } else {
#pragma unroll
                for (int c = 0; c < 4; ++c) x[c] = (u32x4){0u, 0u, 0u, 0u};
            }
#pragma unroll
            for (int c = 0; c < 4; ++c)
#pragma unroll
                for (int e = 0; e < 4; ++e) {
                    const unsigned u = x[c][e];
                    Vt[(32 * hf + 8 * c + 2 * e) * AT_VS + kl] = (bf16_t)(u & 0xffffu);
                    Vt[(32 * hf + 8 * c + 2 * e + 1) * AT_VS + kl] = (bf16_t)(u >> 16);
                }
            *(unsigned*)(Vt + (tid >> 3) * AT_VS + 256 + (tid & 7) * 2) = 0u;
        }
        __syncthreads();
        const size_t qtok = (size_t)((l0 + lr) * d + r);
        bf16x8 qf[2];
#pragma unroll
        for (int ks = 0; ks < 2; ++ks) qf[ks] = *(const bf16x8*)(ZB + qtok * 768 + h * 64 + 32 * ks + 8 * lq);
        f32x4 sc[9];
#pragma unroll
        for (int kt = 0; kt < 9; ++kt) {
            const int kbase = l0 - 128 + 16 * kt;
            sc[kt] = (f32x4){0.f, 0.f, 0.f, 0.f};
            if (kbase >= 0) {
                const bf16_t* kp = ZB + (size_t)((kbase + lr) * d + r) * 768 + 256 + h * 64 + 8 * lq;
                const bf16x8 a0 = *(const bf16x8*)kp, a1 = *(const bf16x8*)(kp + 32);
                sc[kt] = __builtin_amdgcn_mfma_f32_16x16x32_bf16(a0, qf[0], sc[kt], 0, 0, 0);
                sc[kt] = __builtin_amdgcn_mfma_f32_16x16x32_bf16(a1, qf[1], sc[kt], 0, 0, 0);
            }
        }
        const int qidx = l0 + lr;
        float m = -1e30f;
#pragma unroll
        for (int kt = 0; kt < 9; ++kt)
#pragma unroll
            for (int e = 0; e < 4; ++e) {
                const int kidx = l0 - 128 + 16 * kt + 4 * lq + e;
                const bool valid = (kidx >= 0) && (kidx <= qidx) && (kidx >= qidx - 128);
                const float sv = valid ? sc[kt][e] * 0.125f : -1e30f;
                sc[kt][e] = sv; m = fmaxf(m, sv);
            }
        m = fmaxf(m, __shfl_xor(m, 16)); m = fmaxf(m, __shfl_xor(m, 32));
        float sum = 0.f;
#pragma unroll
        for (int kt = 0; kt < 9; ++kt)
#pragma unroll
            for (int e = 0; e < 4; ++e) {
                const float sv = sc[kt][e];
                const float pv = (sv > -1e29f) ? __expf(sv - m) : 0.f;
                sc[kt][e] = pv; sum += pv;
            }
        sum += __shfl_xor(sum, 16); sum += __shfl_xor(sum, 32);
        f32x4 acc[4];
#pragma unroll
        for (int n = 0; n < 4; ++n) acc[n] = (f32x4){0.f, 0.f, 0.f, 0.f};
#pragma unroll
        for (int s5 = 0; s5 < 5; ++s5) {
            u32x4 pw;
            pw.x = pk2(sc[2 * s5][0], sc[2 * s5][1]); pw.y = pk2(sc[2 * s5][2], sc[2 * s5][3]);
            if (s5 < 4) { pw.z = pk2(sc[2 * s5 + 1][0], sc[2 * s5 + 1][1]); pw.w = pk2(sc[2 * s5 + 1][2], sc[2 * s5 + 1][3]); } else { pw.z = 0u; pw.w = 0u; }
            const bf16x8 pf = __builtin_bit_cast(bf16x8, pw);
#pragma unroll
            for (int n = 0; n < 4; ++n) {
                const bf16_t* vp = Vt + (16 * n + lr) * AT_VS + 16 * w + 32 * s5 + 4 * lq;
                const f32x2v lo = *(const f32x2v*)vp, hi = *(const f32x2v*)(vp + 16);
                f32x4 vv; vv.x = lo.x; vv.y = lo.y; vv.z = hi.x; vv.w = hi.y;
                const bf16x8 vf = __builtin_bit_cast(bf16x8, vv);
                acc[n] = __builtin_amdgcn_mfma_f32_16x16x32_bf16(vf, pf, acc[n], 0, 0, 0);
            }
        }
        const float inv = 1.f / sum;
        const int slot = ((p == 0) ? 0 : (p == 1 ? 256 : 768)) + h * 64;
        bf16_t* orow = MIX + qtok * 1024 + slot + 4 * lq;
#pragma unroll
        for (int n = 0; n < 4; ++n) {
            const unsigned long long o8 = (unsigned long long)pk2(acc[n][0] * inv, acc[n][1] * inv) | ((unsigned long long)pk2(acc[n][2] * inv, acc[n][3] * inv) << 32);
            *(unsigned long long*)(orow + 16 * n) = o8;
        }
        if (lq == 0) LSE[((size_t)p * S_ + qtok) * 4 + h] = m + __logf(sum);
    }
}

__device__ __forceinline__ void attn_combine(const Params& P, int tid) {
    bf16_t* MIX = (bf16_t*)(P.ws + OFF_HN);
    const float* LSE = (const float*)(P.ws + OFF_LSE);
    const int total = S_ * 4 * 8;
    for (int it = blockIdx.x * NTHREADS + tid; it < total; it += gridDim.x * NTHREADS) {
        const int c8 = it & 7, h = (it >> 3) & 3, t = it >> 5;
        const float l0 = LSE[((size_t)0 * S_ + t) * 4 + h], l1 = LSE[((size_t)1 * S_ + t) * 4 + h], l2 = LSE[((size_t)2 * S_ + t) * 4 + h];
        const float mx = fmaxf(l0, fmaxf(l1, l2));
        float w0 = __expf(l0 - mx), w1 = __expf(l1 - mx), w2 = __expf(l2 - mx);
        const float inv = 1.f / (w0 + w1 + w2); w0 *= inv; w1 *= inv; w2 *= inv;
        const size_t rb = (size_t)t * 1024 + h * 64 + c8 * 8;
        const u32x4 a = *(const u32x4*)(MIX + rb), b = *(const u32x4*)(MIX + rb + 256), c = *(const u32x4*)(MIX + rb + 768);
        u32x4 o;
        o.x = pk2(w0 * bflo(a.x) + w1 * bflo(b.x) + w2 * bflo(c.x), w0 * bfhi(a.x) + w1 * bfhi(b.x) + w2 * bfhi(c.x));
        o.y = pk2(w0 * bflo(a.y) + w1 * bflo(b.y) + w2 * bflo(c.y), w0 * bfhi(a.y) + w1 * bfhi(b.y) + w2 * bfhi(c.y));
        o.z = pk2(w0 * bflo(a.z) + w1 * bflo(b.z) + w2 * bflo(c.z), w0 * bfhi(a.z) + w1 * bfhi(b.z) + w2 * bfhi(c.z));
        o.w = pk2(w0 * bflo(a.w) + w1 * bflo(b.w) + w2 * bflo(c.w), w0 * bfhi(a.w) + w1 * bfhi(b.w) + w2 * bfhi(c.w));
        *(u32x4*)(MIX + rb + 512) = o;
    }
}

__device__ __forceinline__ float hgrn_lb(const Params& P, int layer, int idx) {
    if (layer == 0) return 0.f;
    return sigm(P.in[I_LB][512 + idx] - P.in[I_LB][idx]);
}

__device__ __forceinline__ void hgrn_pass1(const Params& P, int layer, unsigned char* smem, int tid) {
    using pg8::bf16x8;
    bf16_t* Vt = (bf16_t*)smem;
    bf16_t* KhT = Vt + 128 * 72;
    float* tot = (float*)(KhT + 128 * 72);
    bf16_t* Rf = (bf16_t*)(tot + 512);
    bf16_t* Ri = Rf + 64 * 128;
    const bf16_t* ZH = (const bf16_t*)(P.ws + OFF_ZH);
    bf16_t* NC = (bf16_t*)(P.ws + OFF_ZC);
    float* GB = (float*)(P.ws + OFF_GB);
    const int k = tid & 127, qd = tid >> 7;
    const int w = tid >> 6, lane = tid & 63, lr = lane & 15, lq = lane >> 4;
    for (int item = blockIdx.x; item < 1024; item += gridDim.x) {
        const int c = item >> 2, h = item & 3, t0 = c * 64;
        const float lbv = hgrn_lb(P, layer, h * 128 + k);
        __syncthreads();
        {
            u32x4 rv[4];
#pragma unroll
            for (int e = 0; e < 4; ++e) { const int ch = tid + 512 * (e & 1), row = ch >> 4, c8 = (ch & 15) * 8;
                rv[e] = *(const u32x4*)(ZH + (size_t)(t0 + row) * 2048 + ((e < 2) ? 512 : 1024) + h * 128 + c8); }
#pragma unroll
            for (int e = 0; e < 4; ++e) { const int ch = tid + 512 * (e & 1), row = ch >> 4, c8 = (ch & 15) * 8;
                *(u32x4*)(((e < 2) ? Rf : Ri) + row * 128 + c8) = rv[e]; }
        }
        __syncthreads();
        float fl[16], bl[16]; float run = 0.f;
#pragma unroll
        for (int i = 0; i < 16; ++i) {
            const float fr = bf2f(Rf[(16 * qd + i) * 128 + k]);
            const float f = lbv + (1.f - lbv) * sigm(fr);
            fl[i] = f; run += __logf(f); bl[i] = run;
            Vt[k * 72 + 16 * qd + i] = Ri[(16 * qd + i) * 128 + k];
        }
        tot[qd * 128 + k] = run;
        __syncthreads();
        float pre = 0.f, all = 0.f;
#pragma unroll
        for (int q = 0; q < 4; ++q) { const float x = tot[q * 128 + k]; if (q < qd) pre += x; all += x; }
        {
            float kh[16];
#pragma unroll
            for (int i = 0; i < 16; ++i) kh[i] = (1.f - fl[i]) * __expf(all - (pre + bl[i]));
            u32x4 w0, w1;
            w0.x = pk2(kh[0], kh[1]); w0.y = pk2(kh[2], kh[3]); w0.z = pk2(kh[4], kh[5]); w0.w = pk2(kh[6], kh[7]);
            w1.x = pk2(kh[8], kh[9]); w1.y = pk2(kh[10], kh[11]); w1.z = pk2(kh[12], kh[13]); w1.w = pk2(kh[14], kh[15]);
            *(u32x4*)(KhT + k * 72 + 16 * qd) = w0; *(u32x4*)(KhT + k * 72 + 16 * qd + 8) = w1;
        }
        if (qd == 0) GB[(size_t)(c * 4 + h) * 128 + k] = __expf(all);
        __syncthreads();
        bf16x8 af[2];
#pragma unroll
        for (int ks = 0; ks < 2; ++ks) af[ks] = *(const bf16x8*)(KhT + (16 * w + lr) * 72 + 32 * ks + 8 * lq);
#pragma unroll
        for (int vt = 0; vt < 8; ++vt) {
            f32x4 acc = (f32x4){0.f, 0.f, 0.f, 0.f};
#pragma unroll
            for (int ks = 0; ks < 2; ++ks) {
                const bf16x8 b = *(const bf16x8*)(Vt + (16 * vt + lr) * 72 + 32 * ks + 8 * lq);
                acc = __builtin_amdgcn_mfma_f32_16x16x32_bf16(af[ks], b, acc, 0, 0, 0);
            }
            *(unsigned long long*)(NC + ((size_t)(c * 4 + h) * 128 + 16 * vt + lr) * 128 + 16 * w + 4 * lq) = (unsigned long long)pk2_sw(acc[0], acc[1]) | ((unsigned long long)pk2_sw(acc[2], acc[3]) << 32);
        }
    }
}

__device__ __forceinline__ void hgrn_scan(const Params& P, int tid) {
    bf16_t* NC = (bf16_t*)(P.ws + OFF_ZC);
    const float* GB = (const float*)(P.ws + OFF_GB);
    if (tid >= 128) return;
    for (int e = blockIdx.x * 128 + tid; e < 32768; e += gridDim.x * 128) {
        const int h = e >> 13, vr = (e >> 6) & 127, k2 = e & 63;
        float s0 = 0.f, s1 = 0.f;
        for (int c0 = 0; c0 < 256; c0 += 32) {
            unsigned n[32]; f32x2v g[32];
#pragma unroll
            for (int u = 0; u < 32; ++u) {
                n[u] = *(const unsigned*)(NC + ((size_t)((c0 + u) * 4 + h) * 128 + vr) * 128 + 2 * k2);
                g[u] = *(const f32x2v*)(GB + (size_t)((c0 + u) * 4 + h) * 128 + 2 * k2);
            }
#pragma unroll
            for (int u = 0; u < 32; ++u) {
                *(unsigned*)(NC + ((size_t)((c0 + u) * 4 + h) * 128 + vr) * 128 + 2 * k2) = pk2(s0, s1);
                s0 = g[u].x * s0 + bflo(n[u]); s1 = g[u].y * s1 + bfhi(n[u]);
            }
        }
    }
}

constexpr int H3_QS = 136, H3_VS = 72;
__device__ __forceinline__ void hgrn_pass3_item(const Params& P, int layer, unsigned char* smem, int tid, int item) {
    using pg8::bf16x8;
    bf16_t* Qt = (bf16_t*)smem;
    bf16_t* Kt = Qt + 64 * H3_QS;
    bf16_t* Qh = Kt + 64 * H3_QS;
    bf16_t* Vt = Qh + 64 * H3_QS;
    float* tot = (float*)(Vt + 128 * H3_VS);
    float* ssq = tot + 512;
    bf16_t* Rq = (bf16_t*)(ssq + 128);
    const bf16_t* ZH = (const bf16_t*)(P.ws + OFF_ZH);
    const bf16_t* NC = (const bf16_t*)(P.ws + OFF_ZC);
    bf16_t* MIX = (bf16_t*)(P.ws + OFF_HN);
    const int c = item >> 2, h = item & 3, t0 = c * 64;
    const int w3 = tid >> 6, lr3 = tid & 15, lq3 = (tid & 63) >> 4;
    bf16x8 sfr[4][4]; unsigned long long graw[4];
    {
        const int k = tid & 127, qd = tid >> 7;
        const float lbv = hgrn_lb(P, layer, h * 128 + k);
        __syncthreads();
        {
            u32x4 rv[6];
#pragma unroll
            for (int e = 0; e < 6; ++e) { const int ch = tid + 512 * (e & 1), row = ch >> 4, c8 = (ch & 15) * 8;
                rv[e] = *(const u32x4*)(ZH + (size_t)(t0 + row) * 2048 + 512 * (e >> 1) + h * 128 + c8); }
#pragma unroll
            for (int e = 0; e < 6; ++e) { const int ch = tid + 512 * (e & 1), row = ch >> 4, c8 = (ch & 15) * 8;
                *(u32x4*)(Rq + (e >> 1) * (64 * 128) + row * 128 + c8) = rv[e]; }
        }
        __syncthreads();
        const bf16_t* Rf = Rq + 64 * 128; const bf16_t* Ri = Rf + 64 * 128;
        float fl[16], bl[16], qv[16]; float run = 0.f;
#pragma unroll
        for (int i = 0; i < 16; ++i) {
            const float qr = bf2f(Rq[(16 * qd + i) * 128 + k]);
            const float fr = bf2f(Rf[(16 * qd + i) * 128 + k]);
            const float f = lbv + (1.f - lbv) * sigm(fr);
            fl[i] = f; run += __logf(f); bl[i] = run; qv[i] = qr * sigm(qr);
            Vt[k * H3_VS + 16 * qd + i] = Ri[(16 * qd + i) * 128 + k];
        }
        tot[qd * 128 + k] = run;
        __syncthreads();
        float pre = 0.f;
#pragma unroll
        for (int q = 0; q < 4; ++q) { const float x = tot[q * 128 + k]; if (q < qd) pre += x; }
        const float rho = tot[k] + tot[128 + k];
#pragma unroll
        for (int i = 0; i < 16; ++i) {
            const float b = pre + bl[i]; const int row = 16 * qd + i;
            Qt[row * H3_QS + k] = f2bf(qv[i] * __expf(b - rho));
            Kt[row * H3_QS + k] = f2bf((1.f - fl[i]) * __expf(rho - b));
            Qh[row * H3_QS + k] = f2bf(qv[i] * __expf(b));
        }
#pragma unroll
        for (int vt = 0; vt < 4; ++vt) {
            const bf16_t* Sr = NC + ((size_t)(c * 4 + h) * 128 + 64 * (w3 >> 2) + 16 * vt + lr3) * 128 + 8 * lq3;
#pragma unroll
            for (int ks = 0; ks < 4; ++ks) sfr[vt][ks] = *(const bf16x8*)(Sr + 32 * ks);
            graw[vt] = *(const unsigned long long*)(ZH + (size_t)(t0 + 16 * (w3 & 3) + lr3) * 2048 + 1536 + h * 128 + 64 * (w3 >> 2) + 16 * vt + 4 * lq3);
        }
        __syncthreads();
    }
    const int w = tid >> 6, lane = tid & 63, lr = lane & 15, lq = lane >> 4, ti = w & 3, vh = w >> 2;
    f32x4 sc[4];
#pragma unroll
    for (int jt = 0; jt < 4; ++jt) {
        sc[jt] = (f32x4){0.f, 0.f, 0.f, 0.f};
        if (jt <= ti) {
#pragma unroll
            for (int ks = 0; ks < 4; ++ks) {
                const bf16x8 a = *(const bf16x8*)(Kt + (16 * jt + lr) * H3_QS + 32 * ks + 8 * lq);
                const bf16x8 b = *(const bf16x8*)(Qt + (16 * ti + lr) * H3_QS + 32 * ks + 8 * lq);
                sc[jt] = __builtin_amdgcn_mfma_f32_16x16x32_bf16(a, b, sc[jt], 0, 0, 0);
            }
            if (jt == ti) {
#pragma unroll
                for (int e = 0; e < 4; ++e) if (4 * lq + e > lr) sc[jt][e] = 0.f;
            }
        }
    }
    bf16x8 pf[2];
#pragma unroll
    for (int s2 = 0; s2 < 2; ++s2) {
        u32x4 pw; pw.x = pk2_sw(sc[2 * s2][0], sc[2 * s2][1]); pw.y = pk2_sw(sc[2 * s2][2], sc[2 * s2][3]); pw.z = pk2_sw(sc[2 * s2 + 1][0], sc[2 * s2 + 1][1]); pw.w = pk2_sw(sc[2 * s2 + 1][2], sc[2 * s2 + 1][3]);
        pf[s2] = __builtin_bit_cast(bf16x8, pw);
    }
    bf16x8 qh[4];
#pragma unroll
    for (int ks = 0; ks < 4; ++ks) qh[ks] = *(const bf16x8*)(Qh + (16 * ti + lr) * H3_QS + 32 * ks + 8 * lq);
    f32x4 acc[4]; float ss = 0.f;
#pragma unroll
    for (int vt = 0; vt < 4; ++vt) {
        const int v0 = 64 * vh + 16 * vt;
        acc[vt] = (f32x4){0.f, 0.f, 0.f, 0.f};
#pragma unroll
        for (int ks = 0; ks < 4; ++ks) acc[vt] = __builtin_amdgcn_mfma_f32_16x16x32_bf16(sfr[vt][ks], qh[ks], acc[vt], 0, 0, 0);
#pragma unroll
        for (int s2 = 0; s2 < 2; ++s2) {
            const bf16_t* vp = Vt + (v0 + lr) * H3_VS + 32 * s2 + 4 * lq;
            const f32x2v lo = *(const f32x2v*)vp, hi = *(const f32x2v*)(vp + 16);
            f32x4 vv; vv.x = lo.x; vv.y = lo.y; vv.z = hi.x; vv.w = hi.y;
            acc[vt] = __builtin_amdgcn_mfma_f32_16x16x32_bf16(__builtin_bit_cast(bf16x8, vv), pf[s2], acc[vt], 0, 0, 0);
        }
        ss += (acc[vt][0] * acc[vt][0] + acc[vt][1] * acc[vt][1]) + (acc[vt][2] * acc[vt][2] + acc[vt][3] * acc[vt][3]);
    }
    ss += __shfl_xor(ss, 16); ss += __shfl_xor(ss, 32);
    if (lq == 0) ssq[vh * 64 + 16 * ti + lr] = ss;
    __syncthreads();
    const float rinv = rsqrtf((ssq[16 * ti + lr] + ssq[64 + 16 * ti + lr]) * (1.f / 128.f) + 1e-6f);
    const size_t t = (size_t)(t0 + 16 * ti + lr);
#pragma unroll
    for (int vt = 0; vt < 4; ++vt) {
        const int v = 64 * vh + 16 * vt + 4 * lq;
        const f32x4 gn = *(const f32x4*)(P.in[I_GN] + layer * 512 + h * 128 + v);
        const unsigned long long gr8 = graw[vt];
        const float g0 = bflo((unsigned)gr8), g1 = bfhi((unsigned)gr8), g2 = bflo((unsigned)(gr8 >> 32)), g3 = bfhi((unsigned)(gr8 >> 32));
        const float o0 = acc[vt][0] * rinv * gn.x * g0 * sigm(g0), o1 = acc[vt][1] * rinv * gn.y * g1 * sigm(g1);
        const float o2 = acc[vt][2] * rinv * gn.z * g2 * sigm(g2), o3 = acc[vt][3] * rinv * gn.w * g3 * sigm(g3);
        *(unsigned long long*)(MIX + t * 1024 + h * 128 + v) = (unsigned long long)pk2(o0, o1) | ((unsigned long long)pk2(o2, o3) << 32);
    }
}

__device__ __forceinline__ float dpp_f(float x, const int ctrl_sel) {
    const int xi = __float_as_int(x); int r;
    if (ctrl_sel == 0) r = __builtin_amdgcn_update_dpp(0, xi, 0xB1, 0xF, 0xF, true);
    else if (ctrl_sel == 1) r = __builtin_amdgcn_update_dpp(0, xi, 0x4E, 0xF, 0xF, true);
    else if (ctrl_sel == 2) r = __builtin_amdgcn_update_dpp(0, xi, 0x141, 0xF, 0xF, true);
    else r = __builtin_amdgcn_update_dpp(0, xi, 0x140, 0xF, 0xF, true);
    return __int_as_float(r);
}
__device__ __forceinline__ float sum16(float x) { x += dpp_f(x, 0); x += dpp_f(x, 1); x += dpp_f(x, 2); x += dpp_f(x, 3); return x; }

constexpr int RS_T = 32;
constexpr int RS_BUF = 5 * RS_T * 64 + RS_T * 32;
constexpr int RS_G = 32, RS_LS = S_ / RS_G, RS_CPS = RS_LS / RS_T;
__device__ __forceinline__ void rwkv_scan_load(const h16* RK, float* buf, int ch, int h, int vrg, int lt) {
    const int tok = lt >> 3, col = (lt & 7) * 8; const size_t t = (size_t)ch * RS_T + tok;
    const size_t go = t * 256 + h * 64 + col;
    const h16x8 hv0 = *(const h16x8*)(RK + (size_t)5 * RKSZ + go);
    const h16x8 hv1 = *(const h16x8*)(RK + (size_t)3 * RKSZ + go);
    const h16x8 hv2 = *(const h16x8*)(RK + (size_t)4 * RKSZ + go);
    const h16x8 hv3 = *(const h16x8*)(RK + (size_t)1 * RKSZ + go);
    const h16x8 hv4 = *(const h16x8*)(RK + (size_t)0 * RKSZ + go);
    h16x4 vh; vh[0] = (h16)0.f; vh[1] = (h16)0.f; vh[2] = (h16)0.f; vh[3] = (h16)0.f;
    if (vrg >= 0) vh = *(const h16x4*)(RK + (size_t)2 * RKSZ + t * 256 + h * 64 + 32 * vrg + 4 * (lt & 7));
    const h16x8 hvs[5] = {hv0, hv1, hv2, hv3, hv4};
#pragma unroll
    for (int a = 0; a < 5; ++a) {
        const h16x8 hv = hvs[a];
        f32x4 lo, hi;
        lo.x = (float)hv[0]; lo.y = (float)hv[1]; lo.z = (float)hv[2]; lo.w = (float)hv[3]; hi.x = (float)hv[4]; hi.y = (float)hv[5]; hi.z = (float)hv[6]; hi.w = (float)hv[7];
        if (a == 0) { lo.x = __expf(-lo.x); lo.y = __expf(-lo.y); lo.z = __expf(-lo.z); lo.w = __expf(-lo.w); hi.x = __expf(-hi.x); hi.y = __expf(-hi.y); hi.z = __expf(-hi.z); hi.w = __expf(-hi.w); }
        float* d = buf + a * (RS_T * 64) + tok * 64 + col;
        *(f32x4*)d = lo; *(f32x4*)(d + 4) = hi;
    }
    f32x4 vf; vf.x = (float)vh[0]; vf.y = (float)vh[1]; vf.z = (float)vh[2]; vf.w = (float)vh[3];
    *(f32x4*)(buf + 5 * RS_T * 64 + tok * 32 + 4 * (lt & 7)) = vf;
}
__device__ __forceinline__ void hgrn_scan_slice(const Params& P, int t, int slice, float& s0, float& s1) {
    bf16_t* NC = (bf16_t*)(P.ws + OFF_ZC);
    const float* GB = (const float*)(P.ws + OFF_GB);
    const int e = blockIdx.x * 128 + t;
    const int h = e >> 13, vr = (e >> 6) & 127, k2 = e & 63;
    const int c0 = 16 * slice;
    unsigned n[16]; f32x2v g[16];
#pragma unroll
    for (int u = 0; u < 16; ++u) {
        n[u] = *(const unsigned*)(NC + ((size_t)((c0 + u) * 4 + h) * 128 + vr) * 128 + 2 * k2);
        g[u] = *(const f32x2v*)(GB + (size_t)((c0 + u) * 4 + h) * 128 + 2 * k2);
    }
#pragma unroll
    for (int u = 0; u < 16; ++u) {
        *(unsigned*)(NC + ((size_t)((c0 + u) * 4 + h) * 128 + vr) * 128 + 2 * k2) = pk2(s0, s1);
        s0 = g[u].x * s0 + bflo(n[u]); s1 = g[u].y * s1 + bfhi(n[u]);
    }
}
template <bool PASS_A> __device__ __forceinline__ void rwkv_seg_job(const Params& P, unsigned char* smem, int tid, int g, int h, int rgx, bool chain_only = false, bool side_scan = false) {
    float* L = (float*)smem;
    float* srow = L + 2 * RS_BUF;
    const h16* RK = (const h16*)(P.ws + OFF_RK);
    float* LX = (float*)(P.ws + OFF_LX);
    bf16_t* MIX = (bf16_t*)(P.ws + OFF_HN);
    const int w = tid >> 6, lane = tid & 63;
    const int row = 8 * (w & 3) + 2 * (lane >> 4), ks = lane & 15;
    const bool ident = PASS_A && (rgx >= 2);
    const int vrg = ident ? -1 : rgx;
    const int ch0 = g * RS_CPS;
    __syncthreads();
    f32x4 sA = (f32x4){0.f, 0.f, 0.f, 0.f}, sB = sA;
    if (PASS_A) {
        if (ident) {
            const int ra = 32 * (rgx - 2) + row, rb = ra + 1;
            sA.x = (4 * ks + 0 == ra) ? 1.f : 0.f; sA.y = (4 * ks + 1 == ra) ? 1.f : 0.f; sA.z = (4 * ks + 2 == ra) ? 1.f : 0.f; sA.w = (4 * ks + 3 == ra) ? 1.f : 0.f;
            sB.x = (4 * ks + 0 == rb) ? 1.f : 0.f; sB.y = (4 * ks + 1 == rb) ? 1.f : 0.f; sB.z = (4 * ks + 2 == rb) ? 1.f : 0.f; sB.w = (4 * ks + 3 == rb) ? 1.f : 0.f;
        }
    } else {
        float* Xl = L;
        float* sr = srow + row * 64;
        const int lt = tid - 256;
        float* S0 = (float*)(P.ws + OFF_S0);
        if (!chain_only && g > 0 && w < 4) { const float* Sb = S0 + ((size_t)(g * 4 + h) * 64 + 32 * rgx + row) * 64 + 4 * ks; sA = *(const f32x4*)Sb; sB = *(const f32x4*)(Sb + 64); }
        const int gend = chain_only ? g : 0;
        float* srC = L + 8 * 4096 + row * 64;
        const int nrounds = (gend + 3) >> 2;
        if (gend > 0 && w >= 4) {
            f32x4 xr[4][4];
#pragma unroll
            for (int q = 0; q < 4; ++q)
#pragma unroll
                for (int e = 0; e < 4; ++e)
                    xr[q][e] = (q < gend) ? *(const f32x4*)(LX + ((size_t)(q * 4 + h) * 128 + 64) * 64 + (size_t)(lt + 256 * e) * 4) : (f32x4){0.f, 0.f, 0.f, 0.f};
#pragma unroll
            for (int q = 0; q < 4; ++q)
#pragma unroll
                for (int e = 0; e < 4; ++e) *(f32x4*)(Xl + q * 4096 + (lt + 256 * e) * 4) = xr[q][e];
        }
        if (gend > 0) __syncthreads();
        for (int r = 0; r < nrounds; ++r) {
            const int g0 = 4 * r, nb = (gend - g0 < 4) ? (gend - g0) : 4;
            float* Xc = Xl + (r & 1) * (4 * 4096);
            if (w >= 4) {
                if (r + 1 < nrounds) {
                    float* Xn = Xl + ((r + 1) & 1) * (4 * 4096); const int gn = g0 + 4, nn = (gend - gn < 4) ? (gend - gn) : 4;
                    f32x4 xr[4][4];
#pragma unroll
                    for (int q = 0; q < 4; ++q)
#pragma unroll
                        for (int e = 0; e < 4; ++e)
                            xr[q][e] = (q < nn) ? *(const f32x4*)(LX + ((size_t)((gn + q) * 4 + h) * 128 + 64) * 64 + (size_t)(lt + 256 * e) * 4) : (f32x4){0.f, 0.f, 0.f, 0.f};
#pragma unroll
                    for (int q = 0; q < 4; ++q)
#pragma unroll
                        for (int e = 0; e < 4; ++e) *(f32x4*)(Xn + q * 4096 + (lt + 256 * e) * 4) = xr[q][e];
                }
            } else {
                for (int q = 0; q < nb; ++q) {
                    const float* Xb = Xc + q * 4096 + 4 * ks;
                    const float* Lb = LX + ((size_t)((g0 + q) * 4 + h) * 128 + 32 * rgx + row) * 64 + 4 * ks;
                    f32x4 nA = *(const f32x4*)Lb, nB = *(const f32x4*)(Lb + 64);
                    *(f32x4*)(srC + 4 * ks) = sA; *(f32x4*)(srC + 64 + 4 * ks) = sB;
                    lds_wait();
#pragma unroll 8
                    for (int kp = 0; kp < 64; ++kp) {
                        const float ska = srC[kp], skb = srC[64 + kp]; const f32x4 xv = *(const f32x4*)(Xb + kp * 64);
                        nA.x += ska * xv.x; nA.y += ska * xv.y; nA.z += ska * xv.z; nA.w += ska * xv.w;
                        nB.x += skb * xv.x; nB.y += skb * xv.y; nB.z += skb * xv.z; nB.w += skb * xv.w;
                    }
                    lds_wait();
                    sA = nA; sB = nB;
                    float* dst = S0 + ((size_t)((g0 + q + 1) * 4 + h) * 64 + 32 * rgx + row) * 64 + 4 * ks;
                    *(f32x4*)dst = sA; *(f32x4*)(dst + 64) = sB;
                }
            }
            __syncthreads();
        }
        if (chain_only) return;
    }
    if (w >= 4) rwkv_scan_load(RK, L, ch0, h, vrg, tid - 256);
    __syncthreads();
    float sc0 = 0.f, sc1 = 0.f;
    for (int cc = 0; cc < RS_CPS; ++cc) {
        const int ch = ch0 + cc;
        float* buf = L + (cc & 1) * RS_BUF;
        if (w >= 4) {
            if (cc + 1 < RS_CPS) rwkv_scan_load(RK, L + ((cc + 1) & 1) * RS_BUF, ch + 1, h, vrg, tid - 256);
            if (PASS_A && side_scan && w >= 6) hgrn_scan_slice(P, tid - 384, cc, sc0, sc1);
        }
        else {
            const unsigned abase = (unsigned)(size_t)(PG8_LAS float*)buf + 16u * (unsigned)ks;
            const unsigned vbase = (unsigned)(size_t)(PG8_LAS float*)buf + (unsigned)(5 * RS_T * 64 + row) * 4u;
            f32x4 w4n, kk4n, b4n, k4n, r4n = (f32x4){0.f, 0.f, 0.f, 0.f}; f32x2v vvn;
#define RS_LD(tn) do { const unsigned _a = abase + (unsigned)(tn) * 256u; \
                asm volatile("ds_read_b128 %0, %1" : "=v"(w4n) : "v"(_a) : "memory"); \
                asm volatile("ds_read_b128 %0, %1 offset:8192" : "=v"(kk4n) : "v"(_a) : "memory"); \
                asm volatile("ds_read_b128 %0, %1 offset:16384" : "=v"(b4n) : "v"(_a) : "memory"); \
                asm volatile("ds_read_b128 %0, %1 offset:24576" : "=v"(k4n) : "v"(_a) : "memory"); \
                if (!PASS_A) asm volatile("ds_read_b128 %0, %1 offset:32768" : "=v"(r4n) : "v"(_a) : "memory"); \
                { const unsigned _v = vbase + (unsigned)(tn) * 128u; asm volatile("ds_read_b64 %0, %1" : "=v"(vvn) : "v"(_v) : "memory"); } } while (0)
            RS_LD(0);
            float ykA = 0.f, ykB = 0.f;
#pragma unroll 4
            for (int tt = 0; tt < RS_T; ++tt) {
                if (PASS_A) asm volatile("s_waitcnt lgkmcnt(0)" : "+v"(w4n), "+v"(kk4n), "+v"(b4n), "+v"(k4n), "+v"(vvn), "+v"(sA), "+v"(sB) :: "memory");
                else asm volatile("s_waitcnt lgkmcnt(0)" : "+v"(w4n), "+v"(kk4n), "+v"(b4n), "+v"(k4n), "+v"(r4n), "+v"(vvn), "+v"(sA), "+v"(sB) :: "memory");
                const f32x4 w4 = w4n, kk4 = kk4n, b4 = b4n, k4 = k4n, r4 = r4n; const f32x2v vv = vvn;
                const int tn = (tt + 1 < RS_T) ? tt + 1 : tt;
                RS_LD(tn);
                const float dA = (sA.x * kk4.x + sA.y * kk4.y) + (sA.z * kk4.z + sA.w * kk4.w);
                const float dB = (sB.x * kk4.x + sB.y * kk4.y) + (sB.z * kk4.z + sB.w * kk4.w);
                const float saA = -sum16(dA), saB = -sum16(dB);
                sA.x = sA.x * w4.x + (saA * b4.x + vv.x * k4.x); sA.y = sA.y * w4.y + (saA * b4.y + vv.x * k4.y);
                sA.z = sA.z * w4.z + (saA * b4.z + vv.x * k4.z); sA.w = sA.w * w4.w + (saA * b4.w + vv.x * k4.w);
                sB.x = sB.x * w4.x + (saB * b4.x + vv.y * k4.x); sB.y = sB.y * w4.y + (saB * b4.y + vv.y * k4.y);
                sB.z = sB.z * w4.z + (saB * b4.z + vv.y * k4.z); sB.w = sB.w * w4.w + (saB * b4.w + vv.y * k4.w);
                if (!PASS_A) {
                    const float yA = sum16((sA.x * r4.x + sA.y * r4.y) + (sA.z * r4.z + sA.w * r4.w));
                    const float yB = sum16((sB.x * r4.x + sB.y * r4.y) + (sB.z * r4.z + sB.w * r4.w));
                    ykA = (ks == (tt & 15)) ? yA : ykA; ykB = (ks == (tt & 15)) ? yB : ykB;
                    if ((tt & 15) == 15) *(unsigned*)(MIX + ((size_t)ch * RS_T + (tt - 15) + ks) * 1024 + 768 + h * 64 + 32 * rgx + row) = pk2(ykA, ykB);
                }
            }
            asm volatile("s_waitcnt lgkmcnt(0)" ::: "memory");
#undef RS_LD
        }
        __syncthreads();
    }
    if (PASS_A && w < 4) {
        float* dst = LX + ((size_t)(g * 4 + h) * 128 + 32 * rgx + row) * 64 + 4 * ks;
        *(f32x4*)dst = sA; *(f32x4*)(dst + 64) = sB;
    }
}

__device__ __forceinline__ void rwkv_post(const Params& P, int layer, int tid) {
    const int wave = tid >> 6, lane = tid & 63;
    const h16* RK = (const h16*)(P.ws + OFF_RK);
    bf16_t* MIX = (bf16_t*)(P.ws + OFF_HN);
    const float* lnw = P.in[I_LNW] + layer * 256; const float* lnb = P.in[I_LNB] + layer * 256; const float* rk = P.in[I_RK] + layer * 256;
    float lw[4], lb[4], rkk[4];
#pragma unroll
    for (int hh = 0; hh < 4; ++hh) { lw[hh] = lnw[hh * 64 + lane]; lb[hh] = lnb[hh * 64 + lane]; rkk[hh] = rk[hh * 64 + lane]; }
    for (int t = blockIdx.x * 8 + wave; t < S_; t += gridDim.x * 8) {
        float y[4], r[4], k[4], v[4], g[4];
#pragma unroll
        for (int hh = 0; hh < 4; ++hh) {
            const int col = hh * 64 + lane; const size_t o = (size_t)t * 256 + col;
            y[hh] = bf2f(MIX[(size_t)t * 1024 + 768 + col]);
            r[hh] = (float)RK[0 * RKSZ + o]; k[hh] = (float)RK[1 * RKSZ + o]; v[hh] = (float)RK[2 * RKSZ + o]; g[hh] = (float)RK[6 * RKSZ + o];
        }
        float m[4], q[4];
#pragma unroll
        for (int hh = 0; hh < 4; ++hh) { m[hh] = y[hh]; q[hh] = r[hh] * k[hh] * rkk[hh]; }
#pragma unroll
        for (int o = 1; o < 64; o <<= 1) {
#pragma unroll
            for (int hh = 0; hh < 4; ++hh) { m[hh] += __shfl_xor(m[hh], o); q[hh] += __shfl_xor(q[hh], o); }
        }
        float dl[4], var[4];
#pragma unroll
        for (int hh = 0; hh < 4; ++hh) { dl[hh] = y[hh] - m[hh] * (1.f / 64.f); var[hh] = dl[hh] * dl[hh]; }
#pragma unroll
        for (int o = 1; o < 64; o <<= 1) {
#pragma unroll
            for (int hh = 0; hh < 4; ++hh) var[hh] += __shfl_xor(var[hh], o);
        }
#pragma unroll
        for (int hh = 0; hh < 4; ++hh) {
            const float yn = dl[hh] * rsqrtf(var[hh] * (1.f / 64.f) + 64e-5f) * lw[hh] + lb[hh];
            MIX[(size_t)t * 1024 + 768 + hh * 64 + lane] = f2bf((yn + q[hh] * v[hh]) * g[hh]);
        }
    }
}

__device__ __forceinline__ void conv_glu(const Params& P, int layer, int hf, int tid) {
    const bf16_t* U = (const bf16_t*)(P.ws + OFF_U);
    bf16_t* ACT = (bf16_t*)(P.ws + OFF_ACT);
    bf16_t* HALO = (bf16_t*)(P.ws + OFF_HALO);
    const float* cw = P.in[I_CW] + (size_t)layer * 3 * 5632; const float* cb = P.in[I_CB] + (size_t)layer * 5632;
    const int gt = blockIdx.x * NTHREADS + tid, nth = gridDim.x * NTHREADS;
    for (int it = gt; it < 352 * 256; it += nth) {
        const int cgp = it % 352, run = it / 352, c = cgp * 8, lt0 = run * 32;
        float wg[3][8], wv[3][8], bg[8], bv[8];
#pragma unroll
        for (int q = 0; q < 8; ++q) {
            bg[q] = cb[c + q]; bv[q] = cb[2816 + c + q];
#pragma unroll
            for (int jx = 0; jx < 3; ++jx) { wg[jx][q] = cw[jx * 5632 + c + q]; wv[jx][q] = cw[jx * 5632 + 2816 + c + q]; }
        }
        u32x4 g2, g1, v2, v1;
        if (lt0 == 0) {
            if (hf == 0) { g2 = (u32x4){0, 0, 0, 0}; g1 = g2; v2 = g2; v1 = g2; }
            else { g2 = *(const u32x4*)(HALO + c); v2 = *(const u32x4*)(HALO + 2816 + c); g1 = *(const u32x4*)(HALO + 5632 + c); v1 = *(const u32x4*)(HALO + 5632 + 2816 + c); }
        } else {
            g2 = *(const u32x4*)(U + (size_t)(lt0 - 2) * 5632 + c); v2 = *(const u32x4*)(U + (size_t)(lt0 - 2) * 5632 + 2816 + c);
            g1 = *(const u32x4*)(U + (size_t)(lt0 - 1) * 5632 + c); v1 = *(const u32x4*)(U + (size_t)(lt0 - 1) * 5632 + 2816 + c);
        }
        for (int i0 = 0; i0 < 32; i0 += 4) {
            u32x4 gl[4], vl[4];
#pragma unroll
            for (int u = 0; u < 4; ++u) { gl[u] = *(const u32x4*)(U + (size_t)(lt0 + i0 + u) * 5632 + c); vl[u] = *(const u32x4*)(U + (size_t)(lt0 + i0 + u) * 5632 + 2816 + c); }
#pragma unroll
            for (int u = 0; u < 4; ++u) {
                const u32x4 g0 = gl[u], v0 = vl[u];
                float res[8];
#pragma unroll
                for (int q = 0; q < 4; ++q) {
                    const unsigned a2 = g2[q], a1 = g1[q], a0 = g0[q], b2 = v2[q], b1 = v1[q], b0 = v0[q];
                    const float glo = bg[2 * q] + wg[0][2 * q] * bflo(a2) + wg[1][2 * q] * bflo(a1) + wg[2][2 * q] * bflo(a0);
                    const float ghi = bg[2 * q + 1] + wg[0][2 * q + 1] * bfhi(a2) + wg[1][2 * q + 1] * bfhi(a1) + wg[2][2 * q + 1] * bfhi(a0);
                    const float vlo = bv[2 * q] + wv[0][2 * q] * bflo(b2) + wv[1][2 * q] * bflo(b1) + wv[2][2 * q] * bflo(b0);
                    const float vhi = bv[2 * q + 1] + wv[0][2 * q + 1] * bfhi(b2) + wv[1][2 * q + 1] * bfhi(b1) + wv[2][2 * q + 1] * bfhi(b0);
                    res[2 * q] = glo * sigm(glo) * vlo; res[2 * q + 1] = ghi * sigm(ghi) * vhi;
                }
                u32x4 o; o.x = pk2(res[0], res[1]); o.y = pk2(res[2], res[3]); o.z = pk2(res[4], res[5]); o.w = pk2(res[6], res[7]);
                *(u32x4*)(ACT + (size_t)(hf * 8192 + lt0 + i0 + u) * 2816 + c) = o;
                g2 = g1; g1 = g0; v2 = v1; v1 = v0;
            }
        }
    }
    if (hf == 0) {
        for (int it = gt; it < 2 * 704; it += nth) { const int r = it / 704, cc = it % 704; *(u32x4*)(HALO + (size_t)r * 5632 + cc * 8) = *(const u32x4*)(U + (size_t)(8190 + r) * 5632 + cc * 8); }
    }
}

__device__ __forceinline__ void run_phase(const Params& P, int ph, unsigned char* smem, int part) {
    const int tid = launder((int)threadIdx.x), wave = tid >> 6, lane = tid & 63;
    const int gw = blockIdx.x * 8 + wave, ngw = gridDim.x * 8;
    bf16_t* WT = (bf16_t*)(P.ws + OFF_WT);
    bf16_t* HN = (bf16_t*)(P.ws + OFF_HN);
    if (PH(16) && ph == 32) {
        const float* g = P.in[I_NFIN];
        for (int row = gw; row < S_; row += ngw) {
            f32x4* xr = (f32x4*)(P.out + (size_t)row * D_) + lane;
            f32x4 v[4]; float s = 0.f;
#pragma unroll
            for (int j = 0; j < 4; ++j) { v[j] = xr[64 * j]; s += (v[j].x * v[j].x + v[j].y * v[j].y) + (v[j].z * v[j].z + v[j].w * v[j].w); }
            s = wave_sum(s);
            const float r = rsqrtf(s * (1.f / 1024.f) + 1e-6f);
#pragma unroll
            for (int j = 0; j < 4; ++j) { const f32x4 gg = ((const f32x4*)g)[lane + 64 * j]; f32x4 o; o.x = v[j].x * r * gg.x; o.y = v[j].y * r * gg.y; o.z = v[j].z * r * gg.z; o.w = v[j].w * r * gg.w; xr[64 * j] = o; }
        }
        return;
    }
    const int layer = ph >> 4, sub = ph & 15;
    if (PH(0) && sub == 0) { phase_prep(P, layer, smem, tid); return; }
    if (PH(1) && sub == 9) {
        EpiConv E; E.act = (bf16_t*)(P.ws + OFF_ACT); E.hl = (bf16_t*)(P.ws + OFF_U); E.hf = (bf16_t*)(P.ws + OFF_U + 8 * MiB);
        E.cw = P.in[I_CW] + (size_t)layer * 3 * 5632; E.cb = P.in[I_CB] + (size_t)layer * 5632;
        run_gemm(smem, HN, WT + WT_UP, S_, 5632, 1024, E); return;
    }
    if (PH(1) && sub == 10) {
        conv_fixup(P, layer, tid);
        float* SSQ = (float*)(P.ws + OFF_SSQ);
        for (int it = blockIdx.x * NTHREADS + tid; it < S_; it += gridDim.x * NTHREADS) SSQ[it] = 0.f;
        return;
    }
    if (PH(1) && sub == 1) {
        EpiRoute E; const bf16_t* A; const bf16_t* Bt; int M, N;
        if (sub == 1) { A = HN; Bt = WT + WT_IN; M = S_; N = 3840; E.d0 = (bf16_t*)(P.ws + OFF_ZH); E.ld0 = 2048; E.d1 = (bf16_t*)(P.ws + OFF_ZB); E.ld1 = 768; E.d2 = (bf16_t*)(P.ws + OFF_ZC); E.ld2 = 1024; E.c1 = 2048; E.c2 = 2816; }
        else { const int hf = (sub == 11); A = HN + (size_t)hf * 8192 * 1024; Bt = WT + WT_UP; M = 8192; N = 5632; E.d0 = (bf16_t*)(P.ws + OFF_U); E.ld0 = 5632; E.d1 = E.d0; E.ld1 = 5632; E.d2 = E.d0; E.ld2 = 5632; E.c1 = 1 << 30; E.c2 = 1 << 30; }
        run_gemm(smem, A, Bt, M, N, 1024, E); return;
    }
    if (PH(7) && sub == 13) {
        EpiF32<3> E; E.hin = P.out; E.out = P.out; E.hb = HN; E.ssq = (float*)(P.ws + OFF_SSQ);
        run_gemm(smem, (const bf16_t*)(P.ws + OFF_ACT), WT + WT_DOWN, S_, 1024, 2816, E);
        const float* p = P.in[I_P] + (size_t)layer * S_ * 256; bf16_t* PB = (bf16_t*)(P.ws + OFF_PB);
        for (int it = blockIdx.x * NTHREADS + tid; it < S_ * 256 / 8; it += gridDim.x * NTHREADS) {
            const f32x4 a = ((const f32x4*)p)[2 * it], b = ((const f32x4*)p)[2 * it + 1];
            u32x4 o; o.x = pk2(a.x, a.y); o.y = pk2(a.z, a.w); o.z = pk2(b.x, b.y); o.w = pk2(b.z, b.w);
            ((u32x4*)PB)[it] = o;
        }
        return;
    }
    if (PH(7) && sub == 7) {
        EpiF32<0> E; const bf16_t* A; const bf16_t* Bt; int K;
        if (sub == 7) { A = HN; Bt = WT + WT_OUT; K = 1024; E.hin = (layer == 0) ? P.in[I_X] : P.out; }
        else { A = (const bf16_t*)(P.ws + OFF_ACT); Bt = WT + WT_DOWN; K = 2816; E.hin = P.out; }
        E.out = P.out;
        run_gemm(smem, A, Bt, S_, 1024, K, E); return;
    }
    if (PH(15) && sub == 15) {
        float* PP = (float*)(P.ws + OFF_PP);
        { EpiF32<1> E; E.hin = nullptr; E.out = PP; E.hb = nullptr; E.ssq = nullptr; run_gemm(smem, (const bf16_t*)(P.ws + OFF_PB), WT + WT_PROJ, S_, 1024, 256, E); }
        __syncthreads();
        { EpiF32<4> E; E.hin = PP; E.out = P.out; E.hb = nullptr; E.ssq = (float*)(P.ws + OFF_SSQ); run_gemm(smem, HN, WT + WT_GATE, S_, 1024, 1024, E); }
        return;
    }
    if (PH(2) && sub == 2) { rwkv_prep(P, layer, smem, tid); __syncthreads(); attn_partial(P, smem, tid); return; }
    if (PH(3) && (sub == 3 || sub == 4)) {
        if (sub == 3) { hgrn_pass1(P, layer, smem, tid); attn_combine(P, tid); }
        const bool ride = (sub == 4) && (gridDim.x == 256);
        if (sub == 4 && !ride) hgrn_scan(P, tid);
        const int base = (sub == 4) ? RS_G * 8 : 0;
        for (int job = base + blockIdx.x; job < base + RS_G * 8; job += gridDim.x) rwkv_seg_job<true>(P, smem, tid, job >> 4, (job >> 2) & 3, job & 3, false, ride);
        return;
    }
    if (PH(5) && sub == 5) {
        if (part == 0 && blockIdx.x >= 8) { for (int item = blockIdx.x - 8; item < 1024; item += gridDim.x - 8) hgrn_pass3_item(P, layer, smem, tid, item); return; }
        const bool co = (part == 0);
        for (int job = blockIdx.x; job < (co ? 8 : RS_G * 8); job += gridDim.x)
            rwkv_seg_job<false>(P, smem, tid, co ? RS_G - 1 : (job >> 3), co ? (job >> 1) : ((job >> 1) & 3), job & 1, co);
        return;
    }
    if (PH(6) && sub == 6) { rwkv_post(P, layer, tid); return; }
    if (PH(8) && sub == 8) { rmsnorm_rows_bf16(P.out, P.in[I_NFFN] + layer * 1024, HN, gw, ngw, lane); return; }
    if (PH(14) && sub == 14) {
        rmsnorm_rows_bf16(P.out, P.in[I_NPLE] + layer * 1024, HN, gw, ngw, lane);
        const float* p = P.in[I_P] + (size_t)layer * S_ * 256; bf16_t* PB = (bf16_t*)(P.ws + OFF_PB);
        for (int it = blockIdx.x * NTHREADS + tid; it < S_ * 256 / 8; it += gridDim.x * NTHREADS) {
            const f32x4 a = ((const f32x4*)p)[2 * it], b = ((const f32x4*)p)[2 * it + 1];
            u32x4 o; o.x = pk2(a.x, a.y); o.y = pk2(a.z, a.w); o.z = pk2(b.x, b.y); o.w = pk2(b.z, b.w);
            ((u32x4*)PB)[it] = o;
        }
        return;
    }
}

#define XB_TMO      128
#define XB_XCNT(j)  (256  + 64 * (j))
#define XB_XSUB(j)  (1280 + 64 * (j))
#define XB_XGEN(j)  (2304 + 64 * (j))
#define XB_TOP      3328
#define XB_TOPGEN   3392
#define XCD_BAR_WORDS 3456
#define XB_SPIN_CAP (1u << 18)
#define XB_LAS __attribute__((address_space(3)))

__device__ __forceinline__ unsigned xb_ld(unsigned* p)              { return __hip_atomic_load(p, __ATOMIC_RELAXED, __HIP_MEMORY_SCOPE_AGENT); }
__device__ __forceinline__ unsigned xb_add(unsigned* p, unsigned v) { return __hip_atomic_fetch_add(p, v, __ATOMIC_RELAXED, __HIP_MEMORY_SCOPE_AGENT); }
__device__ __forceinline__ unsigned xb_xcc_id() { return (unsigned)__builtin_amdgcn_s_getreg((3 << 11) | 20) & 0xFu; }
#define XB_SPIN(cond, bar) do { unsigned _sp = 0; while (cond) { __builtin_amdgcn_s_sleep(1); \
    if ((++_sp & 255u) == 0u) { if (xb_ld(&(bar)[XB_TMO])) break; if (_sp > XB_SPIN_CAP) { atomicAdd(&(bar)[XB_TMO], 1u); break; } } } } while (0)
struct XcdBarrier {
    unsigned* bar; unsigned x;
    volatile XB_LAS unsigned* st;
};

__device__ __forceinline__ XcdBarrier xcd_barrier_post(unsigned* bar, volatile XB_LAS unsigned* st) {
    XcdBarrier b; b.bar = bar; b.x = xb_xcc_id(); b.st = st;
    if (threadIdx.x == 0) (void)xb_add(&bar[XB_XCNT(b.x)], 1u);
    return b;
}
__device__ __forceinline__ void xcd_barrier_complete(unsigned* bar, unsigned x, unsigned& nloc, unsigned& nx) {
    const unsigned G = gridDim.x * gridDim.y * gridDim.z;
    unsigned sum, cnt, mine, sp = 0u;
    for (;;) {
        sum = 0u; cnt = 0u; mine = 0u;
#pragma unroll
        for (unsigned j = 0; j < 16; ++j) { const unsigned c = xb_ld(&bar[XB_XCNT(j)]); sum += c; cnt += (c > 0u) ? 1u : 0u; mine = (j == x) ? c : mine; }
        if (sum == G) break;
        __builtin_amdgcn_s_sleep(1);
        if ((++sp & 255u) == 0u) { if (xb_ld(&bar[XB_TMO])) break; if (sp > XB_SPIN_CAP) { atomicAdd(&bar[XB_TMO], 1u); break; } }
    }
    nloc = mine > 0u ? mine : 1u; nx = cnt > 0u ? cnt : 1u;
}

__device__ __forceinline__ void xcd_barrier(const XcdBarrier& b) {
    asm volatile("s_waitcnt vmcnt(0)" ::: "memory");
    __syncthreads();
    if (threadIdx.x == 0) {
        unsigned* bar = b.bar;
        __builtin_amdgcn_s_waitcnt(0);
        unsigned nloc = b.st[0], nx = b.st[1];
        if (nloc == 0u) { xcd_barrier_complete(bar, b.x, nloc, nx); b.st[0] = nloc; b.st[1] = nx; }
        const unsigned old = xb_add(&bar[XB_XSUB(b.x)], 1u);
        const unsigned gen = old / nloc;
        if (old + 1u == (gen + 1u) * nloc) {
            __builtin_amdgcn_fence(__ATOMIC_RELEASE, "agent");
            asm volatile("s_waitcnt vmcnt(0)" ::: "memory");
            const unsigned og = xb_add(&bar[XB_TOP], 1u);
            const unsigned tg = og / nx;
            if (og + 1u == (tg + 1u) * nx) xb_add(&bar[XB_TOPGEN], 1u);
            else XB_SPIN(xb_ld(&bar[XB_TOPGEN]) == tg, bar);
            __builtin_amdgcn_fence(__ATOMIC_ACQUIRE, "agent");
            xb_add(&bar[XB_XGEN(b.x)], 1u);
            asm volatile("s_waitcnt vmcnt(0)" ::: "memory");
        } else {
            XB_SPIN(xb_ld(&bar[XB_XGEN(b.x)]) == gen, bar);
            __builtin_amdgcn_fence(__ATOMIC_ACQUIRE, "agent");
            asm volatile("s_waitcnt vmcnt(0)" ::: "memory");
        }
    }
    __syncthreads();
}

constexpr size_t OFF_BAR = 65536;

#ifndef ONE_LAUNCH
#define ONE_LAUNCH 1
#endif

__global__ __launch_bounds__(512, 2) void mega(Params P, int ph_lo, int ph_hi) {
    extern __shared__ __attribute__((aligned(16))) unsigned char smem[];
    cg::grid_group grid = cg::this_grid();
    if (ph_hi == 0x7fffffff) grid.sync();
    volatile XB_LAS unsigned* st = (volatile XB_LAS unsigned*)(smem + LDS_BYTES - 16);
    if (threadIdx.x == 0) { st[0] = 0u; st[1] = 0u; }
    __syncthreads();
    XcdBarrier xb = xcd_barrier_post((unsigned*)(P.ws + OFF_BAR), st);
#ifdef EXTRA_SYNCS
    for (int i = 0; i < EXTRA_SYNCS; ++i) xcd_barrier(xb);
#endif
    for (int ph = ph_lo; ph < ph_hi; ++ph) {
        if (ph < 32 && ((ph & 15) == 11 || (ph & 15) == 12 || (ph & 15) == 14)) continue;
        if (ph > ph_lo) xcd_barrier(xb);
        const int nparts = (ph < 32 && (ph & 15) == 5) ? 2 : 1;
        for (int part = 0; part < nparts; ++part) { if (part) xcd_barrier(xb); run_phase(P, ph, smem, part); }
#ifdef REP_MASK
        if (ph < 32 && ((REP_MASK >> (ph & 15)) & 1)) { xcd_barrier(xb); run_phase(P, ph, smem, 0); }
#endif
    }
}

extern "C" void kernel_launch(void* const* d_in, const int* in_sizes, int n_in, void* d_out, int out_size, void* d_ws, size_t ws_size, hipStream_t stream) {
    static int grid_blocks = 0;
    if (grid_blocks == 0) {
        int dev = 0, cus = 0, per_cu = 0;
        if (hipGetDevice(&dev) != hipSuccess || hipDeviceGetAttribute(&cus, hipDeviceAttributeMultiprocessorCount, dev) != hipSuccess) { fprintf(stderr, "kernel_launch: device query failed\n"); grid_blocks = -1; return; }
        if (hipFuncSetAttribute((const void*)mega, hipFuncAttributeMaxDynamicSharedMemorySize, LDS_BYTES) != hipSuccess) { fprintf(stderr, "kernel_launch: hipFuncSetAttribute failed\n"); grid_blocks = -1; return; }
        if (hipOccupancyMaxActiveBlocksPerMultiprocessor(&per_cu, (const void*)mega, NTHREADS, LDS_BYTES) != hipSuccess || per_cu < 1) { fprintf(stderr, "kernel_launch: occupancy query gave %d\n", per_cu); per_cu = 1; }
        (void)hipGetLastError();
        grid_blocks = cus * per_cu;
        if (n_in != 30 || ws_size < 256 * MiB) fprintf(stderr, "kernel_launch: unexpected n_in %d / ws_size %zu\n", n_in, ws_size);
    }
    if (grid_blocks < 0) return;
    Params P{};
    for (int i = 0; i < 30; ++i) P.in[i] = (const float*)d_in[i];
    P.out = (float*)d_out; P.ws = (unsigned char*)d_ws;
#if ONE_LAUNCH
    if (hipMemsetAsync((char*)d_ws + OFF_BAR, 0, XCD_BAR_WORDS * sizeof(unsigned), stream) != hipSuccess) { fprintf(stderr, "kernel_launch: memset of the barrier words failed\n"); return; }
    int lo = 0, hi = NPH;
    void* args[] = {&P, &lo, &hi};
    hipError_t e = hipLaunchCooperativeKernel((const void*)mega, dim3(grid_blocks), dim3(NTHREADS), args, LDS_BYTES, stream);
    if (e != hipSuccess) fprintf(stderr, "cooperative launch failed: %s (grid %d)\n", hipGetErrorString(e), grid_blocks);
#else
    for (int ph = 0; ph < NPH; ++ph) hipLaunchKernelGGL(mega, dim3(grid_blocks), dim3(NTHREADS), LDS_BYTES, stream, P, ph, ph + 1);
#endif
}
```

```cpp
#include <hip/hip_runtime.h>
#include <hip/hip_cooperative_groups.h>
#include <cstdio>
#include <cstdint>
namespace cg = cooperative_groups;
namespace pg8 {
#define PG8_LAS __attribute__((address_space(3)))
typedef unsigned short bf16_t;
typedef short bf16x8 __attribute__((ext_vector_type(8)));
typedef float f32x4 __attribute__((ext_vector_type(4)));
typedef unsigned u32x4 __attribute__((ext_vector_type(4)));
constexpr int BM = 256, BK = 64, HALF = 128, HTB = HALF * BK * 2  , STAGE_BYTES = 8 * HTB, NXCD = 8, WGM = 8;

__host__ __device__ __forceinline__ int lds_byte(int r, int c) { const int st = (r >> 4) * 2 + (c >> 5), rr = r & 15, cc = c & 31, ob = rr * 64 + cc * 2; return st * 1024 + (ob ^ (((ob >> 9) & 1) << 5)); }
__host__ __device__ __forceinline__ void stage_rc(int b, int& R, int& C) { const int st = b / 1024, sb = b % 1024, swz = sb ^ (((sb >> 9) & 1) << 5); R = (st >> 1) * 16 + swz / 64; C = (st & 1) * 32 + (swz % 64) / 2; }
__host__ __device__ __forceinline__ int perm32(int rho) { const int n = rho >> 4, i = rho & 15; return 8 * (i >> 2) + 4 * n + (i & 3); }

struct Unit { int pm, pn; };
struct Gemm { const bf16_t* A; const bf16_t* Bt; int M, N, K; };

struct StaticOrder {
    int nM, nN, nwg, G, c;
    __host__ __device__ void init(int M, int N, int G_, int c_) { nM = M / BM; nN = N / BM; nwg = nM * nN; G = G_; c = c_; }
    __host__ __device__ bool next(int i, Unit& u) const {
        const long L = (long)i * G + c; if (L >= nwg) return false;
        int wgid = (int)L; { const int q = nwg / NXCD, r = nwg % NXCD, xcd = wgid % NXCD, off = wgid / NXCD; wgid = (xcd < r ? xcd * (q + 1) : r * (q + 1) + (xcd - r) * q) + off; }
        const int nig = WGM * nN, gid = wgid / nig, fm = gid * WGM, gsz = (nM - fm) < WGM ? (nM - fm) : WGM;
        u.pm = fm + ((wgid % nig) % gsz); u.pn = (wgid % nig) / gsz; return true;
    }
    __device__ __forceinline__ void a_ready(const Unit&) const {}
    __device__ __forceinline__ void done(const Unit&) const {}
};
__device__ __forceinline__ unsigned cvt_pk_bf16(float lo, float hi) { unsigned r; asm volatile("v_cvt_pk_bf16_f32 %0, %1, %2" : "=v"(r) : "v"(lo), "v"(hi)); return r; }
typedef float f32x2 __attribute__((ext_vector_type(2)));
template <class Epi, class Sched, bool STAMP = false>
__device__ __forceinline__ void gemm_phase(PG8_LAS unsigned char* lds, const Gemm g, const Sched& S, const Epi& E, unsigned long long* stamps) {
    int tid_l = threadIdx.x; asm volatile("" : "+v"(tid_l)); const int tid = tid_l, wid = __builtin_amdgcn_readfirstlane(tid >> 6), lane = tid & 63, wr = wid >> 2, wc = wid & 3, fr = lane & 15, fq = lane >> 4;
    const int K = g.K, nt = K / BK;
    int ts_lo = 0, ts_hi = 0, nts = 0; const unsigned long long rt_entry = STAMP ? (unsigned long long)wall_clock64() : 0ull;
#define PG8_STAMP() do { if (STAMP && wid == 0 && nts < 64) { const unsigned long long _c = (unsigned long long)clock64(); \
        ts_lo = (lane == nts) ? (int)(unsigned)_c : ts_lo; ts_hi = (lane == nts) ? (int)(unsigned)(_c >> 32) : ts_hi; ++nts; } } while (0)
    PG8_STAMP();
    unsigned voffA[2], voffB[2];
#pragma unroll
    for (int i = 0; i < 2; ++i) { int R, C; stage_rc(tid * 16 + i * 8192, R, C); const int Rb = Epi::PERM ? ((R & ~31) + perm32(R & 31)) : R;
        voffA[i] = (unsigned)(R * K + C) * 2u; voffB[i] = (unsigned)(Rb * K + C) * 2u; }
    const size_t kstep = (size_t)(BK * 2);
    const size_t hstep = (size_t)HALF * K * 2;
    const size_t tstep = 2 * hstep;
    const unsigned ldsw = (unsigned)wid * 1024u;
    const int aoff = lds_byte(wr * 64 + fr, fq * 8), boff = lds_byte(wc * 32 + fr, fq * 8);
#define PG8_SA(b, h) (((b) * 2 + (h)) * HTB)
#define PG8_SB(b, h) ((4 + (b) * 2 + (h)) * HTB)
#define PG8_STAGE(bufoff, gbase, voff) do { _Pragma("unroll") for (int _i = 0; _i < 2; ++_i) \
        __builtin_amdgcn_global_load_lds((const unsigned*)((const char*)(gbase) + (voff)[_i]), (PG8_LAS unsigned*)(lds + (bufoff) + ldsw + _i * 8192), 16, 0, 0); } while (0)
#define PG8_LDA(dst, b, h) do { _Pragma("unroll") for (int m = 0; m < 4; ++m) _Pragma("unroll") for (int k = 0; k < 2; ++k) dst[m][k] = *(const PG8_LAS bf16x8*)(lds + PG8_SA(b, h) + aoff + m * 2048 + k * 1024); } while (0)
#define PG8_LDB(dst, b, h) do { _Pragma("unroll") for (int n = 0; n < 2; ++n) _Pragma("unroll") for (int k = 0; k < 2; ++k) dst[n][k] = *(const PG8_LAS bf16x8*)(lds + PG8_SB(b, h) + boff + n * 2048 + k * 1024); } while (0)
#define PG8_MMA(ai, bj, At, Bt) do { __builtin_amdgcn_s_setprio(1); _Pragma("unroll") for (int m = 0; m < 4; ++m) _Pragma("unroll") for (int n = 0; n < 2; ++n) _Pragma("unroll") for (int k = 0; k < 2; ++k) \
        acc[ai][bj][m][n] = __builtin_amdgcn_mfma_f32_16x16x32_bf16(Bt[n][k], At[m][k], acc[ai][bj][m][n], 0, 0, 0); __builtin_amdgcn_s_setprio(0); } while (0)
#define PG8_WAIT_V(n) asm volatile("s_waitcnt vmcnt(" #n ")" ::: "memory")
#define PG8_WAIT_L(n) asm volatile("s_waitcnt lgkmcnt(" #n ")" ::: "memory")
#define PG8_BAR __builtin_amdgcn_s_barrier()
#define PG8_SCHED __builtin_amdgcn_sched_barrier(0)
    Unit cur, nxt; int ui = 0;
    if (!S.next(0, cur)) return;
    f32x4 acc[2][2][4][2];
#pragma unroll
    for (int a = 0; a < 2; ++a)
#pragma unroll
        for (int b = 0; b < 2; ++b)
#pragma unroll
            for (int m = 0; m < 4; ++m)
#pragma unroll
                for (int n = 0; n < 2; ++n) acc[a][b][m][n] = (f32x4){0.f, 0.f, 0.f, 0.f};
    bf16x8 At[4][2], B0[2][2], B1[2][2];
    const char* cA = (const char*)g.A + (size_t)cur.pm * tstep; const char* cB = (const char*)g.Bt + (size_t)cur.pn * tstep;
    S.a_ready(cur);
    PG8_STAGE(PG8_SB(0, 0), cB, voffB); PG8_STAGE(PG8_SA(0, 0), cA, voffA); PG8_STAGE(PG8_SB(0, 1), cB + hstep, voffB); PG8_STAGE(PG8_SA(0, 1), cA + hstep, voffA);
    if (wr == 1) PG8_BAR;
    PG8_WAIT_V(4); PG8_BAR;
    PG8_STAGE(PG8_SB(1, 0), cB + kstep, voffB); PG8_STAGE(PG8_SA(1, 0), cA + kstep, voffA); PG8_STAGE(PG8_SB(1, 1), cB + hstep + kstep, voffB);
    PG8_WAIT_V(6); PG8_BAR;
    PG8_STAMP();
    for (;;) {
        const bool has_next = S.next(ui + 1, nxt);
        const char* nA = has_next ? (const char*)g.A + (size_t)nxt.pm * tstep : cA; const char* nB = has_next ? (const char*)g.Bt + (size_t)nxt.pn * tstep : cB;
        for (int t = 0; t < nt; t += 2) {
            const bool last = (t == nt - 2);
            const char* a1 = cA + (size_t)(t + 1) * kstep;
            const char* a2 = last ? nA : cA + (size_t)(t + 2) * kstep; const char* b2 = last ? nB : cB + (size_t)(t + 2) * kstep;
            const char* a3 = a2 + kstep; const char* b3 = b2 + kstep;
            if (last && has_next) S.a_ready(nxt);
            PG8_LDB(B0, 0, 0); PG8_SCHED; PG8_LDA(At, 0, 0); PG8_STAGE(PG8_SA(1, 1), a1 + hstep, voffA);
            PG8_WAIT_L(8); PG8_BAR; PG8_WAIT_L(0); PG8_MMA(0, 0, At, B0); PG8_BAR; PG8_SCHED;
            PG8_LDB(B1, 0, 1); PG8_STAGE(PG8_SB(0, 0), b2, voffB);
            PG8_BAR; PG8_WAIT_L(0); PG8_MMA(0, 1, At, B1); PG8_BAR;
            PG8_LDA(At, 0, 1); PG8_STAGE(PG8_SA(0, 0), a2, voffA);
            PG8_BAR; PG8_WAIT_L(0); PG8_MMA(1, 0, At, B0); PG8_BAR; PG8_SCHED;
            PG8_STAGE(PG8_SB(0, 1), b2 + hstep, voffB);
            PG8_WAIT_V(6); PG8_BAR; PG8_MMA(1, 1, At, B1); PG8_BAR;
            PG8_LDB(B0, 1, 0); PG8_SCHED; PG8_LDA(At, 1, 0); PG8_STAGE(PG8_SA(0, 1), a2 + hstep, voffA);
            PG8_WAIT_L(8); PG8_BAR; PG8_WAIT_L(0); PG8_MMA(0, 0, At, B0); PG8_BAR; PG8_SCHED;
            PG8_LDB(B1, 1, 1); PG8_STAGE(PG8_SB(1, 0), b3, voffB);
            PG8_BAR; PG8_WAIT_L(0); PG8_MMA(0, 1, At, B1); PG8_BAR;
            PG8_LDA(At, 1, 1); PG8_STAGE(PG8_SA(1, 0), a3, voffA);
            PG8_BAR; PG8_WAIT_L(0); PG8_MMA(1, 0, At, B0); PG8_BAR; PG8_SCHED;
            PG8_STAGE(PG8_SB(1, 1), b3 + hstep, voffB);
            PG8_WAIT_V(6); PG8_BAR; PG8_MMA(1, 1, At, B1); PG8_BAR;
        }
        PG8_STAMP();
        if constexpr (!Epi::AFTER_DRAIN) { E(acc, cur, wr, wc, fr, fq); S.done(cur); }
        PG8_STAMP();
        if (!has_next) break;
#pragma unroll
        for (int a = 0; a < 2; ++a)
#pragma unroll
            for (int b = 0; b < 2; ++b)
#pragma unroll
                for (int m = 0; m < 4; ++m)
#pragma unroll
                    for (int n = 0; n < 2; ++n) acc[a][b][m][n] = (f32x4){0.f, 0.f, 0.f, 0.f};
        cur = nxt; cA = nA; cB = nB; ++ui;
    }
    PG8_WAIT_V(0);
    if (wr == 0) PG8_BAR;
    PG8_BAR;
    if constexpr (Epi::AFTER_DRAIN) { E.fused(acc, cur, wr, wc, fr, fq, lds, wid, lane); S.done(cur); }
    PG8_STAMP();
    if (STAMP && wid == 0) { stamps[lane] = lane < nts ? (((unsigned long long)(unsigned)ts_hi << 32) | (unsigned)ts_lo) : 0ull;
        if (lane == 62) stamps[62] = rt_entry; if (lane == 63) stamps[63] = (unsigned long long)wall_clock64(); }
#undef PG8_STAMP
#undef PG8_SA
#undef PG8_SB
#undef PG8_STAGE
#undef PG8_LDA
#undef PG8_LDB
#undef PG8_MMA
#undef PG8_WAIT_V
#undef PG8_WAIT_L
#undef PG8_BAR
#undef PG8_SCHED
}
}

using pg8::bf16_t; using pg8::f32x4; using pg8::u32x4; using pg8::Unit;
typedef _Float16 h16;
typedef _Float16 h16x8 __attribute__((ext_vector_type(8)));
typedef _Float16 h16x2 __attribute__((ext_vector_type(2)));
typedef _Float16 h16x4 __attribute__((ext_vector_type(4)));
typedef float f32x2v __attribute__((ext_vector_type(2)));

constexpr int S_ = 16384, D_ = 1024;
constexpr int NTHREADS = 512;
constexpr int LDS_BYTES = 155648;
constexpr size_t MiB = (size_t)1 << 20;
constexpr size_t OFF_HALO = 0, OFF_WT = 1 * MiB, OFF_VF = 30 * MiB, OFF_LX = 38 * MiB, OFF_S0 = 42 * MiB, OFF_HN = 46 * MiB, OFF_BIG = 78 * MiB;
constexpr size_t OFF_ZH = OFF_BIG, OFF_ZB = OFF_BIG + 64 * MiB, OFF_ZC = OFF_BIG + 88 * MiB, OFF_RK = OFF_BIG + 120 * MiB,
                 OFF_LSE = OFF_BIG + 176 * MiB, OFF_GB = OFF_BIG + 177 * MiB;
constexpr size_t OFF_U = OFF_BIG, OFF_ACT = OFF_BIG + 88 * MiB;
constexpr size_t OFF_PB = OFF_BIG, OFF_PP = OFF_BIG + 8 * MiB;
constexpr size_t OFF_SSQ = OFF_BIG + 80 * MiB;
constexpr size_t WT_IN = 0, WT_OUT = 3932160, WT_UP = 4980736, WT_DOWN = 10747904, WT_GATE = 13631488, WT_PROJ = 14680064,
                 WT_W2 = 14942208, WT_A2 = 14958592, WT_G2 = 14974976, WT_V1 = 15007744;
constexpr size_t RKSZ = (size_t)S_ * 256;

enum { I_X = 0, I_P, I_WIN, I_WOUT, I_NMIX, I_NFFN, I_NPLE, I_NFIN, I_LB, I_GN, I_MU, I_W0, I_W2, I_A0, I_A2, I_G2, I_KK, I_KA, I_RK,
       I_LNW, I_LNB, I_V0, I_V1, I_V2, I_UP, I_CW, I_CB, I_DOWN, I_PROJ, I_GATE, N_IN };

struct Params { const float* in[30]; float* out; unsigned char* ws; };

constexpr int NPH_LAYER = 16, NPH = 33;
#ifndef PHMASK
#define PHMASK 0x1FFFF
#endif
#define PH(x) ((PHMASK >> (x)) & 1)

__device__ __forceinline__ float bf2f(unsigned short b) { return __uint_as_float(((unsigned)b) << 16); }
__device__ __forceinline__ float bflo(unsigned u) { return __uint_as_float(u << 16); }
__device__ __forceinline__ float bfhi(unsigned u) { return __uint_as_float(u & 0xffff0000u); }
__device__ __forceinline__ unsigned pk2(float lo, float hi) { return pg8::cvt_pk_bf16(lo, hi); }
__device__ __forceinline__ unsigned pk2_sw(float lo, float hi) { unsigned a = __float_as_uint(lo), b = __float_as_uint(hi); a += 0x7fffu + ((a >> 16) & 1u); b += 0x7fffu + ((b >> 16) & 1u); return (a >> 16) | (b & 0xffff0000u); }
__device__ __forceinline__ unsigned short f2bf(float f) { return (unsigned short)(pk2(f, 0.f) & 0xffffu); }
__device__ __forceinline__ float wave_sum(float v) {
#pragma unroll
    for (int o = 1; o < 64; o <<= 1) v += __shfl_xor(v, o);
    return v;
}
__device__ __forceinline__ float sigm(float x) { return __builtin_amdgcn_rcpf(1.f + __expf(-x)); }
__device__ __forceinline__ int launder(int x) { asm volatile("" : "+v"(x)); return x; }
__device__ __forceinline__ void lds_wait() { asm volatile("s_waitcnt lgkmcnt(0)" ::: "memory"); }

__device__ __forceinline__ void transpose_item(const float* __restrict__ W, int K, int N, bf16_t* __restrict__ WT, float* scr, int item, int lane, bool perm_up = false, const float* __restrict__ kscale = nullptr) {
    const int nblk = N / 32, kb = item / nblk, nb = item % nblk, k0 = 64 * kb, n0 = 32 * nb;
    const int d0 = !perm_up ? n0 : ((n0 < 2816) ? (256 * (n0 >> 7) + (n0 & 127)) : (256 * ((n0 - 2816) >> 7) + 128 + ((n0 - 2816) & 127)));
#pragma unroll 8
    for (int i = 0; i < 32; ++i) { const int kk = 2 * i + (lane >> 5); float x = W[(size_t)(k0 + kk) * N + n0 + (lane & 31)]; if (kscale) x *= kscale[k0 + kk]; scr[kk * 33 + (lane & 31)] = x; }
    lds_wait();
    const int c = lane & 7;
#pragma unroll
    for (int j = 0; j < 4; ++j) {
        const int n = (lane >> 3) + 8 * j; const float* s = scr + (8 * c) * 33 + n;
        u32x4 o; o.x = pk2(s[0 * 33], s[1 * 33]); o.y = pk2(s[2 * 33], s[3 * 33]); o.z = pk2(s[4 * 33], s[5 * 33]); o.w = pk2(s[6 * 33], s[7 * 33]);
        *(u32x4*)(WT + (size_t)(d0 + n) * K + k0 + 8 * c) = o;
    }
    lds_wait();
}

__device__ __forceinline__ void rmsnorm_rows_bf16(const float* __restrict__ h, const float* __restrict__ g, bf16_t* __restrict__ out, int gw, int ngw, int lane) {
    f32x4 gg[4];
#pragma unroll
    for (int j = 0; j < 4; ++j) gg[j] = ((const f32x4*)g)[lane + 64 * j];
    for (int row = gw; row < S_; row += 2 * ngw) {
        const f32x4* xa = (const f32x4*)(h + (size_t)row * D_) + lane;
        const f32x4* xb = (const f32x4*)(h + (size_t)(row + ngw) * D_) + lane;
        f32x4 va[4], vb[4]; float sa = 0.f, sb = 0.f;
#pragma unroll
        for (int j = 0; j < 4; ++j) { va[j] = xa[64 * j]; vb[j] = xb[64 * j]; }
#pragma unroll
        for (int j = 0; j < 4; ++j) { sa += (va[j].x * va[j].x + va[j].y * va[j].y) + (va[j].z * va[j].z + va[j].w * va[j].w); sb += (vb[j].x * vb[j].x + vb[j].y * vb[j].y) + (vb[j].z * vb[j].z + vb[j].w * vb[j].w); }
#pragma unroll
        for (int o = 1; o < 64; o <<= 1) { sa += __shfl_xor(sa, o); sb += __shfl_xor(sb, o); }
        const float ra = rsqrtf(sa * (1.f / 1024.f) + 1e-6f), rb = rsqrtf(sb * (1.f / 1024.f) + 1e-6f);
        unsigned long long* oa = (unsigned long long*)(out + (size_t)row * D_) + lane;
        unsigned long long* ob = (unsigned long long*)(out + (size_t)(row + ngw) * D_) + lane;
#pragma unroll
        for (int j = 0; j < 4; ++j) {
            oa[64 * j] = (unsigned long long)pk2(va[j].x * ra * gg[j].x, va[j].y * ra * gg[j].y) | ((unsigned long long)pk2(va[j].z * ra * gg[j].z, va[j].w * ra * gg[j].w) << 32);
            ob[64 * j] = (unsigned long long)pk2(vb[j].x * rb * gg[j].x, vb[j].y * rb * gg[j].y) | ((unsigned long long)pk2(vb[j].z * rb * gg[j].z, vb[j].w * rb * gg[j].w) << 32);
        }
    }
}

__device__ __forceinline__ void phase_prep(const Params& P, int layer, unsigned char* smem, int tid) {
    const int wave = tid >> 6, lane = tid & 63;
    const int gw = blockIdx.x * 8 + wave, ngw = gridDim.x * 8;
    float* scr = (float*)smem + wave * (64 * 33);
    bf16_t* WT = (bf16_t*)(P.ws + OFF_WT);
    constexpr int I0 = 16 * 120, I1 = 16 * 32, I2 = 16 * 176, I3 = 44 * 32, I4 = 16 * 32, I5 = 4 * 32, I6 = 8, I7 = 8, I8 = 16, I9 = 4;
    constexpr int NIT = I0 + I1 + I2 + I3 + I4 + I5 + I6 + I7 + I8 + I9;
    for (int it = gw; it < NIT; it += ngw) {
        int r = it;
        if (r < I0) { transpose_item(P.in[I_WIN] + (size_t)layer * 1024 * 3840, 1024, 3840, WT + WT_IN, scr, r, lane); continue; } r -= I0;
        if (r < I1) { transpose_item(P.in[I_WOUT] + (size_t)layer * 1024 * 1024, 1024, 1024, WT + WT_OUT, scr, r, lane); continue; } r -= I1;
        if (r < I2) { transpose_item(P.in[I_UP] + (size_t)layer * 1024 * 5632, 1024, 5632, WT + WT_UP, scr, r, lane, true); continue; } r -= I2;
        if (r < I3) { transpose_item(P.in[I_DOWN] + (size_t)layer * 2816 * 1024, 2816, 1024, WT + WT_DOWN, scr, r, lane); continue; } r -= I3;
        if (r < I4) { transpose_item(P.in[I_GATE] + (size_t)layer * 1024 * 1024, 1024, 1024, WT + WT_GATE, scr, r, lane, false, P.in[I_NPLE] + layer * 1024); continue; } r -= I4;
        if (r < I5) { transpose_item(P.in[I_PROJ] + (size_t)layer * 256 * 1024, 256, 1024, WT + WT_PROJ, scr, r, lane); continue; } r -= I5;
        if (r < I6) { transpose_item(P.in[I_W2] + (size_t)layer * 64 * 256, 64, 256, WT + WT_W2, scr, r, lane); continue; } r -= I6;
        if (r < I7) { transpose_item(P.in[I_A2] + (size_t)layer * 64 * 256, 64, 256, WT + WT_A2, scr, r, lane); continue; } r -= I7;
        if (r < I8) { transpose_item(P.in[I_G2] + (size_t)layer * 128 * 256, 128, 256, WT + WT_G2, scr, r, lane); continue; } r -= I8;
        transpose_item(P.in[I_V1], 256, 32, WT + WT_V1, scr, r, lane);
    }
    const float* h = (layer == 0) ? P.in[I_X] : P.out;
    rmsnorm_rows_bf16(h, P.in[I_NMIX] + layer * 1024, (bf16_t*)(P.ws + OFF_HN), gw, ngw, lane);
}

struct EpiRoute {
    static constexpr bool PERM = true, AFTER_DRAIN = false;
    bf16_t* d0; bf16_t* d1; bf16_t* d2; int ld0, ld1, ld2, c1, c2;
    __device__ __forceinline__ void operator()(const f32x4 (&acc)[2][2][4][2], const Unit& u, int wr, int wc, int fr, int fq) const {
        int colt = u.pn * 256; bf16_t* base; int ld;
        if (colt < c1) { base = d0; ld = ld0; } else if (colt < c2) { base = d1; ld = ld1; colt -= c1; } else { base = d2; ld = ld2; colt -= c2; }
        const int row0 = u.pm * 256 + wr * 64 + fr, col0 = colt + wc * 32 + 8 * fq;
#pragma unroll
        for (int ai = 0; ai < 2; ++ai)
#pragma unroll
            for (int m = 0; m < 4; ++m) {
                bf16_t* rowp = base + (size_t)(row0 + ai * 128 + m * 16) * ld + col0;
#pragma unroll
                for (int bj = 0; bj < 2; ++bj) {
                    const f32x4 v0 = acc[ai][bj][m][0], v1 = acc[ai][bj][m][1];
                    u32x4 w; w.x = pk2(v0[0], v0[1]); w.y = pk2(v0[2], v0[3]); w.z = pk2(v1[0], v1[1]); w.w = pk2(v1[2], v1[3]);
                    *(u32x4*)(rowp + bj * 128) = w;
                }
            }
    }
};
template <int MODE  > struct EpiF32 {
    static constexpr bool PERM = false, AFTER_DRAIN = false;
    const float* hin; float* out; bf16_t* hb; float* ssq;
    __device__ __forceinline__ void operator()(const f32x4 (&acc)[2][2][4][2], const Unit& u, int wr, int wc, int fr, int fq) const {
        const int row0 = u.pm * 256 + wr * 64 + fr, col0 = u.pn * 256 + wc * 32 + 4 * fq;
#pragma unroll
        for (int ai = 0; ai < 2; ++ai)
#pragma unroll
            for (int m = 0; m < 4; ++m) {
                const int row = row0 + ai * 128 + m * 16;
                const size_t ro = (size_t)row * 1024 + col0;
                float sq = 0.f, rs = 1.f;
                if (MODE == 4) rs = rsqrtf(ssq[row] * (1.f / 1024.f) + 1e-6f);
#pragma unroll
                for (int bj = 0; bj < 2; ++bj)
#pragma unroll
                    for (int n = 0; n < 2; ++n) {
                        const size_t off = ro + bj * 128 + n * 16;
                        const f32x4 a = acc[ai][bj][m][n];
                        if (MODE == 0) { *(f32x4*)(out + off) = *(const f32x4*)(hin + off) + a; }
                        else if (MODE == 1) { *(f32x4*)(out + off) = a; }
                        else if (MODE == 3) {
                            const f32x4 o = *(const f32x4*)(hin + off) + a; *(f32x4*)(out + off) = o;
                            sq += (o.x * o.x + o.y * o.y) + (o.z * o.z + o.w * o.w);
                            *(unsigned long long*)(hb + off) = (unsigned long long)pk2(o.x, o.y) | ((unsigned long long)pk2(o.z, o.w) << 32);
                        }
                        else { const f32x4 pp = *(const f32x4*)(hin + off); f32x4 hv = *(f32x4*)(out + off);
                               hv.x += sigm(a.x * rs) * pp.x; hv.y += sigm(a.y * rs) * pp.y; hv.z += sigm(a.z * rs) * pp.z; hv.w += sigm(a.w * rs) * pp.w; *(f32x4*)(out + off) = hv; }
                    }
                if (MODE == 3) { sq += __shfl_xor(sq, 16); sq += __shfl_xor(sq, 32); if (fq == 0) atomicAdd(ssq + row, sq); }
            }
    }
};

__device__ __forceinline__ float dpp_ror1(float x) { return __int_as_float(__builtin_amdgcn_update_dpp(0, __float_as_int(x), 0x121, 0xF, 0xF, true)); }
__device__ __forceinline__ float dpp_ror2(float x) { return __int_as_float(__builtin_amdgcn_update_dpp(0, __float_as_int(x), 0x122, 0xF, 0xF, true)); }
__device__ __forceinline__ unsigned long long pk4(float a, float b, float c, float d) { return (unsigned long long)pk2_sw(a, b) | ((unsigned long long)pk2_sw(c, d) << 32); }
struct EpiConv {
    static constexpr bool PERM = true, AFTER_DRAIN = false;
    bf16_t* act; bf16_t* hl; bf16_t* hf; const float* cw; const float* cb;
    __device__ __forceinline__ void operator()(const f32x4 (&acc)[2][2][4][2], const Unit& u, int wr, int wc, int fr, int fq) const {
        const int cg0 = 128 * u.pn + 32 * wc + 8 * fq;
#pragma unroll
        for (int n = 0; n < 2; ++n) {
            const int cg = cg0 + 4 * n;
            const f32x4 bg = *(const f32x4*)(cb + cg), bv = *(const f32x4*)(cb + 2816 + cg);
            const f32x4 g0 = *(const f32x4*)(cw + cg), g1 = *(const f32x4*)(cw + 5632 + cg), g2 = *(const f32x4*)(cw + 11264 + cg);
            const f32x4 v0 = *(const f32x4*)(cw + 2816 + cg), v1 = *(const f32x4*)(cw + 5632 + 2816 + cg), v2 = *(const f32x4*)(cw + 11264 + 2816 + cg);
#pragma unroll
            for (int ai = 0; ai < 2; ++ai) {
                const int rbase = 256 * u.pm + 128 * ai + 64 * wr, grp = rbase >> 6;
#pragma unroll
                for (int m = 0; m < 4; ++m) {
                    const f32x4 xg = acc[ai][0][m][n], xv = acc[ai][1][m][n];
                    const f32x4 yg = acc[ai][0][m > 0 ? m - 1 : 0][n], yv = acc[ai][1][m > 0 ? m - 1 : 0][n];
                    f32x4 gt, vl;
#pragma unroll
                    for (int e = 0; e < 4; ++e) {
                        const float u1 = dpp_ror1((fr == 15) ? yg[e] : xg[e]), u2 = dpp_ror2((fr >= 14) ? yg[e] : xg[e]);
                        gt[e] = bg[e] + g0[e] * u2 + g1[e] * u1 + g2[e] * xg[e];
                    }
#pragma unroll
                    for (int e = 0; e < 4; ++e) {
                        const float u1 = dpp_ror1((fr == 15) ? yv[e] : xv[e]), u2 = dpp_ror2((fr >= 14) ? yv[e] : xv[e]);
                        vl[e] = bv[e] + v0[e] * u2 + v1[e] * u1 + v2[e] * xv[e];
                    }
                    const size_t r = (size_t)(rbase + 16 * m + fr);
                    if (m > 0 || fr >= 2)
                        *(unsigned long long*)(act + r * 2816 + cg) = (unsigned long long)pk2(gt[0] * sigm(gt[0]) * vl[0], gt[1] * sigm(gt[1]) * vl[1]) | ((unsigned long long)pk2(gt[2] * sigm(gt[2]) * vl[2], gt[3] * sigm(gt[3]) * vl[3]) << 32);
                    if (m == 0 && fr < 2) {
                        bf16_t* d = hf + (size_t)(grp * 2 + fr) * 5632 + cg;
                        *(unsigned long long*)d = pk4(xg[0], xg[1], xg[2], xg[3]); *(unsigned long long*)(d + 2816) = pk4(xv[0], xv[1], xv[2], xv[3]);
                    }
                    if (m == 3 && fr >= 14) {
                        bf16_t* d = hl + (size_t)(grp * 2 + (fr - 14)) * 5632 + cg;
                        *(unsigned long long*)d = pk4(xg[0], xg[1], xg[2], xg[3]); *(unsigned long long*)(d + 2816) = pk4(xv[0], xv[1], xv[2], xv[3]);
                    }
                }
            }
        }
    }
};
__device__ __forceinline__ void conv_fixup(const Params& P, int layer, int tid) {
    const bf16_t* hl = (const bf16_t*)(P.ws + OFF_U); const bf16_t* hf = (const bf16_t*)(P.ws + OFF_U + 8 * MiB);
    bf16_t* ACT = (bf16_t*)(P.ws + OFF_ACT);
    const float* cw = P.in[I_CW] + (size_t)layer * 3 * 5632; const float* cb = P.in[I_CB] + (size_t)layer * 5632;
    for (int it = blockIdx.x * NTHREADS + tid; it < 256 * 2 * 352; it += gridDim.x * NTHREADS) {
        const int cgp = it % 352, rs = it / 352, j = rs >> 1, sidx = rs & 1, c = cgp * 8;
        u32x4 a2[2], a1[2], a0[2];
#pragma unroll
        for (int q = 0; q < 2; ++q) {
            const int off = q * 2816 + c;
            const u32x4 z = (u32x4){0u, 0u, 0u, 0u};
            const u32x4 l0 = (j > 0) ? *(const u32x4*)(hl + (size_t)((j - 1) * 2 + 0) * 5632 + off) : z;
            const u32x4 l1 = (j > 0) ? *(const u32x4*)(hl + (size_t)((j - 1) * 2 + 1) * 5632 + off) : z;
            const u32x4 f0 = *(const u32x4*)(hf + (size_t)(j * 2 + 0) * 5632 + off), f1 = *(const u32x4*)(hf + (size_t)(j * 2 + 1) * 5632 + off);
            if (sidx == 0) { a2[q] = l0; a1[q] = l1; a0[q] = f0; } else { a2[q] = l1; a1[q] = f0; a0[q] = f1; }
        }
        float res[8];
#pragma unroll
        for (int q = 0; q < 4; ++q) {
#pragma unroll
            for (int hh = 0; hh < 2; ++hh) {
                const int cc = c + 2 * q + hh;
                const float ug2 = hh ? bfhi(a2[0][q]) : bflo(a2[0][q]), ug1 = hh ? bfhi(a1[0][q]) : bflo(a1[0][q]), ug0 = hh ? bfhi(a0[0][q]) : bflo(a0[0][q]);
                const float uv2 = hh ? bfhi(a2[1][q]) : bflo(a2[1][q]), uv1 = hh ? bfhi(a1[1][q]) : bflo(a1[1][q]), uv0 = hh ? bfhi(a0[1][q]) : bflo(a0[1][q]);
                const float gt = cb[cc] + cw[cc] * ug2 + cw[5632 + cc] * ug1 + cw[11264 + cc] * ug0;
                const float vl = cb[2816 + cc] + cw[2816 + cc] * uv2 + cw[5632 + 2816 + cc] * uv1 + cw[11264 + 2816 + cc] * uv0;
                res[2 * q + hh] = gt * sigm(gt) * vl;
            }
        }
        u32x4 o; o.x = pk2(res[0], res[1]); o.y = pk2(res[2], res[3]); o.z = pk2(res[4], res[5]); o.w = pk2(res[6], res[7]);
        *(u32x4*)(ACT + (size_t)(64 * j + sidx) * 2816 + c) = o;
    }
}

template <class Epi> __device__ __forceinline__ void run_gemm(unsigned char* smem, const bf16_t* A, const bf16_t* Bt, int M, int N, int K, const Epi& E) {
    pg8::Gemm g; g.A = A; g.Bt = Bt; g.M = M; g.N = N; g.K = K;
    pg8::StaticOrder So; So.init(M, N, (int)gridDim.x, (int)blockIdx.x);
    pg8::gemm_phase<Epi, pg8::StaticOrder, false>((PG8_LAS unsigned char*)smem, g, So, E, nullptr);
}

constexpr int CMS = 1028;
__device__ __forceinline__ pg8::bf16x8 lds_f32x8_to_bf16(const float* p) {
    const f32x4 a = *(const f32x4*)p, b = *(const f32x4*)(p + 4);
    u32x4 w; w.x = pk2(a.x, a.y); w.y = pk2(a.z, a.w); w.z = pk2(b.x, b.y); w.w = pk2(b.z, b.w);
    return __builtin_bit_cast(pg8::bf16x8, w);
}
__device__ __forceinline__ void rwkv_prep(const Params& P, int layer, unsigned char* smem, int tid) {
    using pg8::bf16x8;
    float* cmL = (float*)smem;
    float* loraL = cmL + 16 * CMS;
    float* uL = loraL + 16 * 768;
    const bf16_t* ZC = (const bf16_t*)(P.ws + OFF_ZC);
    const bf16_t* WT = (const bf16_t*)(P.ws + OFF_WT);
    h16* VF = (h16*)(P.ws + OFF_VF);
    h16* RK = (h16*)(P.ws + OFF_RK);
    const float* mu = P.in[I_MU] + layer * 1024;
    const int j = tid & 255, th = tid >> 8, tb = th * 8;
    const int w = tid >> 6, lane = tid & 63, lr = lane & 15, lq = lane >> 4;
    const float w0j = P.in[I_W0][layer * 256 + j], a0j = P.in[I_A0][layer * 256 + j], kkj = P.in[I_KK][layer * 256 + j], kaj = P.in[I_KA][layer * 256 + j];
    const float v0j = (layer > 0) ? P.in[I_V0][j] : 0.f;
    float v2c[32];
#pragma unroll
    for (int m = 0; m < 32; ++m) v2c[m] = (layer > 0) ? P.in[I_V2][m * 256 + j] : 0.f;
    const int c2 = tid * 2;
    const float mu0 = mu[c2], mu1 = mu[c2 + 1];
    for (int tile = blockIdx.x; tile < S_ / 16; tile += gridDim.x) {
        const int t0 = tile * 16;
        __syncthreads();
        {
            unsigned cu[17];
            cu[0] = (t0 > 0) ? *(const unsigned*)(ZC + (size_t)(t0 - 1) * 1024 + c2) : 0u;
#pragma unroll
            for (int i = 0; i < 16; ++i) cu[i + 1] = *(const unsigned*)(ZC + (size_t)(t0 + i) * 1024 + c2);
#pragma unroll
            for (int i = 0; i < 16; ++i) {
                const float p0 = bflo(cu[i]), p1 = bfhi(cu[i]), c0 = bflo(cu[i + 1]), c1 = bfhi(cu[i + 1]);
                float m0 = c0 + (p0 - c0) * mu0, m1 = c1 + (p1 - c1) * mu1;
                if (c2 >= 768 && c2 < 832) { m0 = tanhf(m0); m1 = tanhf(m1); }
                else if (c2 >= 896) { m0 = sigm(m0); m1 = sigm(m1); }
                f32x2v mm; mm.x = m0; mm.y = m1;
                *(f32x2v*)(cmL + i * CMS + c2) = mm;
            }
        }
        __syncthreads();
        {
#pragma unroll 2
            for (int i = 0; i < 6; ++i) {
                const int nt = 6 * w + i, seg = nt >> 4, n0 = (nt & 15) * 16;
                const int cmoff = (seg == 0) ? 768 : (seg == 1 ? 832 : 896);
                f32x4 acc = (f32x4){0.f, 0.f, 0.f, 0.f};
                if (seg == 2) {
                    const bf16_t* Wp = WT + WT_G2 + (size_t)(n0 + lr) * 128 + 8 * lq;
                    bf16x8 bq[4];
#pragma unroll
                    for (int ks = 0; ks < 4; ++ks) bq[ks] = *(const bf16x8*)(Wp + 32 * ks);
#pragma unroll
                    for (int ks = 0; ks < 4; ++ks) acc = __builtin_amdgcn_mfma_f32_16x16x32_bf16(lds_f32x8_to_bf16(cmL + lr * CMS + cmoff + 32 * ks + 8 * lq), bq[ks], acc, 0, 0, 0);
                } else {
                    const bf16_t* Wp = WT + ((seg == 0) ? WT_W2 : WT_A2) + (size_t)(n0 + lr) * 64 + 8 * lq;
                    bf16x8 bq[2];
#pragma unroll
                    for (int ks = 0; ks < 2; ++ks) bq[ks] = *(const bf16x8*)(Wp + 32 * ks);
#pragma unroll
                    for (int ks = 0; ks < 2; ++ks) acc = __builtin_amdgcn_mfma_f32_16x16x32_bf16(lds_f32x8_to_bf16(cmL + lr * CMS + cmoff + 32 * ks + 8 * lq), bq[ks], acc, 0, 0, 0);
                }
#pragma unroll
                for (int e = 0; e < 4; ++e) loraL[(4 * lq + e) * 768 + seg * 256 + n0 + lr] = acc[e];
            }
            if (layer > 0 && w < 2) {
                f32x4 acc = (f32x4){0.f, 0.f, 0.f, 0.f};
                const bf16_t* Vp = WT + WT_V1 + (size_t)(16 * w + lr) * 256 + 8 * lq;
#pragma unroll
                for (int ks = 0; ks < 8; ++ks) {
                    const bf16x8 b = *(const bf16x8*)(Vp + 32 * ks);
                    const bf16x8 a = lds_f32x8_to_bf16(cmL + lr * CMS + 512 + 32 * ks + 8 * lq);
                    acc = __builtin_amdgcn_mfma_f32_16x16x32_bf16(a, b, acc, 0, 0, 0);
                }
#pragma unroll
                for (int e = 0; e < 4; ++e) uL[(4 * lq + e) * 32 + 16 * w + lr] = acc[e];
            }
        }
        __syncthreads();
#pragma unroll
        for (int tt = 0; tt < 8; ++tt) {
            const int t = t0 + tb + tt; const float* cr = cmL + (tb + tt) * CMS; const float* lo = loraL + (tb + tt) * 768;
            const float r = cr[j], k = cr[256 + j]; float v = cr[512 + j];
            const float x = -(w0j + lo[j]);
            const float sp = fmaxf(x, 0.f) + log1pf(__expf(-fabsf(x)));
            const float e = __expf(-sp - 0.5f);
            const float a = sigm(a0j + lo[256 + j]);
            const float g = lo[512 + j];
            if (layer == 0) { VF[(size_t)t * 256 + j] = (h16)v; }
            else {
                float acc = v0j;
#pragma unroll
                for (int m = 0; m < 32; ++m) acc += uL[(tb + tt) * 32 + m] * v2c[m];
                const float vf = (float)VF[(size_t)t * 256 + j];
                v = v + (vf - v) * sigm(acc);
            }
            float kk = k * kkj; const float ss = wave_sum(kk * kk); kk = kk / fmaxf(sqrtf(ss), 1e-12f);
            const float k2 = k * (1.f + (a - 1.f) * kaj);
            const size_t o = (size_t)t * 256 + j;
            RK[0 * RKSZ + o] = (h16)r; RK[1 * RKSZ + o] = (h16)k2; RK[2 * RKSZ + o] = (h16)v; RK[3 * RKSZ + o] = (h16)kk;
            RK[4 * RKSZ + o] = (h16)(kk * a); RK[5 * RKSZ + o] = (h16)e; RK[6 * RKSZ + o] = (h16)g;
        }
    }
}

constexpr int AT_VS = 280;
__device__ __forceinline__ void attn_partial(const Params& P, unsigned char* smem, int tid) {
    using pg8::bf16x8;
    const bf16_t* ZB = (const bf16_t*)(P.ws + OFF_ZB);
    bf16_t* MIX = (bf16_t*)(P.ws + OFF_HN);
    float* LSE = (float*)(P.ws + OFF_LSE);
    bf16_t* Vt = (bf16_t*)smem;
    const int w = tid >> 6, lane = tid & 63, lr = lane & 15, lq = lane >> 4;
    for (int item = blockIdx.x; item < 1536; item += gridDim.x) {
        const int p = item >> 9, rem = item & 511, h = rem & 3, rest = rem >> 2;
        const int d = (p == 0) ? 1 : (p == 1 ? 4 : 16);
        const int nqb = 128 / d, r = rest / nqb, qb = rest % nqb;
        const int L0 = qb * 128, l0 = L0 + 16 * w;
        __syncthreads();
        {
            const int kl = tid & 255, hf = tid >> 8, kidx = L0 - 128 + kl;
            u32x4 x[4];
            if (kidx >= 0) {
                const u32x4* src = (const u32x4*)(ZB + (size_t)(kidx * d + r) * 768 + 512 + h * 64 + 32 * hf);
#pragma unroll
                for (int c = 0; c < 4; ++c) x[c] = src[c];
            } else {
#pragma unroll
                for (int c = 0; c < 4; ++c) x[c] = (u32x4){0u, 0u, 0u, 0u};
            }
#pragma unroll
            for (int c = 0; c < 4; ++c)
#pragma unroll
                for (int e = 0; e < 4; ++e) {
                    const unsigned u = x[c][e];
                    Vt[(32 * hf + 8 * c + 2 * e) * AT_VS + kl] = (bf16_t)(u & 0xffffu);
                    Vt[(32 * hf + 8 * c + 2 * e + 1) * AT_VS + kl] = (bf16_t)(u >> 16);
                }
            *(unsigned*)(Vt + (tid >> 3) * AT_VS + 256 + (tid & 7) * 2) = 0u;
        }
        __syncthreads();
        const size_t qtok = (size_t)((l0 + lr) * d + r);
        bf16x8 qf[2];
#pragma unroll
        for (int ks = 0; ks < 2; ++ks) qf[ks] = *(const bf16x8*)(ZB + qtok * 768 + h * 64 + 32 * ks + 8 * lq);
        f32x4 sc[9];
#pragma unroll
        for (int kt = 0; kt < 9; ++kt) {
            const int kbase = l0 - 128 + 16 * kt;
            sc[kt] = (f32x4){0.f, 0.f, 0.f, 0.f};
            if (kbase >= 0) {
                const bf16_t* kp = ZB + (size_t)((kbase + lr) * d + r) * 768 + 256 + h * 64 + 8 * lq;
                const bf16x8 a0 = *(const bf16x8*)kp, a1 = *(const bf16x8*)(kp + 32);
                sc[kt] = __builtin_amdgcn_mfma_f32_16x16x32_bf16(a0, qf[0], sc[kt], 0, 0, 0);
                sc[kt] = __builtin_amdgcn_mfma_f32_16x16x32_bf16(a1, qf[1], sc[kt], 0, 0, 0);
            }
        }
        const int qidx = l0 + lr;
        float m = -1e30f;
#pragma unroll
        for (int kt = 0; kt < 9; ++kt)
#pragma unroll
            for (int e = 0; e < 4; ++e) {
                const int kidx = l0 - 128 + 16 * kt + 4 * lq + e;
                const bool valid = (kidx >= 0) && (kidx <= qidx) && (kidx >= qidx - 128);
                const float sv = valid ? sc[kt][e] * 0.125f : -1e30f;
                sc[kt][e] = sv; m = fmaxf(m, sv);
            }
        m = fmaxf(m, __shfl_xor(m, 16)); m = fmaxf(m, __shfl_xor(m, 32));
        float sum = 0.f;
#pragma unroll
        for (int kt = 0; kt < 9; ++kt)
#pragma unroll
            for (int e = 0; e < 4; ++e) {
                const float sv = sc[kt][e];
                const float pv = (sv > -1e29f) ? __expf(sv - m) : 0.f;
                sc[kt][e] = pv; sum += pv;
            }
        sum += __shfl_xor(sum, 16); sum += __shfl_xor(sum, 32);
        f32x4 acc[4];
#pragma unroll
        for (int n = 0; n < 4; ++n) acc[n] = (f32x4){0.f, 0.f, 0.f, 0.f};
#pragma unroll
        for (int s5 = 0; s5 < 5; ++s5) {
            u32x4 pw;
            pw.x = pk2(sc[2 * s5][0], sc[2 * s5][1]); pw.y = pk2(sc[2 * s5][2], sc[2 * s5][3]);
            if (s5 < 4) { pw.z = pk2(sc[2 * s5 + 1][0], sc[2 * s5 + 1][1]); pw.w = pk2(sc[2 * s5 + 1][2], sc[2 * s5 + 1][3]); } else { pw.z = 0u; pw.w = 0u; }
            const bf16x8 pf = __builtin_bit_cast(bf16x8, pw);
#pragma unroll
            for (int n = 0; n < 4; ++n) {
                const bf16_t* vp = Vt + (16 * n + lr) * AT_VS + 16 * w + 32 * s5 + 4 * lq;
                const f32x2v lo = *(const f32x2v*)vp, hi = *(const f32x2v*)(vp + 16);
                f32x4 vv; vv.x = lo.x; vv.y = lo.y; vv.z = hi.x; vv.w = hi.y;
                const bf16x8 vf = __builtin_bit_cast(bf16x8, vv);
                acc[n] = __builtin_amdgcn_mfma_f32_16x16x32_bf16(vf, pf, acc[n], 0, 0, 0);
            }
        }
        const float inv = 1.f / sum;
        const int slot = ((p == 0) ? 0 : (p == 1 ? 256 : 768)) + h * 64;
        bf16_t* orow = MIX + qtok * 1024 + slot + 4 * lq;
#pragma unroll
        for (int n = 0; n < 4; ++n) {
            const unsigned long long o8 = (unsigned long long)pk2(acc[n][0] * inv, acc[n][1] * inv) | ((unsigned long long)pk2(acc[n][2] * inv, acc[n][3] * inv) << 32);
            *(unsigned long long*)(orow + 16 * n) = o8;
        }
        if (lq == 0) LSE[((size_t)p * S_ + qtok) * 4 + h] = m + __logf(sum);
    }
}

__device__ __forceinline__ void attn_combine(const Params& P, int tid, int first = -1, int step = 0) {
    bf16_t* MIX = (bf16_t*)(P.ws + OFF_HN);
    const float* LSE = (const float*)(P.ws + OFF_LSE);
    const int total = S_ * 4 * 8;
    for (int it = (first >= 0 ? first : (int)(blockIdx.x * NTHREADS + tid)); it < total; it += (first >= 0 ? step : (int)(gridDim.x * NTHREADS))) {
        const int c8 = it & 7, h = (it >> 3) & 3, t = it >> 5;
        const float l0 = LSE[((size_t)0 * S_ + t) * 4 + h], l1 = LSE[((size_t)1 * S_ + t) * 4 + h], l2 = LSE[((size_t)2 * S_ + t) * 4 + h];
        const float mx = fmaxf(l0, fmaxf(l1, l2));
        float w0 = __expf(l0 - mx), w1 = __expf(l1 - mx), w2 = __expf(l2 - mx);
        const float inv = 1.f / (w0 + w1 + w2); w0 *= inv; w1 *= inv; w2 *= inv;
        const size_t rb = (size_t)t * 1024 + h * 64 + c8 * 8;
        const u32x4 a = *(const u32x4*)(MIX + rb), b = *(const u32x4*)(MIX + rb + 256), c = *(const u32x4*)(MIX + rb + 768);
        u32x4 o;
        o.x = pk2(w0 * bflo(a.x) + w1 * bflo(b.x) + w2 * bflo(c.x), w0 * bfhi(a.x) + w1 * bfhi(b.x) + w2 * bfhi(c.x));
        o.y = pk2(w0 * bflo(a.y) + w1 * bflo(b.y) + w2 * bflo(c.y), w0 * bfhi(a.y) + w1 * bfhi(b.y) + w2 * bfhi(c.y));
        o.z = pk2(w0 * bflo(a.z) + w1 * bflo(b.z) + w2 * bflo(c.z), w0 * bfhi(a.z) + w1 * bfhi(b.z) + w2 * bfhi(c.z));
        o.w = pk2(w0 * bflo(a.w) + w1 * bflo(b.w) + w2 * bflo(c.w), w0 * bfhi(a.w) + w1 * bfhi(b.w) + w2 * bfhi(c.w));
        *(u32x4*)(MIX + rb + 512) = o;
    }
}

__device__ __forceinline__ float hgrn_lb(const Params& P, int layer, int idx) {
    if (layer == 0) return 0.f;
    return sigm(P.in[I_LB][512 + idx] - P.in[I_LB][idx]);
}

__device__ __forceinline__ void hgrn_pass1(const Params& P, int layer, unsigned char* smem, int tid) {
    using pg8::bf16x8;
    bf16_t* Vt = (bf16_t*)smem;
    bf16_t* KhT = Vt + 128 * 72;
    float* tot = (float*)(KhT + 128 * 72);
    bf16_t* Rf = (bf16_t*)(tot + 512);
    bf16_t* Ri = Rf + 64 * 128;
    const bf16_t* ZH = (const bf16_t*)(P.ws + OFF_ZH);
    bf16_t* NC = (bf16_t*)(P.ws + OFF_ZC);
    float* GB = (float*)(P.ws + OFF_GB);
    const int k = tid & 127, qd = tid >> 7;
    const int w = tid >> 6, lane = tid & 63, lr = lane & 15, lq = lane >> 4;
    for (int item = blockIdx.x; item < 1024; item += gridDim.x) {
        const int c = item >> 2, h = item & 3, t0 = c * 64;
        const float lbv = hgrn_lb(P, layer, h * 128 + k);
        __syncthreads();
        {
            u32x4 rv[4];
#pragma unroll
            for (int e = 0; e < 4; ++e) { const int ch = tid + 512 * (e & 1), row = ch >> 4, c8 = (ch & 15) * 8;
                rv[e] = *(const u32x4*)(ZH + (size_t)(t0 + row) * 2048 + ((e < 2) ? 512 : 1024) + h * 128 + c8); }
#pragma unroll
            for (int e = 0; e < 4; ++e) { const int ch = tid + 512 * (e & 1), row = ch >> 4, c8 = (ch & 15) * 8;
                *(u32x4*)(((e < 2) ? Rf : Ri) + row * 128 + c8) = rv[e]; }
        }
        __syncthreads();
        float fl[16], bl[16]; float run = 0.f;
#pragma unroll
        for (int i = 0; i < 16; ++i) {
            const float fr = bf2f(Rf[(16 * qd + i) * 128 + k]);
            const float f = lbv + (1.f - lbv) * sigm(fr);
            fl[i] = f; run += __logf(f); bl[i] = run;
            Vt[k * 72 + 16 * qd + i] = Ri[(16 * qd + i) * 128 + k];
        }
        tot[qd * 128 + k] = run;
        __syncthreads();
        float pre = 0.f, all = 0.f;
#pragma unroll
        for (int q = 0; q < 4; ++q) { const float x = tot[q * 128 + k]; if (q < qd) pre += x; all += x; }
        {
            float kh[16];
#pragma unroll
            for (int i = 0; i < 16; ++i) kh[i] = (1.f - fl[i]) * __expf(all - (pre + bl[i]));
            u32x4 w0, w1;
            w0.x = pk2(kh[0], kh[1]); w0.y = pk2(kh[2], kh[3]); w0.z = pk2(kh[4], kh[5]); w0.w = pk2(kh[6], kh[7]);
            w1.x = pk2(kh[8], kh[9]); w1.y = pk2(kh[10], kh[11]); w1.z = pk2(kh[12], kh[13]); w1.w = pk2(kh[14], kh[15]);
            *(u32x4*)(KhT + k * 72 + 16 * qd) = w0; *(u32x4*)(KhT + k * 72 + 16 * qd + 8) = w1;
        }
        if (qd == 0) GB[(size_t)(c * 4 + h) * 128 + k] = __expf(all);
        __syncthreads();
        bf16x8 af[2];
#pragma unroll
        for (int ks = 0; ks < 2; ++ks) af[ks] = *(const bf16x8*)(KhT + (16 * w + lr) * 72 + 32 * ks + 8 * lq);
#pragma unroll
        for (int vt = 0; vt < 8; ++vt) {
            f32x4 acc = (f32x4){0.f, 0.f, 0.f, 0.f};
#pragma unroll
            for (int ks = 0; ks < 2; ++ks) {
                const bf16x8 b = *(const bf16x8*)(Vt + (16 * vt + lr) * 72 + 32 * ks + 8 * lq);
                acc = __builtin_amdgcn_mfma_f32_16x16x32_bf16(af[ks], b, acc, 0, 0, 0);
            }
            *(unsigned long long*)(NC + ((size_t)(c * 4 + h) * 128 + 16 * vt + lr) * 128 + 16 * w + 4 * lq) = (unsigned long long)pk2_sw(acc[0], acc[1]) | ((unsigned long long)pk2_sw(acc[2], acc[3]) << 32);
        }
    }
}

__device__ __forceinline__ void hgrn_scan(const Params& P, int tid) {
    bf16_t* NC = (bf16_t*)(P.ws + OFF_ZC);
    const float* GB = (const float*)(P.ws + OFF_GB);
    if (tid >= 128) return;
    for (int e = blockIdx.x * 128 + tid; e < 32768; e += gridDim.x * 128) {
        const int h = e >> 13, vr = (e >> 6) & 127, k2 = e & 63;
        float s0 = 0.f, s1 = 0.f;
        for (int c0 = 0; c0 < 256; c0 += 32) {
            unsigned n[32]; f32x2v g[32];
#pragma unroll
            for (int u = 0; u < 32; ++u) {
                n[u] = *(const unsigned*)(NC + ((size_t)((c0 + u) * 4 + h) * 128 + vr) * 128 + 2 * k2);
                g[u] = *(const f32x2v*)(GB + (size_t)((c0 + u) * 4 + h) * 128 + 2 * k2);
            }
#pragma unroll
            for (int u = 0; u < 32; ++u) {
                *(unsigned*)(NC + ((size_t)((c0 + u) * 4 + h) * 128 + vr) * 128 + 2 * k2) = pk2(s0, s1);
                s0 = g[u].x * s0 + bflo(n[u]); s1 = g[u].y * s1 + bfhi(n[u]);
            }
        }
    }
}

constexpr int H3_QS = 136, H3_VS = 72;
__device__ __forceinline__ void hgrn_pass3_item(const Params& P, int layer, unsigned char* smem, int tid, int item) {
    using pg8::bf16x8;
    bf16_t* Qt = (bf16_t*)smem;
    bf16_t* Kt = Qt + 64 * H3_QS;
    bf16_t* Qh = Kt + 64 * H3_QS;
    bf16_t* Vt = Qh + 64 * H3_QS;
    float* tot = (float*)(Vt + 128 * H3_VS);
    float* ssq = tot + 512;
    bf16_t* Rq = (bf16_t*)(ssq + 128);
    const bf16_t* ZH = (const bf16_t*)(P.ws + OFF_ZH);
    const bf16_t* NC = (const bf16_t*)(P.ws + OFF_ZC);
    bf16_t* MIX = (bf16_t*)(P.ws + OFF_HN);
    const int c = item >> 2, h = item & 3, t0 = c * 64;
    const int w3 = tid >> 6, lr3 = tid & 15, lq3 = (tid & 63) >> 4;
    bf16x8 sfr[4][4]; unsigned long long graw[4];
    {
        const int k = tid & 127, qd = tid >> 7;
        const float lbv = hgrn_lb(P, layer, h * 128 + k);
        __syncthreads();
        {
            u32x4 rv[6];
#pragma unroll
            for (int e = 0; e < 6; ++e) { const int ch = tid + 512 * (e & 1), row = ch >> 4, c8 = (ch & 15) * 8;
                rv[e] = *(const u32x4*)(ZH + (size_t)(t0 + row) * 2048 + 512 * (e >> 1) + h * 128 + c8); }
#pragma unroll
            for (int e = 0; e < 6; ++e) { const int ch = tid + 512 * (e & 1), row = ch >> 4, c8 = (ch & 15) * 8;
                *(u32x4*)(Rq + (e >> 1) * (64 * 128) + row * 128 + c8) = rv[e]; }
        }
        __syncthreads();
        const bf16_t* Rf = Rq + 64 * 128; const bf16_t* Ri = Rf + 64 * 128;
        float fl[16], bl[16], qv[16]; float run = 0.f;
#pragma unroll
        for (int i = 0; i < 16; ++i) {
            const float qr = bf2f(Rq[(16 * qd + i) * 128 + k]);
            const float fr = bf2f(Rf[(16 * qd + i) * 128 + k]);
            const float f = lbv + (1.f - lbv) * sigm(fr);
            fl[i] = f; run += __logf(f); bl[i] = run; qv[i] = qr * sigm(qr);
            Vt[k * H3_VS + 16 * qd + i] = Ri[(16 * qd + i) * 128 + k];
        }
        tot[qd * 128 + k] = run;
        __syncthreads();
        float pre = 0.f;
#pragma unroll
        for (int q = 0; q < 4; ++q) { const float x = tot[q * 128 + k]; if (q < qd) pre += x; }
        const float rho = tot[k] + tot[128 + k];
#pragma unroll
        for (int i = 0; i < 16; ++i) {
            const float b = pre + bl[i]; const int row = 16 * qd + i;
            Qt[row * H3_QS + k] = f2bf(qv[i] * __expf(b - rho));
            Kt[row * H3_QS + k] = f2bf((1.f - fl[i]) * __expf(rho - b));
            Qh[row * H3_QS + k] = f2bf(qv[i] * __expf(b));
        }
#pragma unroll
        for (int vt = 0; vt < 4; ++vt) {
            const bf16_t* Sr = NC + ((size_t)(c * 4 + h) * 128 + 64 * (w3 >> 2) + 16 * vt + lr3) * 128 + 8 * lq3;
#pragma unroll
            for (int ks = 0; ks < 4; ++ks) sfr[vt][ks] = *(const bf16x8*)(Sr + 32 * ks);
            graw[vt] = *(const unsigned long long*)(ZH + (size_t)(t0 + 16 * (w3 & 3) + lr3) * 2048 + 1536 + h * 128 + 64 * (w3 >> 2) + 16 * vt + 4 * lq3);
        }
        __syncthreads();
    }
    const int w = tid >> 6, lane = tid & 63, lr = lane & 15, lq = lane >> 4, ti = w & 3, vh = w >> 2;
    f32x4 sc[4];
#pragma unroll
    for (int jt = 0; jt < 4; ++jt) {
        sc[jt] = (f32x4){0.f, 0.f, 0.f, 0.f};
        if (jt <= ti) {
#pragma unroll
            for (int ks = 0; ks < 4; ++ks) {
                const bf16x8 a = *(const bf16x8*)(Kt + (16 * jt + lr) * H3_QS + 32 * ks + 8 * lq);
                const bf16x8 b = *(const bf16x8*)(Qt + (16 * ti + lr) * H3_QS + 32 * ks + 8 * lq);
                sc[jt] = __builtin_amdgcn_mfma_f32_16x16x32_bf16(a, b, sc[jt], 0, 0, 0);
            }
            if (jt == ti) {
#pragma unroll
                for (int e = 0; e < 4; ++e) if (4 * lq + e > lr) sc[jt][e] = 0.f;
            }
        }
    }
    bf16x8 pf[2];
#pragma unroll
    for (int s2 = 0; s2 < 2; ++s2) {
        u32x4 pw; pw.x = pk2_sw(sc[2 * s2][0], sc[2 * s2][1]); pw.y = pk2_sw(sc[2 * s2][2], sc[2 * s2][3]); pw.z = pk2_sw(sc[2 * s2 + 1][0], sc[2 * s2 + 1][1]); pw.w = pk2_sw(sc[2 * s2 + 1][2], sc[2 * s2 + 1][3]);
        pf[s2] = __builtin_bit_cast(bf16x8, pw);
    }
    bf16x8 qh[4];
#pragma unroll
    for (int ks = 0; ks < 4; ++ks) qh[ks] = *(const bf16x8*)(Qh + (16 * ti + lr) * H3_QS + 32 * ks + 8 * lq);
    f32x4 acc[4]; float ss = 0.f;
#pragma unroll
    for (int vt = 0; vt < 4; ++vt) {
        const int v0 = 64 * vh + 16 * vt;
        acc[vt] = (f32x4){0.f, 0.f, 0.f, 0.f};
#pragma unroll
        for (int ks = 0; ks < 4; ++ks) acc[vt] = __builtin_amdgcn_mfma_f32_16x16x32_bf16(sfr[vt][ks], qh[ks], acc[vt], 0, 0, 0);
#pragma unroll
        for (int s2 = 0; s2 < 2; ++s2) {
            const bf16_t* vp = Vt + (v0 + lr) * H3_VS + 32 * s2 + 4 * lq;
            const f32x2v lo = *(const f32x2v*)vp, hi = *(const f32x2v*)(vp + 16);
            f32x4 vv; vv.x = lo.x; vv.y = lo.y; vv.z = hi.x; vv.w = hi.y;
            acc[vt] = __builtin_amdgcn_mfma_f32_16x16x32_bf16(__builtin_bit_cast(bf16x8, vv), pf[s2], acc[vt], 0, 0, 0);
        }
        ss += (acc[vt][0] * acc[vt][0] + acc[vt][1] * acc[vt][1]) + (acc[vt][2] * acc[vt][2] + acc[vt][3] * acc[vt][3]);
    }
    ss += __shfl_xor(ss, 16); ss += __shfl_xor(ss, 32);
    if (lq == 0) ssq[vh * 64 + 16 * ti + lr] = ss;
    __syncthreads();
    const float rinv = rsqrtf((ssq[16 * ti + lr] + ssq[64 + 16 * ti + lr]) * (1.f / 128.f) + 1e-6f);
    const size_t t = (size_t)(t0 + 16 * ti + lr);
#pragma unroll
    for (int vt = 0; vt < 4; ++vt) {
        const int v = 64 * vh + 16 * vt + 4 * lq;
        const f32x4 gn = *(const f32x4*)(P.in[I_GN] + layer * 512 + h * 128 + v);
        const unsigned long long gr8 = graw[vt];
        const float g0 = bflo((unsigned)gr8), g1 = bfhi((unsigned)gr8), g2 = bflo((unsigned)(gr8 >> 32)), g3 = bfhi((unsigned)(gr8 >> 32));
        const float o0 = acc[vt][0] * rinv * gn.x * g0 * sigm(g0), o1 = acc[vt][1] * rinv * gn.y * g1 * sigm(g1);
        const float o2 = acc[vt][2] * rinv * gn.z * g2 * sigm(g2), o3 = acc[vt][3] * rinv * gn.w * g3 * sigm(g3);
        *(unsigned long long*)(MIX + t * 1024 + h * 128 + v) = (unsigned long long)pk2(o0, o1) | ((unsigned long long)pk2(o2, o3) << 32);
    }
}

__device__ __forceinline__ float dpp_f(float x, const int ctrl_sel) {
    const int xi = __float_as_int(x); int r;
    if (ctrl_sel == 0) r = __builtin_amdgcn_update_dpp(0, xi, 0xB1, 0xF, 0xF, true);
    else if (ctrl_sel == 1) r = __builtin_amdgcn_update_dpp(0, xi, 0x4E, 0xF, 0xF, true);
    else if (ctrl_sel == 2) r = __builtin_amdgcn_update_dpp(0, xi, 0x141, 0xF, 0xF, true);
    else r = __builtin_amdgcn_update_dpp(0, xi, 0x140, 0xF, 0xF, true);
    return __int_as_float(r);
}
__device__ __forceinline__ float sum16(float x) { x += dpp_f(x, 0); x += dpp_f(x, 1); x += dpp_f(x, 2); x += dpp_f(x, 3); return x; }

constexpr int RS_T = 32;
constexpr int RS_BUF = 5 * RS_T * 64 + RS_T * 32;
constexpr int RS_G = 32, RS_LS = S_ / RS_G, RS_CPS = RS_LS / RS_T;
__device__ __forceinline__ void rwkv_scan_load(const h16* RK, float* buf, int ch, int h, int vrg, int lt) {
    const int tok = lt >> 3, col = (lt & 7) * 8; const size_t t = (size_t)ch * RS_T + tok;
    const size_t go = t * 256 + h * 64 + col;
    const h16x8 hv0 = *(const h16x8*)(RK + (size_t)5 * RKSZ + go);
    const h16x8 hv1 = *(const h16x8*)(RK + (size_t)3 * RKSZ + go);
    const h16x8 hv2 = *(const h16x8*)(RK + (size_t)4 * RKSZ + go);
    const h16x8 hv3 = *(const h16x8*)(RK + (size_t)1 * RKSZ + go);
    const h16x8 hv4 = *(const h16x8*)(RK + (size_t)0 * RKSZ + go);
    h16x4 vh; vh[0] = (h16)0.f; vh[1] = (h16)0.f; vh[2] = (h16)0.f; vh[3] = (h16)0.f;
    if (vrg >= 0) vh = *(const h16x4*)(RK + (size_t)2 * RKSZ + t * 256 + h * 64 + 32 * vrg + 4 * (lt & 7));
    const h16x8 hvs[5] = {hv0, hv1, hv2, hv3, hv4};
#pragma unroll
    for (int a = 0; a < 5; ++a) {
        const h16x8 hv = hvs[a];
        f32x4 lo, hi;
        lo.x = (float)hv[0]; lo.y = (float)hv[1]; lo.z = (float)hv[2]; lo.w = (float)hv[3]; hi.x = (float)hv[4]; hi.y = (float)hv[5]; hi.z = (float)hv[6]; hi.w = (float)hv[7];
        if (a == 0) { lo.x = __expf(-lo.x); lo.y = __expf(-lo.y); lo.z = __expf(-lo.z); lo.w = __expf(-lo.w); hi.x = __expf(-hi.x); hi.y = __expf(-hi.y); hi.z = __expf(-hi.z); hi.w = __expf(-hi.w); }
        float* d = buf + a * (RS_T * 64) + tok * 64 + col;
        *(f32x4*)d = lo; *(f32x4*)(d + 4) = hi;
    }
    f32x4 vf; vf.x = (float)vh[0]; vf.y = (float)vh[1]; vf.z = (float)vh[2]; vf.w = (float)vh[3];
    *(f32x4*)(buf + 5 * RS_T * 64 + tok * 32 + 4 * (lt & 7)) = vf;
}
__device__ __forceinline__ void hgrn_scan_slice(const Params& P, int t, int slice, float& s0, float& s1) {
    bf16_t* NC = (bf16_t*)(P.ws + OFF_ZC);
    const float* GB = (const float*)(P.ws + OFF_GB);
    const int e = blockIdx.x * 128 + t;
    const int h = e >> 13, vr = (e >> 6) & 127, k2 = e & 63;
    const int c0 = 16 * slice;
    unsigned n[16]; f32x2v g[16];
#pragma unroll
    for (int u = 0; u < 16; ++u) {
        n[u] = *(const unsigned*)(NC + ((size_t)((c0 + u) * 4 + h) * 128 + vr) * 128 + 2 * k2);
        g[u] = *(const f32x2v*)(GB + (size_t)((c0 + u) * 4 + h) * 128 + 2 * k2);
    }
#pragma unroll
    for (int u = 0; u < 16; ++u) {
        *(unsigned*)(NC + ((size_t)((c0 + u) * 4 + h) * 128 + vr) * 128 + 2 * k2) = pk2(s0, s1);
        s0 = g[u].x * s0 + bflo(n[u]); s1 = g[u].y * s1 + bfhi(n[u]);
    }
}
template <bool PASS_A> __device__ __forceinline__ void rwkv_seg_job(const Params& P, unsigned char* smem, int tid, int g, int h, int rgx, bool chain_only = false, bool side_scan = false, bool side_comb = false) {
    float* L = (float*)smem;
    float* srow = L + 2 * RS_BUF;
    const h16* RK = (const h16*)(P.ws + OFF_RK);
    float* LX = (float*)(P.ws + OFF_LX);
    bf16_t* MIX = (bf16_t*)(P.ws + OFF_HN);
    const int w = tid >> 6, lane = tid & 63;
    const int row = 8 * (w & 3) + 2 * (lane >> 4), ks = lane & 15;
    const bool ident = PASS_A && (rgx >= 2);
    const int vrg = ident ? -1 : rgx;
    const int ch0 = g * RS_CPS;
    __syncthreads();
    f32x4 sA = (f32x4){0.f, 0.f, 0.f, 0.f}, sB = sA;
    if (PASS_A) {
        if (ident) {
            const int ra = 32 * (rgx - 2) + row, rb = ra + 1;
            sA.x = (4 * ks + 0 == ra) ? 1.f : 0.f; sA.y = (4 * ks + 1 == ra) ? 1.f : 0.f; sA.z = (4 * ks + 2 == ra) ? 1.f : 0.f; sA.w = (4 * ks + 3 == ra) ? 1.f : 0.f;
            sB.x = (4 * ks + 0 == rb) ? 1.f : 0.f; sB.y = (4 * ks + 1 == rb) ? 1.f : 0.f; sB.z = (4 * ks + 2 == rb) ? 1.f : 0.f; sB.w = (4 * ks + 3 == rb) ? 1.f : 0.f;
        }
    } else {
        float* Xl = L;
        float* sr = srow + row * 64;
        const int lt = tid - 256;
        float* S0 = (float*)(P.ws + OFF_S0);
        if (!chain_only && g > 0 && w < 4) { const float* Sb = S0 + ((size_t)(g * 4 + h) * 64 + 32 * rgx + row) * 64 + 4 * ks; sA = *(const f32x4*)Sb; sB = *(const f32x4*)(Sb + 64); }
        const int gend = chain_only ? g : 0;
        float* srC = L + 8 * 4096 + row * 64;
        const int nrounds = (gend + 3) >> 2;
        if (gend > 0 && w >= 4) {
            f32x4 xr[4][4];
#pragma unroll
            for (int q = 0; q < 4; ++q)
#pragma unroll
                for (int e = 0; e < 4; ++e)
                    xr[q][e] = (q < gend) ? *(const f32x4*)(LX + ((size_t)(q * 4 + h) * 128 + 64) * 64 + (size_t)(lt + 256 * e) * 4) : (f32x4){0.f, 0.f, 0.f, 0.f};
#pragma unroll
            for (int q = 0; q < 4; ++q)
#pragma unroll
                for (int e = 0; e < 4; ++e) *(f32x4*)(Xl + q * 4096 + (lt + 256 * e) * 4) = xr[q][e];
        }
        if (gend > 0) __syncthreads();
        for (int r = 0; r < nrounds; ++r) {
            const int g0 = 4 * r, nb = (gend - g0 < 4) ? (gend - g0) : 4;
            float* Xc = Xl + (r & 1) * (4 * 4096);
            if (w >= 4) {
                if (r + 1 < nrounds) {
                    float* Xn = Xl + ((r + 1) & 1) * (4 * 4096); const int gn = g0 + 4, nn = (gend - gn < 4) ? (gend - gn) : 4;
                    f32x4 xr[4][4];
#pragma unroll
                    for (int q = 0; q < 4; ++q)
#pragma unroll
                        for (int e = 0; e < 4; ++e)
                            xr[q][e] = (q < nn) ? *(const f32x4*)(LX + ((size_t)((gn + q) * 4 + h) * 128 + 64) * 64 + (size_t)(lt + 256 * e) * 4) : (f32x4){0.f, 0.f, 0.f, 0.f};
#pragma unroll
                    for (int q = 0; q < 4; ++q)
#pragma unroll
                        for (int e = 0; e < 4; ++e) *(f32x4*)(Xn + q * 4096 + (lt + 256 * e) * 4) = xr[q][e];
                }
            } else {
                for (int q = 0; q < nb; ++q) {
                    const float* Xb = Xc + q * 4096 + 4 * ks;
                    const float* Lb = LX + ((size_t)((g0 + q) * 4 + h) * 128 + 32 * rgx + row) * 64 + 4 * ks;
                    f32x4 nA = *(const f32x4*)Lb, nB = *(const f32x4*)(Lb + 64);
                    *(f32x4*)(srC + 4 * ks) = sA; *(f32x4*)(srC + 64 + 4 * ks) = sB;
                    lds_wait();
#pragma unroll 8
                    for (int kp = 0; kp < 64; ++kp) {
                        const float ska = srC[kp], skb = srC[64 + kp]; const f32x4 xv = *(const f32x4*)(Xb + kp * 64);
                        nA.x += ska * xv.x; nA.y += ska * xv.y; nA.z += ska * xv.z; nA.w += ska * xv.w;
                        nB.x += skb * xv.x; nB.y += skb * xv.y; nB.z += skb * xv.z; nB.w += skb * xv.w;
                    }
                    lds_wait();
                    sA = nA; sB = nB;
                    float* dst = S0 + ((size_t)((g0 + q + 1) * 4 + h) * 64 + 32 * rgx + row) * 64 + 4 * ks;
                    *(f32x4*)dst = sA; *(f32x4*)(dst + 64) = sB;
                }
            }
            __syncthreads();
        }
        if (chain_only) return;
    }
    if (w >= 4) rwkv_scan_load(RK, L, ch0, h, vrg, tid - 256);
    __syncthreads();
    float sc0 = 0.f, sc1 = 0.f;
    for (int cc = 0; cc < RS_CPS; ++cc) {
        const int ch = ch0 + cc;
        float* buf = L + (cc & 1) * RS_BUF;
        if (w >= 4) {
            if (cc + 1 < RS_CPS) rwkv_scan_load(RK, L + ((cc + 1) & 1) * RS_BUF, ch + 1, h, vrg, tid - 256);
            if (PASS_A && side_scan && w >= 6) hgrn_scan_slice(P, tid - 384, cc, sc0, sc1);
            if (PASS_A && side_comb && w >= 6) attn_combine(P, tid, (cc * 256 + (int)blockIdx.x) * 128 + (tid - 384), 1 << 30);
        }
        else {
            const unsigned abase = (unsigned)(size_t)(PG8_LAS float*)buf + 16u * (unsigned)ks;
            const unsigned vbase = (unsigned)(size_t)(PG8_LAS float*)buf + (unsigned)(5 * RS_T * 64 + row) * 4u;
            f32x4 w4n, kk4n, b4n, k4n, r4n = (f32x4){0.f, 0.f, 0.f, 0.f}; f32x2v vvn;
#define RS_LD(tn) do { const unsigned _a = abase + (unsigned)(tn) * 256u; \
                asm volatile("ds_read_b128 %0, %1" : "=v"(w4n) : "v"(_a) : "memory"); \
                asm volatile("ds_read_b128 %0, %1 offset:8192" : "=v"(kk4n) : "v"(_a) : "memory"); \
                asm volatile("ds_read_b128 %0, %1 offset:16384" : "=v"(b4n) : "v"(_a) : "memory"); \
                asm volatile("ds_read_b128 %0, %1 offset:24576" : "=v"(k4n) : "v"(_a) : "memory"); \
                if (!PASS_A) asm volatile("ds_read_b128 %0, %1 offset:32768" : "=v"(r4n) : "v"(_a) : "memory"); \
                { const unsigned _v = vbase + (unsigned)(tn) * 128u; asm volatile("ds_read_b64 %0, %1" : "=v"(vvn) : "v"(_v) : "memory"); } } while (0)
            RS_LD(0);
            float ykA = 0.f, ykB = 0.f;
#pragma unroll 4
            for (int tt = 0; tt < RS_T; ++tt) {
                if (PASS_A) asm volatile("s_waitcnt lgkmcnt(0)" : "+v"(w4n), "+v"(kk4n), "+v"(b4n), "+v"(k4n), "+v"(vvn), "+v"(sA), "+v"(sB) :: "memory");
                else asm volatile("s_waitcnt lgkmcnt(0)" : "+v"(w4n), "+v"(kk4n), "+v"(b4n), "+v"(k4n), "+v"(r4n), "+v"(vvn), "+v"(sA), "+v"(sB) :: "memory");
                const f32x4 w4 = w4n, kk4 = kk4n, b4 = b4n, k4 = k4n, r4 = r4n; const f32x2v vv = vvn;
                const int tn = (tt + 1 < RS_T) ? tt + 1 : tt;
                RS_LD(tn);
                const float dA = (sA.x * kk4.x + sA.y * kk4.y) + (sA.z * kk4.z + sA.w * kk4.w);
                const float dB = (sB.x * kk4.x + sB.y * kk4.y) + (sB.z * kk4.z + sB.w * kk4.w);
                const float saA = -sum16(dA), saB = -sum16(dB);
                sA.x = sA.x * w4.x + (saA * b4.x + vv.x * k4.x); sA.y = sA.y * w4.y + (saA * b4.y + vv.x * k4.y);
                sA.z = sA.z * w4.z + (saA * b4.z + vv.x * k4.z); sA.w = sA.w * w4.w + (saA * b4.w + vv.x * k4.w);
                sB.x = sB.x * w4.x + (saB * b4.x + vv.y * k4.x); sB.y = sB.y * w4.y + (saB * b4.y + vv.y * k4.y);
                sB.z = sB.z * w4.z + (saB * b4.z + vv.y * k4.z); sB.w = sB.w * w4.w + (saB * b4.w + vv.y * k4.w);
                if (!PASS_A) {
                    const float yA = sum16((sA.x * r4.x + sA.y * r4.y) + (sA.z * r4.z + sA.w * r4.w));
                    const float yB = sum16((sB.x * r4.x + sB.y * r4.y) + (sB.z * r4.z + sB.w * r4.w));
                    ykA = (ks == (tt & 15)) ? yA : ykA; ykB = (ks == (tt & 15)) ? yB : ykB;
                    if ((tt & 15) == 15) *(unsigned*)(MIX + ((size_t)ch * RS_T + (tt - 15) + ks) * 1024 + 768 + h * 64 + 32 * rgx + row) = pk2(ykA, ykB);
                }
            }
            asm volatile("s_waitcnt lgkmcnt(0)" ::: "memory");
#undef RS_LD
        }
        __syncthreads();
    }
    if (PASS_A && w < 4) {
        float* dst = LX + ((size_t)(g * 4 + h) * 128 + 32 * rgx + row) * 64 + 4 * ks;
        *(f32x4*)dst = sA; *(f32x4*)(dst + 64) = sB;
    }
}

__device__ __forceinline__ void rwkv_post(const Params& P, int layer, int tid) {
    const int wave = tid >> 6, lane = tid & 63;
    const h16* RK = (const h16*)(P.ws + OFF_RK);
    bf16_t* MIX = (bf16_t*)(P.ws + OFF_HN);
    const float* lnw = P.in[I_LNW] + layer * 256; const float* lnb = P.in[I_LNB] + layer * 256; const float* rk = P.in[I_RK] + layer * 256;
    float lw[4], lb[4], rkk[4];
#pragma unroll
    for (int hh = 0; hh < 4; ++hh) { lw[hh] = lnw[hh * 64 + lane]; lb[hh] = lnb[hh * 64 + lane]; rkk[hh] = rk[hh * 64 + lane]; }
    for (int t = blockIdx.x * 8 + wave; t < S_; t += gridDim.x * 8) {
        float y[4], r[4], k[4], v[4], g[4];
#pragma unroll
        for (int hh = 0; hh < 4; ++hh) {
            const int col = hh * 64 + lane; const size_t o = (size_t)t * 256 + col;
            y[hh] = bf2f(MIX[(size_t)t * 1024 + 768 + col]);
            r[hh] = (float)RK[0 * RKSZ + o]; k[hh] = (float)RK[1 * RKSZ + o]; v[hh] = (float)RK[2 * RKSZ + o]; g[hh] = (float)RK[6 * RKSZ + o];
        }
        float m[4], q[4];
#pragma unroll
        for (int hh = 0; hh < 4; ++hh) { m[hh] = y[hh]; q[hh] = r[hh] * k[hh] * rkk[hh]; }
#pragma unroll
        for (int o = 1; o < 64; o <<= 1) {
#pragma unroll
            for (int hh = 0; hh < 4; ++hh) { m[hh] += __shfl_xor(m[hh], o); q[hh] += __shfl_xor(q[hh], o); }
        }
        float dl[4], var[4];
#pragma unroll
        for (int hh = 0; hh < 4; ++hh) { dl[hh] = y[hh] - m[hh] * (1.f / 64.f); var[hh] = dl[hh] * dl[hh]; }
#pragma unroll
        for (int o = 1; o < 64; o <<= 1) {
#pragma unroll
            for (int hh = 0; hh < 4; ++hh) var[hh] += __shfl_xor(var[hh], o);
        }
#pragma unroll
        for (int hh = 0; hh < 4; ++hh) {
            const float yn = dl[hh] * rsqrtf(var[hh] * (1.f / 64.f) + 64e-5f) * lw[hh] + lb[hh];
            MIX[(size_t)t * 1024 + 768 + hh * 64 + lane] = f2bf((yn + q[hh] * v[hh]) * g[hh]);
        }
    }
}

__device__ __forceinline__ void conv_glu(const Params& P, int layer, int hf, int tid) {
    const bf16_t* U = (const bf16_t*)(P.ws + OFF_U);
    bf16_t* ACT = (bf16_t*)(P.ws + OFF_ACT);
    bf16_t* HALO = (bf16_t*)(P.ws + OFF_HALO);
    const float* cw = P.in[I_CW] + (size_t)layer * 3 * 5632; const float* cb = P.in[I_CB] + (size_t)layer * 5632;
    const int gt = blockIdx.x * NTHREADS + tid, nth = gridDim.x * NTHREADS;
    for (int it = gt; it < 352 * 256; it += nth) {
        const int cgp = it % 352, run = it / 352, c = cgp * 8, lt0 = run * 32;
        float wg[3][8], wv[3][8], bg[8], bv[8];
#pragma unroll
        for (int q = 0; q < 8; ++q) {
            bg[q] = cb[c + q]; bv[q] = cb[2816 + c + q];
#pragma unroll
            for (int jx = 0; jx < 3; ++jx) { wg[jx][q] = cw[jx * 5632 + c + q]; wv[jx][q] = cw[jx * 5632 + 2816 + c + q]; }
        }
        u32x4 g2, g1, v2, v1;
        if (lt0 == 0) {
            if (hf == 0) { g2 = (u32x4){0, 0, 0, 0}; g1 = g2; v2 = g2; v1 = g2; }
            else { g2 = *(const u32x4*)(HALO + c); v2 = *(const u32x4*)(HALO + 2816 + c); g1 = *(const u32x4*)(HALO + 5632 + c); v1 = *(const u32x4*)(HALO + 5632 + 2816 + c); }
        } else {
            g2 = *(const u32x4*)(U + (size_t)(lt0 - 2) * 5632 + c); v2 = *(const u32x4*)(U + (size_t)(lt0 - 2) * 5632 + 2816 + c);
            g1 = *(const u32x4*)(U + (size_t)(lt0 - 1) * 5632 + c); v1 = *(const u32x4*)(U + (size_t)(lt0 - 1) * 5632 + 2816 + c);
        }
        for (int i0 = 0; i0 < 32; i0 += 4) {
            u32x4 gl[4], vl[4];
#pragma unroll
            for (int u = 0; u < 4; ++u) { gl[u] = *(const u32x4*)(U + (size_t)(lt0 + i0 + u) * 5632 + c); vl[u] = *(const u32x4*)(U + (size_t)(lt0 + i0 + u) * 5632 + 2816 + c); }
#pragma unroll
            for (int u = 0; u < 4; ++u) {
                const u32x4 g0 = gl[u], v0 = vl[u];
                float res[8];
#pragma unroll
                for (int q = 0; q < 4; ++q) {
                    const unsigned a2 = g2[q], a1 = g1[q], a0 = g0[q], b2 = v2[q], b1 = v1[q], b0 = v0[q];
                    const float glo = bg[2 * q] + wg[0][2 * q] * bflo(a2) + wg[1][2 * q] * bflo(a1) + wg[2][2 * q] * bflo(a0);
                    const float ghi = bg[2 * q + 1] + wg[0][2 * q + 1] * bfhi(a2) + wg[1][2 * q + 1] * bfhi(a1) + wg[2][2 * q + 1] * bfhi(a0);
                    const float vlo = bv[2 * q] + wv[0][2 * q] * bflo(b2) + wv[1][2 * q] * bflo(b1) + wv[2][2 * q] * bflo(b0);
                    const float vhi = bv[2 * q + 1] + wv[0][2 * q + 1] * bfhi(b2) + wv[1][2 * q + 1] * bfhi(b1) + wv[2][2 * q + 1] * bfhi(b0);
                    res[2 * q] = glo * sigm(glo) * vlo; res[2 * q + 1] = ghi * sigm(ghi) * vhi;
                }
                u32x4 o; o.x = pk2(res[0], res[1]); o.y = pk2(res[2], res[3]); o.z = pk2(res[4], res[5]); o.w = pk2(res[6], res[7]);
                *(u32x4*)(ACT + (size_t)(hf * 8192 + lt0 + i0 + u) * 2816 + c) = o;
                g2 = g1; g1 = g0; v2 = v1; v1 = v0;
            }
        }
    }
    if (hf == 0) {
        for (int it = gt; it < 2 * 704; it += nth) { const int r = it / 704, cc = it % 704; *(u32x4*)(HALO + (size_t)r * 5632 + cc * 8) = *(const u32x4*)(U + (size_t)(8190 + r) * 5632 + cc * 8); }
    }
}

__device__ __forceinline__ void run_phase(const Params& P, int ph, unsigned char* smem, int part) {
    const int tid = launder((int)threadIdx.x), wave = tid >> 6, lane = tid & 63;
    const int gw = blockIdx.x * 8 + wave, ngw = gridDim.x * 8;
    bf16_t* WT = (bf16_t*)(P.ws + OFF_WT);
    bf16_t* HN = (bf16_t*)(P.ws + OFF_HN);
    if (PH(16) && ph == 32) {
        const float* g = P.in[I_NFIN];
        for (int row = gw; row < S_; row += ngw) {
            f32x4* xr = (f32x4*)(P.out + (size_t)row * D_) + lane;
            f32x4 v[4]; float s = 0.f;
#pragma unroll
            for (int j = 0; j < 4; ++j) { v[j] = xr[64 * j]; s += (v[j].x * v[j].x + v[j].y * v[j].y) + (v[j].z * v[j].z + v[j].w * v[j].w); }
            s = wave_sum(s);
            const float r = rsqrtf(s * (1.f / 1024.f) + 1e-6f);
#pragma unroll
            for (int j = 0; j < 4; ++j) { const f32x4 gg = ((const f32x4*)g)[lane + 64 * j]; f32x4 o; o.x = v[j].x * r * gg.x; o.y = v[j].y * r * gg.y; o.z = v[j].z * r * gg.z; o.w = v[j].w * r * gg.w; xr[64 * j] = o; }
        }
        return;
    }
    const int layer = ph >> 4, sub = ph & 15;
    if (PH(0) && sub == 0) { phase_prep(P, layer, smem, tid); return; }
    if (PH(1) && sub == 9) {
        EpiConv E; E.act = (bf16_t*)(P.ws + OFF_ACT); E.hl = (bf16_t*)(P.ws + OFF_U); E.hf = (bf16_t*)(P.ws + OFF_U + 8 * MiB);
        E.cw = P.in[I_CW] + (size_t)layer * 3 * 5632; E.cb = P.in[I_CB] + (size_t)layer * 5632;
        run_gemm(smem, HN, WT + WT_UP, S_, 5632, 1024, E); return;
    }
    if (PH(1) && sub == 10) {
        conv_fixup(P, layer, tid);
        float* SSQ = (float*)(P.ws + OFF_SSQ);
        for (int it = blockIdx.x * NTHREADS + tid; it < S_; it += gridDim.x * NTHREADS) SSQ[it] = 0.f;
        return;
    }
    if (PH(1) && sub == 1) {
        EpiRoute E; const bf16_t* A; const bf16_t* Bt; int M, N;
        if (sub == 1) { A = HN; Bt = WT + WT_IN; M = S_; N = 3840; E.d0 = (bf16_t*)(P.ws + OFF_ZH); E.ld0 = 2048; E.d1 = (bf16_t*)(P.ws + OFF_ZB); E.ld1 = 768; E.d2 = (bf16_t*)(P.ws + OFF_ZC); E.ld2 = 1024; E.c1 = 2048; E.c2 = 2816; }
        else { const int hf = (sub == 11); A = HN + (size_t)hf * 8192 * 1024; Bt = WT + WT_UP; M = 8192; N = 5632; E.d0 = (bf16_t*)(P.ws + OFF_U); E.ld0 = 5632; E.d1 = E.d0; E.ld1 = 5632; E.d2 = E.d0; E.ld2 = 5632; E.c1 = 1 << 30; E.c2 = 1 << 30; }
        run_gemm(smem, A, Bt, M, N, 1024, E); return;
    }
    if (PH(7) && sub == 13) {
        EpiF32<3> E; E.hin = P.out; E.out = P.out; E.hb = HN; E.ssq = (float*)(P.ws + OFF_SSQ);
        run_gemm(smem, (const bf16_t*)(P.ws + OFF_ACT), WT + WT_DOWN, S_, 1024, 2816, E);
        const float* p = P.in[I_P] + (size_t)layer * S_ * 256; bf16_t* PB = (bf16_t*)(P.ws + OFF_PB);
        for (int it = blockIdx.x * NTHREADS + tid; it < S_ * 256 / 8; it += gridDim.x * NTHREADS) {
            const f32x4 a = ((const f32x4*)p)[2 * it], b = ((const f32x4*)p)[2 * it + 1];
            u32x4 o; o.x = pk2(a.x, a.y); o.y = pk2(a.z, a.w); o.z = pk2(b.x, b.y); o.w = pk2(b.z, b.w);
            ((u32x4*)PB)[it] = o;
        }
        return;
    }
    if (PH(7) && sub == 7) {
        EpiF32<0> E; const bf16_t* A; const bf16_t* Bt; int K;
        if (sub == 7) { A = HN; Bt = WT + WT_OUT; K = 1024; E.hin = (layer == 0) ? P.in[I_X] : P.out; }
        else { A = (const bf16_t*)(P.ws + OFF_ACT); Bt = WT + WT_DOWN; K = 2816; E.hin = P.out; }
        E.out = P.out;
        run_gemm(smem, A, Bt, S_, 1024, K, E); return;
    }
    if (PH(15) && sub == 15) {
        float* PP = (float*)(P.ws + OFF_PP);
        { EpiF32<1> E; E.hin = nullptr; E.out = PP; E.hb = nullptr; E.ssq = nullptr; run_gemm(smem, (const bf16_t*)(P.ws + OFF_PB), WT + WT_PROJ, S_, 1024, 256, E); }
        __syncthreads();
        { EpiF32<4> E; E.hin = PP; E.out = P.out; E.hb = nullptr; E.ssq = (float*)(P.ws + OFF_SSQ); run_gemm(smem, HN, WT + WT_GATE, S_, 1024, 1024, E); }
        return;
    }
    if (PH(2) && sub == 2) { rwkv_prep(P, layer, smem, tid); __syncthreads(); attn_partial(P, smem, tid); return; }
    if (PH(3) && (sub == 3 || sub == 4)) {
        const bool full = (gridDim.x == 256);
        if (sub == 3) { hgrn_pass1(P, layer, smem, tid); if (!full) attn_combine(P, tid); }
        const bool ride = (sub == 4) && full;
        if (sub == 4 && !ride) hgrn_scan(P, tid);
        const int base = (sub == 4) ? RS_G * 8 : 0;
        for (int job = base + blockIdx.x; job < base + RS_G * 8; job += gridDim.x) rwkv_seg_job<true>(P, smem, tid, job >> 4, (job >> 2) & 3, job & 3, false, ride, (sub == 3) && full);
        return;
    }
    if (PH(5) && sub == 5) {
        if (part == 0 && blockIdx.x >= 8) { for (int item = blockIdx.x - 8; item < 1024; item += gridDim.x - 8) hgrn_pass3_item(P, layer, smem, tid, item); return; }
        const bool co = (part == 0);
        for (int job = blockIdx.x; job < (co ? 8 : RS_G * 8); job += gridDim.x)
            rwkv_seg_job<false>(P, smem, tid, co ? RS_G - 1 : (job >> 3), co ? (job >> 1) : ((job >> 1) & 3), job & 1, co);
        return;
    }
    if (PH(6) && sub == 6) { rwkv_post(P, layer, tid); return; }
    if (PH(8) && sub == 8) { rmsnorm_rows_bf16(P.out, P.in[I_NFFN] + layer * 1024, HN, gw, ngw, lane); return; }
    if (PH(14) && sub == 14) {
        rmsnorm_rows_bf16(P.out, P.in[I_NPLE] + layer * 1024, HN, gw, ngw, lane);
        const float* p = P.in[I_P] + (size_t)layer * S_ * 256; bf16_t* PB = (bf16_t*)(P.ws + OFF_PB);
        for (int it = blockIdx.x * NTHREADS + tid; it < S_ * 256 / 8; it += gridDim.x * NTHREADS) {
            const f32x4 a = ((const f32x4*)p)[2 * it], b = ((const f32x4*)p)[2 * it + 1];
            u32x4 o; o.x = pk2(a.x, a.y); o.y = pk2(a.z, a.w); o.z = pk2(b.x, b.y); o.w = pk2(b.z, b.w);
            ((u32x4*)PB)[it] = o;
        }
        return;
    }
}

#define XB_TMO      128
#define XB_XCNT(j)  (256  + 64 * (j))
#define XB_XSUB(j)  (1280 + 64 * (j))
#define XB_XGEN(j)  (2304 + 64 * (j))
#define XB_TOP      3328
#define XB_TOPGEN   3392
#define XCD_BAR_WORDS 3456
#define XB_SPIN_CAP (1u << 18)
#define XB_LAS __attribute__((address_space(3)))

__device__ __forceinline__ unsigned xb_ld(unsigned* p)              { return __hip_atomic_load(p, __ATOMIC_RELAXED, __HIP_MEMORY_SCOPE_AGENT); }
__device__ __forceinline__ unsigned xb_add(unsigned* p, unsigned v) { return __hip_atomic_fetch_add(p, v, __ATOMIC_RELAXED, __HIP_MEMORY_SCOPE_AGENT); }
__device__ __forceinline__ unsigned xb_xcc_id() { return (unsigned)__builtin_amdgcn_s_getreg((3 << 11) | 20) & 0xFu; }
#define XB_SPIN(cond, bar) do { unsigned _sp = 0; while (cond) { __builtin_amdgcn_s_sleep(1); \
    if ((++_sp & 255u) == 0u) { if (xb_ld(&(bar)[XB_TMO])) break; if (_sp > XB_SPIN_CAP) { atomicAdd(&(bar)[XB_TMO], 1u); break; } } } } while (0)
struct XcdBarrier {
    unsigned* bar; unsigned x;
    volatile XB_LAS unsigned* st;
};

__device__ __forceinline__ XcdBarrier xcd_barrier_post(unsigned* bar, volatile XB_LAS unsigned* st) {
    XcdBarrier b; b.bar = bar; b.x = xb_xcc_id(); b.st = st;
    if (threadIdx.x == 0) (void)xb_add(&bar[XB_XCNT(b.x)], 1u);
    return b;
}
__device__ __forceinline__ void xcd_barrier_complete(unsigned* bar, unsigned x, unsigned& nloc, unsigned& nx) {
    const unsigned G = gridDim.x * gridDim.y * gridDim.z;
    unsigned sum, cnt, mine, sp = 0u;
    for (;;) {
        sum = 0u; cnt = 0u; mine = 0u;
#pragma unroll
        for (unsigned j = 0; j < 16; ++j) { const unsigned c = xb_ld(&bar[XB_XCNT(j)]); sum += c; cnt += (c > 0u) ? 1u : 0u; mine = (j == x) ? c : mine; }
        if (sum == G) break;
        __builtin_amdgcn_s_sleep(1);
        if ((++sp & 255u) == 0u) { if (xb_ld(&bar[XB_TMO])) break; if (sp > XB_SPIN_CAP) { atomicAdd(&bar[XB_TMO], 1u); break; } }
    }
    nloc = mine > 0u ? mine : 1u; nx = cnt > 0u ? cnt : 1u;
}

__device__ __forceinline__ void xcd_barrier(const XcdBarrier& b) {
    asm volatile("s_waitcnt vmcnt(0)" ::: "memory");
    __syncthreads();
    if (threadIdx.x == 0) {
        unsigned* bar = b.bar;
        __builtin_amdgcn_s_waitcnt(0);
        unsigned nloc = b.st[0], nx = b.st[1];
        if (nloc == 0u) { xcd_barrier_complete(bar, b.x, nloc, nx); b.st[0] = nloc; b.st[1] = nx; }
        const unsigned old = xb_add(&bar[XB_XSUB(b.x)], 1u);
        const unsigned gen = old / nloc;
        if (old + 1u == (gen + 1u) * nloc) {
            __builtin_amdgcn_fence(__ATOMIC_RELEASE, "agent");
            asm volatile("s_waitcnt vmcnt(0)" ::: "memory");
            const unsigned og = xb_add(&bar[XB_TOP], 1u);
            const unsigned tg = og / nx;
            if (og + 1u == (tg + 1u) * nx) xb_add(&bar[XB_TOPGEN], 1u);
            else XB_SPIN(xb_ld(&bar[XB_TOPGEN]) == tg, bar);
            __builtin_amdgcn_fence(__ATOMIC_ACQUIRE, "agent");
            xb_add(&bar[XB_XGEN(b.x)], 1u);
            asm volatile("s_waitcnt vmcnt(0)" ::: "memory");
        } else {
            XB_SPIN(xb_ld(&bar[XB_XGEN(b.x)]) == gen, bar);
            __builtin_amdgcn_fence(__ATOMIC_ACQUIRE, "agent");
            asm volatile("s_waitcnt vmcnt(0)" ::: "memory");
        }
    }
    __syncthreads();
}

constexpr size_t OFF_BAR = 65536;

#ifndef ONE_LAUNCH
#define ONE_LAUNCH 1
#endif

__global__ __launch_bounds__(512, 2) void mega(Params P, int ph_lo, int ph_hi) {
    extern __shared__ __attribute__((aligned(16))) unsigned char smem[];
    cg::grid_group grid = cg::this_grid();
    if (ph_hi == 0x7fffffff) grid.sync();
    volatile XB_LAS unsigned* st = (volatile XB_LAS unsigned*)(smem + LDS_BYTES - 16);
    if (threadIdx.x == 0) { st[0] = 0u; st[1] = 0u; }
    __syncthreads();
    XcdBarrier xb = xcd_barrier_post((unsigned*)(P.ws + OFF_BAR), st);
#ifdef EXTRA_SYNCS
    for (int i = 0; i < EXTRA_SYNCS; ++i) xcd_barrier(xb);
#endif
    for (int ph = ph_lo; ph < ph_hi; ++ph) {
        if (ph < 32 && ((ph & 15) == 11 || (ph & 15) == 12 || (ph & 15) == 14)) continue;
        if (ph > ph_lo) xcd_barrier(xb);
        const int nparts = (ph < 32 && (ph & 15) == 5) ? 2 : 1;
        for (int part = 0; part < nparts; ++part) { if (part) xcd_barrier(xb); run_phase(P, ph, smem, part); }
#ifdef REP_MASK
        if (ph < 32 && ((REP_MASK >> (ph & 15)) & 1)) { xcd_barrier(xb); run_phase(P, ph, smem, 0); }
#endif
    }
}

extern "C" void kernel_launch(void* const* d_in, const int* in_sizes, int n_in, void* d_out, int out_size, void* d_ws, size_t ws_size, hipStream_t stream) {
    static int grid_blocks = 0;
    if (grid_blocks == 0) {
        int dev = 0, cus = 0, per_cu = 0;
        if (hipGetDevice(&dev) != hipSuccess || hipDeviceGetAttribute(&cus, hipDeviceAttributeMultiprocessorCount, dev) != hipSuccess) { fprintf(stderr, "kernel_launch: device query failed\n"); grid_blocks = -1; return; }
        if (hipFuncSetAttribute((const void*)mega, hipFuncAttributeMaxDynamicSharedMemorySize, LDS_BYTES) != hipSuccess) { fprintf(stderr, "kernel_launch: hipFuncSetAttribute failed\n"); grid_blocks = -1; return; }
        if (hipOccupancyMaxActiveBlocksPerMultiprocessor(&per_cu, (const void*)mega, NTHREADS, LDS_BYTES) != hipSuccess || per_cu < 1) { fprintf(stderr, "kernel_launch: occupancy query gave %d\n", per_cu); per_cu = 1; }
        (void)hipGetLastError();
        grid_blocks = cus * per_cu;
        if (n_in != 30 || ws_size < 256 * MiB) fprintf(stderr, "kernel_launch: unexpected n_in %d / ws_size %zu\n", n_in, ws_size);
    }
    if (grid_blocks < 0) return;
    Params P{};
    for (int i = 0; i < 30; ++i) P.in[i] = (const float*)d_in[i];
    P.out = (float*)d_out; P.ws = (unsigned char*)d_ws;
#if ONE_LAUNCH
    if (hipMemsetAsync((char*)d_ws + OFF_BAR, 0, XCD_BAR_WORDS * sizeof(unsigned), stream) != hipSuccess) { fprintf(stderr, "kernel_launch: memset of the barrier words failed\n"); return; }
    int lo = 0, hi = NPH;
    void* args[] = {&P, &lo, &hi};
    hipError_t e = hipLaunchCooperativeKernel((const void*)mega, dim3(grid_blocks), dim3(NTHREADS), args, LDS_BYTES, stream);
    if (e != hipSuccess) fprintf(stderr, "cooperative launch failed: %s (grid %d)\n", hipGetErrorString(e), grid_blocks);
#else
    for (int ph = 0; ph < NPH; ++ph) hipLaunchKernelGGL(mega, dim3(grid_blocks), dim3(NTHREADS), LDS_BYTES, stream, P, ph, ph + 1);
#endif
}
```

```cpp
#include <hip/hip_runtime.h>
#include <hip/hip_cooperative_groups.h>
#include <cstdio>
#include <cstdint>
namespace cg = cooperative_groups;
namespace pg8 {
#define PG8_LAS __attribute__((address_space(3)))
typedef unsigned short bf16_t;
typedef short bf16x8 __attribute__((ext_vector_type(8)));
typedef float f32x4 __attribute__((ext_vector_type(4)));
typedef unsigned u32x4 __attribute__((ext_vector_type(4)));
constexpr int BM = 256, BK = 64, HALF = 128, HTB = HALF * BK * 2  , STAGE_BYTES = 8 * HTB, NXCD = 8, WGM = 8;

__host__ __device__ __forceinline__ int lds_byte(int r, int c) { const int st = (r >> 4) * 2 + (c >> 5), rr = r & 15, cc = c & 31, ob = rr * 64 + cc * 2; return st * 1024 + (ob ^ (((ob >> 9) & 1) << 5)); }
__host__ __device__ __forceinline__ void stage_rc(int b, int& R, int& C) { const int st = b / 1024, sb = b % 1024, swz = sb ^ (((sb >> 9) & 1) << 5); R = (st >> 1) * 16 + swz / 64; C = (st & 1) * 32 + (swz % 64) / 2; }
__host__ __device__ __forceinline__ int perm32(int rho) { const int n = rho >> 4, i = rho & 15; return 8 * (i >> 2) + 4 * n + (i & 3); }

struct Unit { int pm, pn; };
struct Gemm { const bf16_t* A; const bf16_t* Bt; int M, N, K; };

struct StaticOrder {
    int nM, nN, nwg, G, c;
    __host__ __device__ void init(int M, int N, int G_, int c_) { nM = M / BM; nN = N / BM; nwg = nM * nN; G = G_; c = c_; }
    __host__ __device__ bool next(int i, Unit& u) const {
        const long L = (long)i * G + c; if (L >= nwg) return false;
        int wgid = (int)L; { const int q = nwg / NXCD, r = nwg % NXCD, xcd = wgid % NXCD, off = wgid / NXCD; wgid = (xcd < r ? xcd * (q + 1) : r * (q + 1) + (xcd - r) * q) + off; }
        const int nig = WGM * nN, gid = wgid / nig, fm = gid * WGM, gsz = (nM - fm) < WGM ? (nM - fm) : WGM;
        u.pm = fm + ((wgid % nig) % gsz); u.pn = (wgid % nig) / gsz; return true;
    }
    __device__ __forceinline__ void a_ready(const Unit&) const {}
    __device__ __forceinline__ void done(const Unit&) const {}
};
__device__ __forceinline__ unsigned cvt_pk_bf16(float lo, float hi) { unsigned r; asm volatile("v_cvt_pk_bf16_f32 %0, %1, %2" : "=v"(r) : "v"(lo), "v"(hi)); return r; }
typedef float f32x2 __attribute__((ext_vector_type(2)));
template <class Epi, class Sched, bool STAMP = false>
__device__ __forceinline__ void gemm_phase(PG8_LAS unsigned char* lds, const Gemm g, const Sched& S, const Epi& E, unsigned long long* stamps) {
    int tid_l = threadIdx.x; asm volatile("" : "+v"(tid_l)); const int tid = tid_l, wid = __builtin_amdgcn_readfirstlane(tid >> 6), lane = tid & 63, wr = wid >> 2, wc = wid & 3, fr = lane & 15, fq = lane >> 4;
    const int K = g.K, nt = K / BK;
    int ts_lo = 0, ts_hi = 0, nts = 0; const unsigned long long rt_entry = STAMP ? (unsigned long long)wall_clock64() : 0ull;
#define PG8_STAMP() do { if (STAMP && wid == 0 && nts < 64) { const unsigned long long _c = (unsigned long long)clock64(); \
        ts_lo = (lane == nts) ? (int)(unsigned)_c : ts_lo; ts_hi = (lane == nts) ? (int)(unsigned)(_c >> 32) : ts_hi; ++nts; } } while (0)
    PG8_STAMP();
    unsigned voffA[2], voffB[2];
#pragma unroll
    for (int i = 0; i < 2; ++i) { int R, C; stage_rc(tid * 16 + i * 8192, R, C); const int Rb = Epi::PERM ? ((R & ~31) + perm32(R & 31)) : R;
        voffA[i] = (unsigned)(R * K + C) * 2u; voffB[i] = (unsigned)(Rb * K + C) * 2u; }
    const size_t kstep = (size_t)(BK * 2);
    const size_t hstep = (size_t)HALF * K * 2;
    const size_t tstep = 2 * hstep;
    const unsigned ldsw = (unsigned)wid * 1024u;
    const int aoff = lds_byte(wr * 64 + fr, fq * 8), boff = lds_byte(wc * 32 + fr, fq * 8);
#define PG8_SA(b, h) (((b) * 2 + (h)) * HTB)
#define PG8_SB(b, h) ((4 + (b) * 2 + (h)) * HTB)
#define PG8_STAGE(bufoff, gbase, voff) do { _Pragma("unroll") for (int _i = 0; _i < 2; ++_i) \
        __builtin_amdgcn_global_load_lds((const unsigned*)((const char*)(gbase) + (voff)[_i]), (PG8_LAS unsigned*)(lds + (bufoff) + ldsw + _i * 8192), 16, 0, 0); } while (0)
#define PG8_LDA(dst, b, h) do { _Pragma("unroll") for (int m = 0; m < 4; ++m) _Pragma("unroll") for (int k = 0; k < 2; ++k) dst[m][k] = *(const PG8_LAS bf16x8*)(lds + PG8_SA(b, h) + aoff + m * 2048 + k * 1024); } while (0)
#define PG8_LDB(dst, b, h) do { _Pragma("unroll") for (int n = 0; n < 2; ++n) _Pragma("unroll") for (int k = 0; k < 2; ++k) dst[n][k] = *(const PG8_LAS bf16x8*)(lds + PG8_SB(b, h) + boff + n * 2048 + k * 1024); } while (0)
#define PG8_MMA(ai, bj, At, Bt) do { __builtin_amdgcn_s_setprio(1); _Pragma("unroll") for (int m = 0; m < 4; ++m) _Pragma("unroll") for (int n = 0; n < 2; ++n) _Pragma("unroll") for (int k = 0; k < 2; ++k) \
        acc[ai][bj][m][n] = __builtin_amdgcn_mfma_f32_16x16x32_bf16(Bt[n][k], At[m][k], acc[ai][bj][m][n], 0, 0, 0); __builtin_amdgcn_s_setprio(0); } while (0)
#define PG8_WAIT_V(n) asm volatile("s_waitcnt vmcnt(" #n ")" ::: "memory")
#define PG8_WAIT_L(n) asm volatile("s_waitcnt lgkmcnt(" #n ")" ::: "memory")
#define PG8_BAR __builtin_amdgcn_s_barrier()
#define PG8_SCHED __builtin_amdgcn_sched_barrier(0)
    Unit cur, nxt; int ui = 0;
    if (!S.next(0, cur)) return;
    f32x4 acc[2][2][4][2];
#pragma unroll
    for (int a = 0; a < 2; ++a)
#pragma unroll
        for (int b = 0; b < 2; ++b)
#pragma unroll
            for (int m = 0; m < 4; ++m)
#pragma unroll
                for (int n = 0; n < 2; ++n) acc[a][b][m][n] = (f32x4){0.f, 0.f, 0.f, 0.f};
    bf16x8 At[4][2], B0[2][2], B1[2][2];
    const char* cA = (const char*)g.A + (size_t)cur.pm * tstep; const char* cB = (const char*)g.Bt + (size_t)cur.pn * tstep;
    S.a_ready(cur);
    PG8_STAGE(PG8_SB(0, 0), cB, voffB); PG8_STAGE(PG8_SA(0, 0), cA, voffA); PG8_STAGE(PG8_SB(0, 1), cB + hstep, voffB); PG8_STAGE(PG8_SA(0, 1), cA + hstep, voffA);
    if (wr == 1) PG8_BAR;
    PG8_WAIT_V(4); PG8_BAR;
    PG8_STAGE(PG8_SB(1, 0), cB + kstep, voffB); PG8_STAGE(PG8_SA(1, 0), cA + kstep, voffA); PG8_STAGE(PG8_SB(1, 1), cB + hstep + kstep, voffB);
    PG8_WAIT_V(6); PG8_BAR;
    PG8_STAMP();
    for (;;) {
        const bool has_next = S.next(ui + 1, nxt);
        const char* nA = has_next ? (const char*)g.A + (size_t)nxt.pm * tstep : cA; const char* nB = has_next ? (const char*)g.Bt + (size_t)nxt.pn * tstep : cB;
        for (int t = 0; t < nt; t += 2) {
            const bool last = (t == nt - 2);
            const char* a1 = cA + (size_t)(t + 1) * kstep;
            const char* a2 = last ? nA : cA + (size_t)(t + 2) * kstep; const char* b2 = last ? nB : cB + (size_t)(t + 2) * kstep;
            const char* a3 = a2 + kstep; const char* b3 = b2 + kstep;
            if (last && has_next) S.a_ready(nxt);
            PG8_LDB(B0, 0, 0); PG8_SCHED; PG8_LDA(At, 0, 0); PG8_STAGE(PG8_SA(1, 1), a1 + hstep, voffA);
            PG8_WAIT_L(8); PG8_BAR; PG8_WAIT_L(0); PG8_MMA(0, 0, At, B0); PG8_BAR; PG8_SCHED;
            PG8_LDB(B1, 0, 1); PG8_STAGE(PG8_SB(0, 0), b2, voffB);
            PG8_BAR; PG8_WAIT_L(0); PG8_MMA(0, 1, At, B1); PG8_BAR;
            PG8_LDA(At, 0, 1); PG8_STAGE(PG8_SA(0, 0), a2, voffA);
            PG8_BAR; PG8_WAIT_L(0); PG8_MMA(1, 0, At, B0); PG8_BAR; PG8_SCHED;
            PG8_STAGE(PG8_SB(0, 1), b2 + hstep, voffB);
            PG8_WAIT_V(6); PG8_BAR; PG8_MMA(1, 1, At, B1); PG8_BAR;
            PG8_LDB(B0, 1, 0); PG8_SCHED; PG8_LDA(At, 1, 0); PG8_STAGE(PG8_SA(0, 1), a2 + hstep, voffA);
            PG8_WAIT_L(8); PG8_BAR; PG8_WAIT_L(0); PG8_MMA(0, 0, At, B0); PG8_BAR; PG8_SCHED;
            PG8_LDB(B1, 1, 1); PG8_STAGE(PG8_SB(1, 0), b3, voffB);
            PG8_BAR; PG8_WAIT_L(0); PG8_MMA(0, 1, At, B1); PG8_BAR;
            PG8_LDA(At, 1, 1); PG8_STAGE(PG8_SA(1, 0), a3, voffA);
            PG8_BAR; PG8_WAIT_L(0); PG8_MMA(1, 0, At, B0); PG8_BAR; PG8_SCHED;
            PG8_STAGE(PG8_SB(1, 1), b3 + hstep, voffB);
            PG8_WAIT_V(6); PG8_BAR; PG8_MMA(1, 1, At, B1); PG8_BAR;
        }
        PG8_STAMP();
        if constexpr (!Epi::AFTER_DRAIN) { E(acc, cur, wr, wc, fr, fq); S.done(cur); }
        PG8_STAMP();
        if (!has_next) break;
#pragma unroll
        for (int a = 0; a < 2; ++a)
#pragma unroll
            for (int b = 0; b < 2; ++b)
#pragma unroll
                for (int m = 0; m < 4; ++m)
#pragma unroll
                    for (int n = 0; n < 2; ++n) acc[a][b][m][n] = (f32x4){0.f, 0.f, 0.f, 0.f};
        cur = nxt; cA = nA; cB = nB; ++ui;
    }
    PG8_WAIT_V(0);
    if (wr == 0) PG8_BAR;
    PG8_BAR;
    if constexpr (Epi::AFTER_DRAIN) { E.fused(acc, cur, wr, wc, fr, fq, lds, wid, lane); S.done(cur); }
    PG8_STAMP();
    if (STAMP && wid == 0) { stamps[lane] = lane < nts ? (((unsigned long long)(unsigned)ts_hi << 32) | (unsigned)ts_lo) : 0ull;
        if (lane == 62) stamps[62] = rt_entry; if (lane == 63) stamps[63] = (unsigned long long)wall_clock64(); }
#undef PG8_STAMP
#undef PG8_SA
#undef PG8_SB
#undef PG8_STAGE
#undef PG8_LDA
#undef PG8_LDB
#undef PG8_MMA
#undef PG8_WAIT_V
#undef PG8_WAIT_L
#undef PG8_BAR
#undef PG8_SCHED
}
}

using pg8::bf16_t; using pg8::f32x4; using pg8::u32x4; using pg8::Unit;
typedef _Float16 h16;
typedef _Float16 h16x8 __attribute__((ext_vector_type(8)));
typedef _Float16 h16x2 __attribute__((ext_vector_type(2)));
typedef _Float16 h16x4 __attribute__((ext_vector_type(4)));
typedef float f32x2v __attribute__((ext_vector_type(2)));

constexpr int S_ = 16384, D_ = 1024;
constexpr int NTHREADS = 512;
constexpr int LDS_BYTES = 155648;
constexpr size_t MiB = (size_t)1 << 20;
constexpr size_t OFF_HALO = 0, OFF_WT = 1 * MiB, OFF_VF = 30 * MiB, OFF_LX = 38 * MiB, OFF_S0 = 42 * MiB, OFF_HN = 46 * MiB, OFF_BIG = 78 * MiB;
constexpr size_t OFF_ZH = OFF_BIG, OFF_ZB = OFF_BIG + 64 * MiB, OFF_ZC = OFF_BIG + 88 * MiB, OFF_RK = OFF_BIG + 120 * MiB,
                 OFF_LSE = OFF_BIG + 176 * MiB, OFF_GB = OFF_BIG + 177 * MiB;
constexpr size_t OFF_U = OFF_BIG, OFF_ACT = OFF_BIG + 88 * MiB;
constexpr size_t OFF_PB = OFF_BIG, OFF_PP = OFF_BIG + 8 * MiB;
constexpr size_t OFF_SSQ = OFF_BIG + 80 * MiB;
constexpr size_t WT_IN = 0, WT_OUT = 3932160, WT_UP = 4980736, WT_DOWN = 10747904, WT_GATE = 13631488, WT_PROJ = 14680064,
                 WT_W2 = 14942208, WT_A2 = 14958592, WT_G2 = 14974976, WT_V1 = 15007744;
constexpr size_t RKSZ = (size_t)S_ * 256;

enum { I_X = 0, I_P, I_WIN, I_WOUT, I_NMIX, I_NFFN, I_NPLE, I_NFIN, I_LB, I_GN, I_MU, I_W0, I_W2, I_A0, I_A2, I_G2, I_KK, I_KA, I_RK,
       I_LNW, I_LNB, I_V0, I_V1, I_V2, I_UP, I_CW, I_CB, I_DOWN, I_PROJ, I_GATE, N_IN };

struct Params { const float* in[30]; float* out; unsigned char* ws; };

constexpr int NPH_LAYER = 16, NPH = 33;
#ifndef PHMASK
#define PHMASK 0x1FFFF
#endif
#define PH(x) ((PHMASK >> (x)) & 1)

__device__ __forceinline__ float bf2f(unsigned short b) { return __uint_as_float(((unsigned)b) << 16); }
__device__ __forceinline__ float bflo(unsigned u) { return __uint_as_float(u << 16); }
__device__ __forceinline__ float bfhi(unsigned u) { return __uint_as_float(u & 0xffff0000u); }
__device__ __forceinline__ unsigned pk2(float lo, float hi) { return pg8::cvt_pk_bf16(lo, hi); }
__device__ __forceinline__ unsigned pk2_sw(float lo, float hi) { unsigned a = __float_as_uint(lo), b = __float_as_uint(hi); a += 0x7fffu + ((a >> 16) & 1u); b += 0x7fffu + ((b >> 16) & 1u); return (a >> 16) | (b & 0xffff0000u); }
__device__ __forceinline__ unsigned short f2bf(float f) { return (unsigned short)(pk2(f, 0.f) & 0xffffu); }
__device__ __forceinline__ float wave_sum(float v) {
#pragma unroll
    for (int o = 1; o < 64; o <<= 1) v += __shfl_xor(v, o);
    return v;
}
__device__ __forceinline__ float sigm(float x) { return __builtin_amdgcn_rcpf(1.f + __expf(-x)); }
__device__ __forceinline__ int launder(int x) { asm volatile("" : "+v"(x)); return x; }
__device__ __forceinline__ void lds_wait() { asm volatile("s_waitcnt lgkmcnt(0)" ::: "memory"); }

__device__ __forceinline__ void transpose_item(const float* __restrict__ W, int K, int N, bf16_t* __restrict__ WT, float* scr, int item, int lane, bool perm_up = false, const float* __restrict__ kscale = nullptr) {
    const int nblk = N / 32, kb = item / nblk, nb = item % nblk, k0 = 64 * kb, n0 = 32 * nb;
    const int d0 = !perm_up ? n0 : ((n0 < 2816) ? (256 * (n0 >> 7) + (n0 & 127)) : (256 * ((n0 - 2816) >> 7) + 128 + ((n0 - 2816) & 127)));
#pragma unroll 8
    for (int i = 0; i < 32; ++i) { const int kk = 2 * i + (lane >> 5); float x = W[(size_t)(k0 + kk) * N + n0 + (lane & 31)]; if (kscale) x *= kscale[k0 + kk]; scr[kk * 33 + (lane & 31)] = x; }
    lds_wait();
    const int c = lane & 7;
#pragma unroll
    for (int j = 0; j < 4; ++j) {
        const int n = (lane >> 3) + 8 * j; const float* s = scr + (8 * c) * 33 + n;
        u32x4 o; o.x = pk2(s[0 * 33], s[1 * 33]); o.y = pk2(s[2 * 33], s[3 * 33]); o.z = pk2(s[4 * 33], s[5 * 33]); o.w = pk2(s[6 * 33], s[7 * 33]);
        *(u32x4*)(WT + (size_t)(d0 + n) * K + k0 + 8 * c) = o;
    }
    lds_wait();
}

__device__ __forceinline__ void rmsnorm_rows_bf16(const float* __restrict__ h, const float* __restrict__ g, bf16_t* __restrict__ out, int gw, int ngw, int lane) {
    f32x4 gg[4];
#pragma unroll
    for (int j = 0; j < 4; ++j) gg[j] = ((const f32x4*)g)[lane + 64 * j];
    for (int row = gw; row < S_; row += 2 * ngw) {
        const f32x4* xa = (const f32x4*)(h + (size_t)row * D_) + lane;
        const f32x4* xb = (const f32x4*)(h + (size_t)(row + ngw) * D_) + lane;
        f32x4 va[4], vb[4]; float sa = 0.f, sb = 0.f;
#pragma unroll
        for (int j = 0; j < 4; ++j) { va[j] = xa[64 * j]; vb[j] = xb[64 * j]; }
#pragma unroll
        for (int j = 0; j < 4; ++j) { sa += (va[j].x * va[j].x + va[j].y * va[j].y) + (va[j].z * va[j].z + va[j].w * va[j].w); sb += (vb[j].x * vb[j].x + vb[j].y * vb[j].y) + (vb[j].z * vb[j].z + vb[j].w * vb[j].w); }
#pragma unroll
        for (int o = 1; o < 64; o <<= 1) { sa += __shfl_xor(sa, o); sb += __shfl_xor(sb, o); }
        const float ra = rsqrtf(sa * (1.f / 1024.f) + 1e-6f), rb = rsqrtf(sb * (1.f / 1024.f) + 1e-6f);
        unsigned long long* oa = (unsigned long long*)(out + (size_t)row * D_) + lane;
        unsigned long long* ob = (unsigned long long*)(out + (size_t)(row + ngw) * D_) + lane;
#pragma unroll
        for (int j = 0; j < 4; ++j) {
            oa[64 * j] = (unsigned long long)pk2(va[j].x * ra * gg[j].x, va[j].y * ra * gg[j].y) | ((unsigned long long)pk2(va[j].z * ra * gg[j].z, va[j].w * ra * gg[j].w) << 32);
            ob[64 * j] = (unsigned long long)pk2(vb[j].x * rb * gg[j].x, vb[j].y * rb * gg[j].y) | ((unsigned long long)pk2(vb[j].z * rb * gg[j].z, vb[j].w * rb * gg[j].w) << 32);
        }
    }
}

__device__ __forceinline__ void phase_prep(const Params& P, int layer, unsigned char* smem, int tid) {
    const int wave = tid >> 6, lane = tid & 63;
    const int gw = blockIdx.x * 8 + wave, ngw = gridDim.x * 8;
    float* scr = (float*)smem + wave * (64 * 33);
    bf16_t* WT = (bf16_t*)(P.ws + OFF_WT);
    constexpr int I0 = 16 * 120, I1 = 16 * 32, I2 = 16 * 176, I3 = 44 * 32, I4 = 16 * 32, I5 = 4 * 32, I6 = 8, I7 = 8, I8 = 16, I9 = 4;
    constexpr int NIT = I0 + I1 + I2 + I3 + I4 + I5 + I6 + I7 + I8 + I9;
    for (int it = gw; it < NIT; it += ngw) {
        int r = it;
        if (r < I0) { transpose_item(P.in[I_WIN] + (size_t)layer * 1024 * 3840, 1024, 3840, WT + WT_IN, scr, r, lane); continue; } r -= I0;
        if (r < I1) { transpose_item(P.in[I_WOUT] + (size_t)layer * 1024 * 1024, 1024, 1024, WT + WT_OUT, scr, r, lane); continue; } r -= I1;
        if (r < I2) { transpose_item(P.in[I_UP] + (size_t)layer * 1024 * 5632, 1024, 5632, WT + WT_UP, scr, r, lane, true); continue; } r -= I2;
        if (r < I3) { transpose_item(P.in[I_DOWN] + (size_t)layer * 2816 * 1024, 2816, 1024, WT + WT_DOWN, scr, r, lane); continue; } r -= I3;
        if (r < I4) { transpose_item(P.in[I_GATE] + (size_t)layer * 1024 * 1024, 1024, 1024, WT + WT_GATE, scr, r, lane, false, P.in[I_NPLE] + layer * 1024); continue; } r -= I4;
        if (r < I5) { transpose_item(P.in[I_PROJ] + (size_t)layer * 256 * 1024, 256, 1024, WT + WT_PROJ, scr, r, lane); continue; } r -= I5;
        if (r < I6) { transpose_item(P.in[I_W2] + (size_t)layer * 64 * 256, 64, 256, WT + WT_W2, scr, r, lane); continue; } r -= I6;
        if (r < I7) { transpose_item(P.in[I_A2] + (size_t)layer * 64 * 256, 64, 256, WT + WT_A2, scr, r, lane); continue; } r -= I7;
        if (r < I8) { transpose_item(P.in[I_G2] + (size_t)layer * 128 * 256, 128, 256, WT + WT_G2, scr, r, lane); continue; } r -= I8;
        transpose_item(P.in[I_V1], 256, 32, WT + WT_V1, scr, r, lane);
    }
    const float* h = (layer == 0) ? P.in[I_X] : P.out;
    rmsnorm_rows_bf16(h, P.in[I_NMIX] + layer * 1024, (bf16_t*)(P.ws + OFF_HN), gw, ngw, lane);
}

struct EpiRoute {
    static constexpr bool PERM = true, AFTER_DRAIN = false;
    bf16_t* d0; bf16_t* d1; bf16_t* d2; int ld0, ld1, ld2, c1, c2;
    __device__ __forceinline__ void operator()(const f32x4 (&acc)[2][2][4][2], const Unit& u, int wr, int wc, int fr, int fq) const {
        int colt = u.pn * 256; bf16_t* base; int ld;
        if (colt < c1) { base = d0; ld = ld0; } else if (colt < c2) { base = d1; ld = ld1; colt -= c1; } else { base = d2; ld = ld2; colt -= c2; }
        const int row0 = u.pm * 256 + wr * 64 + fr, col0 = colt + wc * 32 + 8 * fq;
#pragma unroll
        for (int ai = 0; ai < 2; ++ai)
#pragma unroll
            for (int m = 0; m < 4; ++m) {
                bf16_t* rowp = base + (size_t)(row0 + ai * 128 + m * 16) * ld + col0;
#pragma unroll
                for (int bj = 0; bj < 2; ++bj) {
                    const f32x4 v0 = acc[ai][bj][m][0], v1 = acc[ai][bj][m][1];
                    u32x4 w; w.x = pk2(v0[0], v0[1]); w.y = pk2(v0[2], v0[3]); w.z = pk2(v1[0], v1[1]); w.w = pk2(v1[2], v1[3]);
                    *(u32x4*)(rowp + bj * 128) = w;
                }
            }
    }
};
template <int MODE  > struct EpiF32 {
    static constexpr bool PERM = false, AFTER_DRAIN = false;
    const float* hin; float* out; bf16_t* hb; float* ssq;
    __device__ __forceinline__ void operator()(const f32x4 (&acc)[2][2][4][2], const Unit& u, int wr, int wc, int fr, int fq) const {
        const int row0 = u.pm * 256 + wr * 64 + fr, col0 = u.pn * 256 + wc * 32 + 4 * fq;
#pragma unroll
        for (int ai = 0; ai < 2; ++ai)
#pragma unroll
            for (int m = 0; m < 4; ++m) {
                const int row = row0 + ai * 128 + m * 16;
                const size_t ro = (size_t)row * 1024 + col0;
                float sq = 0.f, rs = 1.f;
                if (MODE == 4) rs = rsqrtf(ssq[row] * (1.f / 1024.f) + 1e-6f);
#pragma unroll
                for (int bj = 0; bj < 2; ++bj)
#pragma unroll
                    for (int n = 0; n < 2; ++n) {
                        const size_t off = ro + bj * 128 + n * 16;
                        const f32x4 a = acc[ai][bj][m][n];
                        if (MODE == 0) { *(f32x4*)(out + off) = *(const f32x4*)(hin + off) + a; }
                        else if (MODE == 1) { *(f32x4*)(out + off) = a; }
                        else if (MODE == 3) {
                            const f32x4 o = *(const f32x4*)(hin + off) + a; *(f32x4*)(out + off) = o;
                            sq += (o.x * o.x + o.y * o.y) + (o.z * o.z + o.w * o.w);
                            *(unsigned long long*)(hb + off) = (unsigned long long)pk2(o.x, o.y) | ((unsigned long long)pk2(o.z, o.w) << 32);
                        }
                        else { const f32x4 pp = *(const f32x4*)(hin + off); f32x4 hv = *(f32x4*)(out + off);
                               hv.x += sigm(a.x * rs) * pp.x; hv.y += sigm(a.y * rs) * pp.y; hv.z += sigm(a.z * rs) * pp.z; hv.w += sigm(a.w * rs) * pp.w; *(f32x4*)(out + off) = hv; }
                    }
                if (MODE == 3) { sq += __shfl_xor(sq, 16); sq += __shfl_xor(sq, 32); if (fq == 0) atomicAdd(ssq + row, sq); }
            }
    }
};

__device__ __forceinline__ float dpp_ror1(float x) { return __int_as_float(__builtin_amdgcn_update_dpp(0, __float_as_int(x), 0x121, 0xF, 0xF, true)); }
__device__ __forceinline__ float dpp_ror2(float x) { return __int_as_float(__builtin_amdgcn_update_dpp(0, __float_as_int(x), 0x122, 0xF, 0xF, true)); }
__device__ __forceinline__ unsigned long long pk4(float a, float b, float c, float d) { return (unsigned long long)pk2_sw(a, b) | ((unsigned long long)pk2_sw(c, d) << 32); }
struct EpiConv {
    static constexpr bool PERM = true, AFTER_DRAIN = false;
    bf16_t* act; bf16_t* hl; bf16_t* hf; const float* cw; const float* cb;
    __device__ __forceinline__ void operator()(const f32x4 (&acc)[2][2][4][2], const Unit& u, int wr, int wc, int fr, int fq) const {
        const int cg0 = 128 * u.pn + 32 * wc + 8 * fq;
#pragma unroll
        for (int n = 0; n < 2; ++n) {
            const int cg = cg0 + 4 * n;
            const f32x4 bg = *(const f32x4*)(cb + cg), bv = *(const f32x4*)(cb + 2816 + cg);
            const f32x4 g0 = *(const f32x4*)(cw + cg), g1 = *(const f32x4*)(cw + 5632 + cg), g2 = *(const f32x4*)(cw + 11264 + cg);
            const f32x4 v0 = *(const f32x4*)(cw + 2816 + cg), v1 = *(const f32x4*)(cw + 5632 + 2816 + cg), v2 = *(const f32x4*)(cw + 11264 + 2816 + cg);
#pragma unroll
            for (int ai = 0; ai < 2; ++ai) {
                const int rbase = 256 * u.pm + 128 * ai + 64 * wr, grp = rbase >> 6;
#pragma unroll
                for (int m = 0; m < 4; ++m) {
                    const f32x4 xg = acc[ai][0][m][n], xv = acc[ai][1][m][n];
                    const f32x4 yg = acc[ai][0][m > 0 ? m - 1 : 0][n], yv = acc[ai][1][m > 0 ? m - 1 : 0][n];
                    f32x4 gt, vl;
#pragma unroll
                    for (int e = 0; e < 4; ++e) {
                        const float u1 = dpp_ror1((fr == 15) ? yg[e] : xg[e]), u2 = dpp_ror2((fr >= 14) ? yg[e] : xg[e]);
                        gt[e] = bg[e] + g0[e] * u2 + g1[e] * u1 + g2[e] * xg[e];
                    }
#pragma unroll
                    for (int e = 0; e < 4; ++e) {
                        const float u1 = dpp_ror1((fr == 15) ? yv[e] : xv[e]), u2 = dpp_ror2((fr >= 14) ? yv[e] : xv[e]);
                        vl[e] = bv[e] + v0[e] * u2 + v1[e] * u1 + v2[e] * xv[e];
                    }
                    const size_t r = (size_t)(rbase + 16 * m + fr);
                    if (m > 0 || fr >= 2)
                        *(unsigned long long*)(act + r * 2816 + cg) = (unsigned long long)pk2(gt[0] * sigm(gt[0]) * vl[0], gt[1] * sigm(gt[1]) * vl[1]) | ((unsigned long long)pk2(gt[2] * sigm(gt[2]) * vl[2], gt[3] * sigm(gt[3]) * vl[3]) << 32);
                    if (m == 0 && fr < 2) {
                        bf16_t* d = hf + (size_t)(grp * 2 + fr) * 5632 + cg;
                        *(unsigned long long*)d = pk4(xg[0], xg[1], xg[2], xg[3]); *(unsigned long long*)(d + 2816) = pk4(xv[0], xv[1], xv[2], xv[3]);
                    }
                    if (m == 3 && fr >= 14) {
                        bf16_t* d = hl + (size_t)(grp * 2 + (fr - 14)) * 5632 + cg;
                        *(unsigned long long*)d = pk4(xg[0], xg[1], xg[2], xg[3]); *(unsigned long long*)(d + 2816) = pk4(xv[0], xv[1], xv[2], xv[3]);
                    }
                }
            }
        }
    }
};
__device__ __forceinline__ void conv_fixup(const Params& P, int layer, int tid) {
    const bf16_t* hl = (const bf16_t*)(P.ws + OFF_U + 16 * MiB); const bf16_t* hf = (const bf16_t*)(P.ws + OFF_U + 24 * MiB);
    bf16_t* ACT = (bf16_t*)(P.ws + OFF_ACT);
    const float* cw = P.in[I_CW] + (size_t)layer * 3 * 5632; const float* cb = P.in[I_CB] + (size_t)layer * 5632;
    for (int it = blockIdx.x * NTHREADS + tid; it < 256 * 2 * 352; it += gridDim.x * NTHREADS) {
        const int cgp = it % 352, rs = it / 352, j = rs >> 1, sidx = rs & 1, c = cgp * 8;
        u32x4 a2[2], a1[2], a0[2];
#pragma unroll
        for (int q = 0; q < 2; ++q) {
            const int off = q * 2816 + c;
            const u32x4 z = (u32x4){0u, 0u, 0u, 0u};
            const u32x4 l0 = (j > 0) ? *(const u32x4*)(hl + (size_t)((j - 1) * 2 + 0) * 5632 + off) : z;
            const u32x4 l1 = (j > 0) ? *(const u32x4*)(hl + (size_t)((j - 1) * 2 + 1) * 5632 + off) : z;
            const u32x4 f0 = *(const u32x4*)(hf + (size_t)(j * 2 + 0) * 5632 + off), f1 = *(const u32x4*)(hf + (size_t)(j * 2 + 1) * 5632 + off);
            if (sidx == 0) { a2[q] = l0; a1[q] = l1; a0[q] = f0; } else { a2[q] = l1; a1[q] = f0; a0[q] = f1; }
        }
        float res[8];
#pragma unroll
        for (int q = 0; q < 4; ++q) {
#pragma unroll
            for (int hh = 0; hh < 2; ++hh) {
                const int cc = c + 2 * q + hh;
                const float ug2 = hh ? bfhi(a2[0][q]) : bflo(a2[0][q]), ug1 = hh ? bfhi(a1[0][q]) : bflo(a1[0][q]), ug0 = hh ? bfhi(a0[0][q]) : bflo(a0[0][q]);
                const float uv2 = hh ? bfhi(a2[1][q]) : bflo(a2[1][q]), uv1 = hh ? bfhi(a1[1][q]) : bflo(a1[1][q]), uv0 = hh ? bfhi(a0[1][q]) : bflo(a0[1][q]);
                const float gt = cb[cc] + cw[cc] * ug2 + cw[5632 + cc] * ug1 + cw[11264 + cc] * ug0;
                const float vl = cb[2816 + cc] + cw[2816 + cc] * uv2 + cw[5632 + 2816 + cc] * uv1 + cw[11264 + 2816 + cc] * uv0;
                res[2 * q + hh] = gt * sigm(gt) * vl;
            }
        }
        u32x4 o; o.x = pk2(res[0], res[1]); o.y = pk2(res[2], res[3]); o.z = pk2(res[4], res[5]); o.w = pk2(res[6], res[7]);
        *(u32x4*)(ACT + (size_t)(64 * j + sidx) * 2816 + c) = o;
    }
}

template <class Epi> __device__ __forceinline__ void run_gemm(unsigned char* smem, const bf16_t* A, const bf16_t* Bt, int M, int N, int K, const Epi& E) {
    pg8::Gemm g; g.A = A; g.Bt = Bt; g.M = M; g.N = N; g.K = K;
    pg8::StaticOrder So; So.init(M, N, (int)gridDim.x, (int)blockIdx.x);
    pg8::gemm_phase<Epi, pg8::StaticOrder, false>((PG8_LAS unsigned char*)smem, g, So, E, nullptr);
}

constexpr int CMS = 1028;
__device__ __forceinline__ pg8::bf16x8 lds_f32x8_to_bf16(const float* p) {
    const f32x4 a = *(const f32x4*)p, b = *(const f32x4*)(p + 4);
    u32x4 w; w.x = pk2(a.x, a.y); w.y = pk2(a.z, a.w); w.z = pk2(b.x, b.y); w.w = pk2(b.z, b.w);
    return __builtin_bit_cast(pg8::bf16x8, w);
}
__device__ __forceinline__ void rwkv_prep(const Params& P, int layer, unsigned char* smem, int tid) {
    using pg8::bf16x8;
    float* cmL = (float*)smem;
    float* loraL = cmL + 16 * CMS;
    float* uL = loraL + 16 * 768;
    const bf16_t* ZC = (const bf16_t*)(P.ws + OFF_ZC);
    const bf16_t* WT = (const bf16_t*)(P.ws + OFF_WT);
    h16* VF = (h16*)(P.ws + OFF_VF);
    h16* RK = (h16*)(P.ws + OFF_RK);
    const float* mu = P.in[I_MU] + layer * 1024;
    const int j = tid & 255, th = tid >> 8, tb = th * 8;
    const int w = tid >> 6, lane = tid & 63, lr = lane & 15, lq = lane >> 4;
    const float w0j = P.in[I_W0][layer * 256 + j], a0j = P.in[I_A0][layer * 256 + j], kkj = P.in[I_KK][layer * 256 + j], kaj = P.in[I_KA][layer * 256 + j];
    const float v0j = (layer > 0) ? P.in[I_V0][j] : 0.f;
    float v2c[32];
#pragma unroll
    for (int m = 0; m < 32; ++m) v2c[m] = (layer > 0) ? P.in[I_V2][m * 256 + j] : 0.f;
    const int c2 = tid * 2;
    const float mu0 = mu[c2], mu1 = mu[c2 + 1];
    for (int tile = blockIdx.x; tile < S_ / 16; tile += gridDim.x) {
        const int t0 = tile * 16;
        __syncthreads();
        {
            unsigned cu[17];
            cu[0] = (t0 > 0) ? *(const unsigned*)(ZC + (size_t)(t0 - 1) * 1024 + c2) : 0u;
#pragma unroll
            for (int i = 0; i < 16; ++i) cu[i + 1] = *(const unsigned*)(ZC + (size_t)(t0 + i) * 1024 + c2);
#pragma unroll
            for (int i = 0; i < 16; ++i) {
                const float p0 = bflo(cu[i]), p1 = bfhi(cu[i]), c0 = bflo(cu[i + 1]), c1 = bfhi(cu[i + 1]);
                float m0 = c0 + (p0 - c0) * mu0, m1 = c1 + (p1 - c1) * mu1;
                if (c2 >= 768 && c2 < 832) { m0 = tanhf(m0); m1 = tanhf(m1); }
                else if (c2 >= 896) { m0 = sigm(m0); m1 = sigm(m1); }
                f32x2v mm; mm.x = m0; mm.y = m1;
                *(f32x2v*)(cmL + i * CMS + c2) = mm;
            }
        }
        __syncthreads();
        {
#pragma unroll 2
            for (int i = 0; i < 6; ++i) {
                const int nt = 6 * w + i, seg = nt >> 4, n0 = (nt & 15) * 16;
                const int cmoff = (seg == 0) ? 768 : (seg == 1 ? 832 : 896);
                f32x4 acc = (f32x4){0.f, 0.f, 0.f, 0.f};
                if (seg == 2) {
                    const bf16_t* Wp = WT + WT_G2 + (size_t)(n0 + lr) * 128 + 8 * lq;
                    bf16x8 bq[4];
#pragma unroll
                    for (int ks = 0; ks < 4; ++ks) bq[ks] = *(const bf16x8*)(Wp + 32 * ks);
#pragma unroll
                    for (int ks = 0; ks < 4; ++ks) acc = __builtin_amdgcn_mfma_f32_16x16x32_bf16(lds_f32x8_to_bf16(cmL + lr * CMS + cmoff + 32 * ks + 8 * lq), bq[ks], acc, 0, 0, 0);
                } else {
                    const bf16_t* Wp = WT + ((seg == 0) ? WT_W2 : WT_A2) + (size_t)(n0 + lr) * 64 + 8 * lq;
                    bf16x8 bq[2];
#pragma unroll
                    for (int ks = 0; ks < 2; ++ks) bq[ks] = *(const bf16x8*)(Wp + 32 * ks);
#pragma unroll
                    for (int ks = 0; ks < 2; ++ks) acc = __builtin_amdgcn_mfma_f32_16x16x32_bf16(lds_f32x8_to_bf16(cmL + lr * CMS + cmoff + 32 * ks + 8 * lq), bq[ks], acc, 0, 0, 0);
                }
#pragma unroll
                for (int e = 0; e < 4; ++e) loraL[(4 * lq + e) * 768 + seg * 256 + n0 + lr] = acc[e];
            }
            if (layer > 0 && w < 2) {
                f32x4 acc = (f32x4){0.f, 0.f, 0.f, 0.f};
                const bf16_t* Vp = WT + WT_V1 + (size_t)(16 * w + lr) * 256 + 8 * lq;
#pragma unroll
                for (int ks = 0; ks < 8; ++ks) {
                    const bf16x8 b = *(const bf16x8*)(Vp + 32 * ks);
                    const bf16x8 a = lds_f32x8_to_bf16(cmL + lr * CMS + 512 + 32 * ks + 8 * lq);
                    acc = __builtin_amdgcn_mfma_f32_16x16x32_bf16(a, b, acc, 0, 0, 0);
                }
#pragma unroll
                for (int e = 0; e < 4; ++e) uL[(4 * lq + e) * 32 + 16 * w + lr] = acc[e];
            }
        }
        __syncthreads();
#pragma unroll
        for (int tt = 0; tt < 8; ++tt) {
            const int t = t0 + tb + tt; const float* cr = cmL + (tb + tt) * CMS; const float* lo = loraL + (tb + tt) * 768;
            const float r = cr[j], k = cr[256 + j]; float v = cr[512 + j];
            const float x = -(w0j + lo[j]);
            const float sp = fmaxf(x, 0.f) + log1pf(__expf(-fabsf(x)));
            const float e = __expf(-sp - 0.5f);
            const float a = sigm(a0j + lo[256 + j]);
            const float g = lo[512 + j];
            if (layer == 0) { VF[(size_t)t * 256 + j] = (h16)v; }
            else {
                float acc = v0j;
#pragma unroll
                for (int m = 0; m < 32; ++m) acc += uL[(tb + tt) * 32 + m] * v2c[m];
                const float vf = (float)VF[(size_t)t * 256 + j];
                v = v + (vf - v) * sigm(acc);
            }
            float kk = k * kkj; const float ss = wave_sum(kk * kk); kk = kk / fmaxf(sqrtf(ss), 1e-12f);
            const float k2 = k * (1.f + (a - 1.f) * kaj);
            const size_t o = (size_t)t * 256 + j;
            RK[0 * RKSZ + o] = (h16)r; RK[1 * RKSZ + o] = (h16)k2; RK[2 * RKSZ + o] = (h16)v; RK[3 * RKSZ + o] = (h16)kk;
            RK[4 * RKSZ + o] = (h16)(kk * a); RK[5 * RKSZ + o] = (h16)e; RK[6 * RKSZ + o] = (h16)g;
        }
    }
}

constexpr int AT_VS = 280;
__device__ __forceinline__ void attn_partial(const Params& P, unsigned char* smem, int tid) {
    using pg8::bf16x8;
    const bf16_t* ZB = (const bf16_t*)(P.ws + OFF_ZB);
    bf16_t* MIX = (bf16_t*)(P.ws + OFF_HN);
    float* LSE = (float*)(P.ws + OFF_LSE);
    bf16_t* Vt = (bf16_t*)smem;
    const int w = tid >> 6, lane = tid & 63, lr = lane & 15, lq = lane >> 4;
    for (int item = blockIdx.x; item < 1536; item += gridDim.x) {
        const int p = item >> 9, rem = item & 511, h = rem & 3, rest = rem >> 2;
        const int d = (p == 0) ? 1 : (p == 1 ? 4 : 16);
        const int nqb = 128 / d, r = rest / nqb, qb = rest % nqb;
        const int L0 = qb * 128, l0 = L0 + 16 * w;
        __syncthreads();
        {
            const int kl = tid & 255, hf = tid >> 8, kidx = L0 - 128 + kl;
            u32x4 x[4];
            if (kidx >= 0) {
                const u32x4* src = (const u32x4*)(ZB + (size_t)(kidx * d + r) * 768 + 512 + h * 64 + 32 * hf);
#pragma unroll
                for (int c = 0; c < 4; ++c) x[c] = src[c];
            } else {
#pragma unroll
                for (int c = 0; c < 4; ++c) x[c] = (u32x4){0u, 0u, 0u, 0u};
            }
#pragma unroll
            for (int c = 0; c < 4; ++c)
#pragma unroll
                for (int e = 0; e < 4; ++e) {
                    const unsigned u = x[c][e];
                    Vt[(32 * hf + 8 * c + 2 * e) * AT_VS + kl] = (bf16_t)(u & 0xffffu);
                    Vt[(32 * hf + 8 * c + 2 * e + 1) * AT_VS + kl] = (bf16_t)(u >> 16);
                }
            *(unsigned*)(Vt + (tid >> 3) * AT_VS + 256 + (tid & 7) * 2) = 0u;
        }
        __syncthreads();
        const size_t qtok = (size_t)((l0 + lr) * d + r);
        bf16x8 qf[2];
#pragma unroll
        for (int ks = 0; ks < 2; ++ks) qf[ks] = *(const bf16x8*)(ZB + qtok * 768 + h * 64 + 32 * ks + 8 * lq);
        f32x4 sc[9];
#pragma unroll
        for (int kt = 0; kt < 9; ++kt) {
            const int kbase = l0 - 128 + 16 * kt;
            sc[kt] = (f32x4){0.f, 0.f, 0.f, 0.f};
            if (kbase >= 0) {
                const bf16_t* kp = ZB + (size_t)((kbase + lr) * d + r) * 768 + 256 + h * 64 + 8 * lq;
                const bf16x8 a0 = *(const bf16x8*)kp, a1 = *(const bf16x8*)(kp + 32);
                sc[kt] = __builtin_amdgcn_mfma_f32_16x16x32_bf16(a0, qf[0], sc[kt], 0, 0, 0);
                sc[kt] = __builtin_amdgcn_mfma_f32_16x16x32_bf16(a1, qf[1], sc[kt], 0, 0, 0);
            }
        }
        const int qidx = l0 + lr;
        float m = -1e30f;
#pragma unroll
        for (int kt = 0; kt < 9; ++kt)
#pragma unroll
            for (int e = 0; e < 4; ++e) {
                const int kidx = l0 - 128 + 16 * kt + 4 * lq + e;
                const bool valid = (kidx >= 0) && (kidx <= qidx) && (kidx >= qidx - 128);
                const float sv = valid ? sc[kt][e] * 0.125f : -1e30f;
                sc[kt][e] = sv; m = fmaxf(m, sv);
            }
        m = fmaxf(m, __shfl_xor(m, 16)); m = fmaxf(m, __shfl_xor(m, 32));
        float sum = 0.f;
#pragma unroll
        for (int kt = 0; kt < 9; ++kt)
#pragma unroll
            for (int e = 0; e < 4; ++e) {
                const float sv = sc[kt][e];
                const float pv = (sv > -1e29f) ? __expf(sv - m) : 0.f;
                sc[kt][e] = pv; sum += pv;
            }
        sum += __shfl_xor(sum, 16); sum += __shfl_xor(sum, 32);
        f32x4 acc[4];
#pragma unroll
        for (int n = 0; n < 4; ++n) acc[n] = (f32x4){0.f, 0.f, 0.f, 0.f};
#pragma unroll
        for (int s5 = 0; s5 < 5; ++s5) {
            u32x4 pw;
            pw.x = pk2(sc[2 * s5][0], sc[2 * s5][1]); pw.y = pk2(sc[2 * s5][2], sc[2 * s5][3]);
            if (s5 < 4) { pw.z = pk2(sc[2 * s5 + 1][0], sc[2 * s5 + 1][1]); pw.w = pk2(sc[2 * s5 + 1][2], sc[2 * s5 + 1][3]); } else { pw.z = 0u; pw.w = 0u; }
            const bf16x8 pf = __builtin_bit_cast(bf16x8, pw);
#pragma unroll
            for (int n = 0; n < 4; ++n) {
                const bf16_t* vp = Vt + (16 * n + lr) * AT_VS + 16 * w + 32 * s5 + 4 * lq;
                const f32x2v lo = *(const f32x2v*)vp, hi = *(const f32x2v*)(vp + 16);
                f32x4 vv; vv.x = lo.x; vv.y = lo.y; vv.z = hi.x; vv.w = hi.y;
                const bf16x8 vf = __builtin_bit_cast(bf16x8, vv);
                acc[n] = __builtin_amdgcn_mfma_f32_16x16x32_bf16(vf, pf, acc[n], 0, 0, 0);
            }
        }
        const float inv = 1.f / sum;
        const int slot = ((p == 0) ? 0 : (p == 1 ? 256 : 768)) + h * 64;
        bf16_t* orow = MIX + qtok * 1024 + slot + 4 * lq;
#pragma unroll
        for (int n = 0; n < 4; ++n) {
            const unsigned long long o8 = (unsigned long long)pk2(acc[n][0] * inv, acc[n][1] * inv) | ((unsigned long long)pk2(acc[n][2] * inv, acc[n][3] * inv) << 32);
            *(unsigned long long*)(orow + 16 * n) = o8;
        }
        if (lq == 0) LSE[((size_t)p * S_ + qtok) * 4 + h] = m + __logf(sum);
    }
}

__device__ __forceinline__ void attn_combine(const Params& P, int tid, int first = -1, int step = 0) {
    bf16_t* MIX = (bf16_t*)(P.ws + OFF_HN);
    const float* LSE = (const float*)(P.ws + OFF_LSE);
    const int total = S_ * 4 * 8;
    for (int it = (first >= 0 ? first : (int)(blockIdx.x * NTHREADS + tid)); it < total; it += (first >= 0 ? step : (int)(gridDim.x * NTHREADS))) {
        const int c8 = it & 7, h = (it >> 3) & 3, t = it >> 5;
        const float l0 = LSE[((size_t)0 * S_ + t) * 4 + h], l1 = LSE[((size_t)1 * S_ + t) * 4 + h], l2 = LSE[((size_t)2 * S_ + t) * 4 + h];
        const float mx = fmaxf(l0, fmaxf(l1, l2));
        float w0 = __expf(l0 - mx), w1 = __expf(l1 - mx), w2 = __expf(l2 - mx);
        const float inv = 1.f / (w0 + w1 + w2); w0 *= inv; w1 *= inv; w2 *= inv;
        const size_t rb = (size_t)t * 1024 + h * 64 + c8 * 8;
        const u32x4 a = *(const u32x4*)(MIX + rb), b = *(const u32x4*)(MIX + rb + 256), c = *(const u32x4*)(MIX + rb + 768);
        u32x4 o;
        o.x = pk2(w0 * bflo(a.x) + w1 * bflo(b.x) + w2 * bflo(c.x), w0 * bfhi(a.x) + w1 * bfhi(b.x) + w2 * bfhi(c.x));
        o.y = pk2(w0 * bflo(a.y) + w1 * bflo(b.y) + w2 * bflo(c.y), w0 * bfhi(a.y) + w1 * bfhi(b.y) + w2 * bfhi(c.y));
        o.z = pk2(w0 * bflo(a.z) + w1 * bflo(b.z) + w2 * bflo(c.z), w0 * bfhi(a.z) + w1 * bfhi(b.z) + w2 * bfhi(c.z));
        o.w = pk2(w0 * bflo(a.w) + w1 * bflo(b.w) + w2 * bflo(c.w), w0 * bfhi(a.w) + w1 * bfhi(b.w) + w2 * bfhi(c.w));
        *(u32x4*)(MIX + rb + 512) = o;
    }
}

__device__ __forceinline__ float hgrn_lb(const Params& P, int layer, int idx) {
    if (layer == 0) return 0.f;
    return sigm(P.in[I_LB][512 + idx] - P.in[I_LB][idx]);
}

__device__ __forceinline__ void hgrn_pass1(const Params& P, int layer, unsigned char* smem, int tid) {
    using pg8::bf16x8;
    bf16_t* Vt = (bf16_t*)smem;
    bf16_t* KhT = Vt + 128 * 72;
    float* tot = (float*)(KhT + 128 * 72);
    bf16_t* Rf = (bf16_t*)(tot + 512);
    bf16_t* Ri = Rf + 64 * 128;
    const bf16_t* ZH = (const bf16_t*)(P.ws + OFF_ZH);
    bf16_t* NC = (bf16_t*)(P.ws + OFF_ZC);
    float* GB = (float*)(P.ws + OFF_GB);
    const int k = tid & 127, qd = tid >> 7;
    const int w = tid >> 6, lane = tid & 63, lr = lane & 15, lq = lane >> 4;
    for (int item = blockIdx.x; item < 1024; item += gridDim.x) {
        const int c = item >> 2, h = item & 3, t0 = c * 64;
        const float lbv = hgrn_lb(P, layer, h * 128 + k);
        __syncthreads();
        {
            u32x4 rv[4];
#pragma unroll
            for (int e = 0; e < 4; ++e) { const int ch = tid + 512 * (e & 1), row = ch >> 4, c8 = (ch & 15) * 8;
                rv[e] = *(const u32x4*)(ZH + (size_t)(t0 + row) * 2048 + ((e < 2) ? 512 : 1024) + h * 128 + c8); }
#pragma unroll
            for (int e = 0; e < 4; ++e) { const int ch = tid + 512 * (e & 1), row = ch >> 4, c8 = (ch & 15) * 8;
                *(u32x4*)(((e < 2) ? Rf : Ri) + row * 128 + c8) = rv[e]; }
        }
        __syncthreads();
        float fl[16], bl[16]; float run = 0.f;
#pragma unroll
        for (int i = 0; i < 16; ++i) {
            const float fr = bf2f(Rf[(16 * qd + i) * 128 + k]);
            const float f = lbv + (1.f - lbv) * sigm(fr);
            fl[i] = f; run += __logf(f); bl[i] = run;
            Vt[k * 72 + 16 * qd + i] = Ri[(16 * qd + i) * 128 + k];
        }
        tot[qd * 128 + k] = run;
        __syncthreads();
        float pre = 0.f, all = 0.f;
#pragma unroll
        for (int q = 0; q < 4; ++q) { const float x = tot[q * 128 + k]; if (q < qd) pre += x; all += x; }
        {
            float kh[16];
#pragma unroll
            for (int i = 0; i < 16; ++i) kh[i] = (1.f - fl[i]) * __expf(all - (pre + bl[i]));
            u32x4 w0, w1;
            w0.x = pk2(kh[0], kh[1]); w0.y = pk2(kh[2], kh[3]); w0.z = pk2(kh[4], kh[5]); w0.w = pk2(kh[6], kh[7]);
            w1.x = pk2(kh[8], kh[9]); w1.y = pk2(kh[10], kh[11]); w1.z = pk2(kh[12], kh[13]); w1.w = pk2(kh[14], kh[15]);
            *(u32x4*)(KhT + k * 72 + 16 * qd) = w0; *(u32x4*)(KhT + k * 72 + 16 * qd + 8) = w1;
        }
        if (qd == 0) GB[(size_t)(c * 4 + h) * 128 + k] = __expf(all);
        __syncthreads();
        bf16x8 af[2];
#pragma unroll
        for (int ks = 0; ks < 2; ++ks) af[ks] = *(const bf16x8*)(KhT + (16 * w + lr) * 72 + 32 * ks + 8 * lq);
#pragma unroll
        for (int vt = 0; vt < 8; ++vt) {
            f32x4 acc = (f32x4){0.f, 0.f, 0.f, 0.f};
#pragma unroll
            for (int ks = 0; ks < 2; ++ks) {
                const bf16x8 b = *(const bf16x8*)(Vt + (16 * vt + lr) * 72 + 32 * ks + 8 * lq);
                acc = __builtin_amdgcn_mfma_f32_16x16x32_bf16(af[ks], b, acc, 0, 0, 0);
            }
            *(unsigned long long*)(NC + ((size_t)(c * 4 + h) * 128 + 16 * vt + lr) * 128 + 16 * w + 4 * lq) = (unsigned long long)pk2_sw(acc[0], acc[1]) | ((unsigned long long)pk2_sw(acc[2], acc[3]) << 32);
        }
    }
}

__device__ __forceinline__ void hgrn_scan(const Params& P, int tid) {
    bf16_t* NC = (bf16_t*)(P.ws + OFF_ZC);
    const float* GB = (const float*)(P.ws + OFF_GB);
    if (tid >= 128) return;
    for (int e = blockIdx.x * 128 + tid; e < 32768; e += gridDim.x * 128) {
        const int h = e >> 13, vr = (e >> 6) & 127, k2 = e & 63;
        float s0 = 0.f, s1 = 0.f;
        for (int c0 = 0; c0 < 256; c0 += 32) {
            unsigned n[32]; f32x2v g[32];
#pragma unroll
            for (int u = 0; u < 32; ++u) {
                n[u] = *(const unsigned*)(NC + ((size_t)((c0 + u) * 4 + h) * 128 + vr) * 128 + 2 * k2);
                g[u] = *(const f32x2v*)(GB + (size_t)((c0 + u) * 4 + h) * 128 + 2 * k2);
            }
#pragma unroll
            for (int u = 0; u < 32; ++u) {
                *(unsigned*)(NC + ((size_t)((c0 + u) * 4 + h) * 128 + vr) * 128 + 2 * k2) = pk2(s0, s1);
                s0 = g[u].x * s0 + bflo(n[u]); s1 = g[u].y * s1 + bfhi(n[u]);
            }
        }
    }
}

constexpr int H3_QS = 136, H3_VS = 72;
__device__ __forceinline__ void hgrn_pass3_item(const Params& P, int layer, unsigned char* smem, int tid, int item) {
    using pg8::bf16x8;
    bf16_t* Qt = (bf16_t*)smem;
    bf16_t* Kt = Qt + 64 * H3_QS;
    bf16_t* Qh = Kt + 64 * H3_QS;
    bf16_t* Vt = Qh + 64 * H3_QS;
    float* tot = (float*)(Vt + 128 * H3_VS);
    float* ssq = tot + 512;
    bf16_t* Rq = (bf16_t*)(ssq + 128);
    const bf16_t* ZH = (const bf16_t*)(P.ws + OFF_ZH);
    const bf16_t* NC = (const bf16_t*)(P.ws + OFF_ZC);
    bf16_t* MIX = (bf16_t*)(P.ws + OFF_HN);
    const int c = item >> 2, h = item & 3, t0 = c * 64;
    const int w3 = tid >> 6, lr3 = tid & 15, lq3 = (tid & 63) >> 4;
    bf16x8 sfr[4][4]; unsigned long long graw[4];
    {
        const int k = tid & 127, qd = tid >> 7;
        const float lbv = hgrn_lb(P, layer, h * 128 + k);
        __syncthreads();
        {
            u32x4 rv[6];
#pragma unroll
            for (int e = 0; e < 6; ++e) { const int ch = tid + 512 * (e & 1), row = ch >> 4, c8 = (ch & 15) * 8;
                rv[e] = *(const u32x4*)(ZH + (size_t)(t0 + row) * 2048 + 512 * (e >> 1) + h * 128 + c8); }
#pragma unroll
            for (int e = 0; e < 6; ++e) { const int ch = tid + 512 * (e & 1), row = ch >> 4, c8 = (ch & 15) * 8;
                *(u32x4*)(Rq + (e >> 1) * (64 * 128) + row * 128 + c8) = rv[e]; }
        }
        __syncthreads();
        const bf16_t* Rf = Rq + 64 * 128; const bf16_t* Ri = Rf + 64 * 128;
        float fl[16], bl[16], qv[16]; float run = 0.f;
#pragma unroll
        for (int i = 0; i < 16; ++i) {
            const float qr = bf2f(Rq[(16 * qd + i) * 128 + k]);
            const float fr = bf2f(Rf[(16 * qd + i) * 128 + k]);
            const float f = lbv + (1.f - lbv) * sigm(fr);
            fl[i] = f; run += __logf(f); bl[i] = run; qv[i] = qr * sigm(qr);
            Vt[k * H3_VS + 16 * qd + i] = Ri[(16 * qd + i) * 128 + k];
        }
        tot[qd * 128 + k] = run;
        __syncthreads();
        float pre = 0.f;
#pragma unroll
        for (int q = 0; q < 4; ++q) { const float x = tot[q * 128 + k]; if (q < qd) pre += x; }
        const float rho = tot[k] + tot[128 + k];
#pragma unroll
        for (int i = 0; i < 16; ++i) {
            const float b = pre + bl[i]; const int row = 16 * qd + i;
            Qt[row * H3_QS + k] = f2bf(qv[i] * __expf(b - rho));
            Kt[row * H3_QS + k] = f2bf((1.f - fl[i]) * __expf(rho - b));
            Qh[row * H3_QS + k] = f2bf(qv[i] * __expf(b));
        }
#pragma unroll
        for (int vt = 0; vt < 4; ++vt) {
            const bf16_t* Sr = NC + ((size_t)(c * 4 + h) * 128 + 64 * (w3 >> 2) + 16 * vt + lr3) * 128 + 8 * lq3;
#pragma unroll
            for (int ks = 0; ks < 4; ++ks) sfr[vt][ks] = *(const bf16x8*)(Sr + 32 * ks);
            graw[vt] = *(const unsigned long long*)(ZH + (size_t)(t0 + 16 * (w3 & 3) + lr3) * 2048 + 1536 + h * 128 + 64 * (w3 >> 2) + 16 * vt + 4 * lq3);
        }
        __syncthreads();
    }
    const int w = tid >> 6, lane = tid & 63, lr = lane & 15, lq = lane >> 4, ti = w & 3, vh = w >> 2;
    f32x4 sc[4];
#pragma unroll
    for (int jt = 0; jt < 4; ++jt) {
        sc[jt] = (f32x4){0.f, 0.f, 0.f, 0.f};
        if (jt <= ti) {
#pragma unroll
            for (int ks = 0; ks < 4; ++ks) {
                const bf16x8 a = *(const bf16x8*)(Kt + (16 * jt + lr) * H3_QS + 32 * ks + 8 * lq);
                const bf16x8 b = *(const bf16x8*)(Qt + (16 * ti + lr) * H3_QS + 32 * ks + 8 * lq);
                sc[jt] = __builtin_amdgcn_mfma_f32_16x16x32_bf16(a, b, sc[jt], 0, 0, 0);
            }
            if (jt == ti) {
#pragma unroll
                for (int e = 0; e < 4; ++e) if (4 * lq + e > lr) sc[jt][e] = 0.f;
            }
        }
    }
    bf16x8 pf[2];
#pragma unroll
    for (int s2 = 0; s2 < 2; ++s2) {
        u32x4 pw; pw.x = pk2_sw(sc[2 * s2][0], sc[2 * s2][1]); pw.y = pk2_sw(sc[2 * s2][2], sc[2 * s2][3]); pw.z = pk2_sw(sc[2 * s2 + 1][0], sc[2 * s2 + 1][1]); pw.w = pk2_sw(sc[2 * s2 + 1][2], sc[2 * s2 + 1][3]);
        pf[s2] = __builtin_bit_cast(bf16x8, pw);
    }
    bf16x8 qh[4];
#pragma unroll
    for (int ks = 0; ks < 4; ++ks) qh[ks] = *(const bf16x8*)(Qh + (16 * ti + lr) * H3_QS + 32 * ks + 8 * lq);
    f32x4 acc[4]; float ss = 0.f;
#pragma unroll
    for (int vt = 0; vt < 4; ++vt) {
        const int v0 = 64 * vh + 16 * vt;
        acc[vt] = (f32x4){0.f, 0.f, 0.f, 0.f};
#pragma unroll
        for (int ks = 0; ks < 4; ++ks) acc[vt] = __builtin_amdgcn_mfma_f32_16x16x32_bf16(sfr[vt][ks], qh[ks], acc[vt], 0, 0, 0);
#pragma unroll
        for (int s2 = 0; s2 < 2; ++s2) {
            const bf16_t* vp = Vt + (v0 + lr) * H3_VS + 32 * s2 + 4 * lq;
            const f32x2v lo = *(const f32x2v*)vp, hi = *(const f32x2v*)(vp + 16);
            f32x4 vv; vv.x = lo.x; vv.y = lo.y; vv.z = hi.x; vv.w = hi.y;
            acc[vt] = __builtin_amdgcn_mfma_f32_16x16x32_bf16(__builtin_bit_cast(bf16x8, vv), pf[s2], acc[vt], 0, 0, 0);
        }
        ss += (acc[vt][0] * acc[vt][0] + acc[vt][1] * acc[vt][1]) + (acc[vt][2] * acc[vt][2] + acc[vt][3] * acc[vt][3]);
    }
    ss += __shfl_xor(ss, 16); ss += __shfl_xor(ss, 32);
    if (lq == 0) ssq[vh * 64 + 16 * ti + lr] = ss;
    __syncthreads();
    const float rinv = rsqrtf((ssq[16 * ti + lr] + ssq[64 + 16 * ti + lr]) * (1.f / 128.f) + 1e-6f);
    const size_t t = (size_t)(t0 + 16 * ti + lr);
#pragma unroll
    for (int vt = 0; vt < 4; ++vt) {
        const int v = 64 * vh + 16 * vt + 4 * lq;
        const f32x4 gn = *(const f32x4*)(P.in[I_GN] + layer * 512 + h * 128 + v);
        const unsigned long long gr8 = graw[vt];
        const float g0 = bflo((unsigned)gr8), g1 = bfhi((unsigned)gr8), g2 = bflo((unsigned)(gr8 >> 32)), g3 = bfhi((unsigned)(gr8 >> 32));
        const float o0 = acc[vt][0] * rinv * gn.x * g0 * sigm(g0), o1 = acc[vt][1] * rinv * gn.y * g1 * sigm(g1);
        const float o2 = acc[vt][2] * rinv * gn.z * g2 * sigm(g2), o3 = acc[vt][3] * rinv * gn.w * g3 * sigm(g3);
        *(unsigned long long*)(MIX + t * 1024 + h * 128 + v) = (unsigned long long)pk2(o0, o1) | ((unsigned long long)pk2(o2, o3) << 32);
    }
}

__device__ __forceinline__ float dpp_f(float x, const int ctrl_sel) {
    const int xi = __float_as_int(x); int r;
    if (ctrl_sel == 0) r = __builtin_amdgcn_update_dpp(0, xi, 0xB1, 0xF, 0xF, true);
    else if (ctrl_sel == 1) r = __builtin_amdgcn_update_dpp(0, xi, 0x4E, 0xF, 0xF, true);
    else if (ctrl_sel == 2) r = __builtin_amdgcn_update_dpp(0, xi, 0x141, 0xF, 0xF, true);
    else r = __builtin_amdgcn_update_dpp(0, xi, 0x140, 0xF, 0xF, true);
    return __int_as_float(r);
}
__device__ __forceinline__ float sum16(float x) { x += dpp_f(x, 0); x += dpp_f(x, 1); x += dpp_f(x, 2); x += dpp_f(x, 3); return x; }

constexpr int RS_T = 32;
constexpr int RS_BUF = 5 * RS_T * 64 + RS_T * 32;
constexpr int RS_G = 32, RS_LS = S_ / RS_G, RS_CPS = RS_LS / RS_T;
__device__ __forceinline__ void rwkv_scan_load(const h16* RK, float* buf, int ch, int h, int vrg, int lt) {
    const int tok = lt >> 3, col = (lt & 7) * 8; const size_t t = (size_t)ch * RS_T + tok;
    const size_t go = t * 256 + h * 64 + col;
    const h16x8 hv0 = *(const h16x8*)(RK + (size_t)5 * RKSZ + go);
    const h16x8 hv1 = *(const h16x8*)(RK + (size_t)3 * RKSZ + go);
    const h16x8 hv2 = *(const h16x8*)(RK + (size_t)4 * RKSZ + go);
    const h16x8 hv3 = *(const h16x8*)(RK + (size_t)1 * RKSZ + go);
    const h16x8 hv4 = *(const h16x8*)(RK + (size_t)0 * RKSZ + go);
    h16x4 vh; vh[0] = (h16)0.f; vh[1] = (h16)0.f; vh[2] = (h16)0.f; vh[3] = (h16)0.f;
    if (vrg >= 0) vh = *(const h16x4*)(RK + (size_t)2 * RKSZ + t * 256 + h * 64 + 32 * vrg + 4 * (lt & 7));
    const h16x8 hvs[5] = {hv0, hv1, hv2, hv3, hv4};
#pragma unroll
    for (int a = 0; a < 5; ++a) {
        const h16x8 hv = hvs[a];
        f32x4 lo, hi;
        lo.x = (float)hv[0]; lo.y = (float)hv[1]; lo.z = (float)hv[2]; lo.w = (float)hv[3]; hi.x = (float)hv[4]; hi.y = (float)hv[5]; hi.z = (float)hv[6]; hi.w = (float)hv[7];
        if (a == 0) { lo.x = __expf(-lo.x); lo.y = __expf(-lo.y); lo.z = __expf(-lo.z); lo.w = __expf(-lo.w); hi.x = __expf(-hi.x); hi.y = __expf(-hi.y); hi.z = __expf(-hi.z); hi.w = __expf(-hi.w); }
        float* d = buf + a * (RS_T * 64) + tok * 64 + col;
        *(f32x4*)d = lo; *(f32x4*)(d + 4) = hi;
    }
    f32x4 vf; vf.x = (float)vh[0]; vf.y = (float)vh[1]; vf.z = (float)vh[2]; vf.w = (float)vh[3];
    *(f32x4*)(buf + 5 * RS_T * 64 + tok * 32 + 4 * (lt & 7)) = vf;
}
__device__ __forceinline__ void hgrn_scan_slice(const Params& P, int t, int slice, float& s0, float& s1) {
    bf16_t* NC = (bf16_t*)(P.ws + OFF_ZC);
    const float* GB = (const float*)(P.ws + OFF_GB);
    const int e = blockIdx.x * 128 + t;
    const int h = e >> 13, vr = (e >> 6) & 127, k2 = e & 63;
    const int c0 = 16 * slice;
    unsigned n[16]; f32x2v g[16];
#pragma unroll
    for (int u = 0; u < 16; ++u) {
        n[u] = *(const unsigned*)(NC + ((size_t)((c0 + u) * 4 + h) * 128 + vr) * 128 + 2 * k2);
        g[u] = *(const f32x2v*)(GB + (size_t)((c0 + u) * 4 + h) * 128 + 2 * k2);
    }
#pragma unroll
    for (int u = 0; u < 16; ++u) {
        *(unsigned*)(NC + ((size_t)((c0 + u) * 4 + h) * 128 + vr) * 128 + 2 * k2) = pk2(s0, s1);
        s0 = g[u].x * s0 + bflo(n[u]); s1 = g[u].y * s1 + bfhi(n[u]);
    }
}
__device__ __forceinline__ void pb_convert_item(const Params& P, int layer, int it) {
    const float* p = P.in[I_P] + (size_t)layer * S_ * 256; bf16_t* PB = (bf16_t*)(P.ws + OFF_PB);
    const f32x4 a = ((const f32x4*)p)[2 * it], b = ((const f32x4*)p)[2 * it + 1];
    u32x4 o; o.x = pk2(a.x, a.y); o.y = pk2(a.z, a.w); o.z = pk2(b.x, b.y); o.w = pk2(b.z, b.w);
    ((u32x4*)PB)[it] = o;
}
template <bool PASS_A> __device__ __forceinline__ void rwkv_seg_job(const Params& P, unsigned char* smem, int tid, int g, int h, int rgx, bool chain_only = false, bool side_scan = false, bool side_comb = false, int layer = 0) {
    float* L = (float*)smem;
    float* srow = L + 2 * RS_BUF;
    const h16* RK = (const h16*)(P.ws + OFF_RK);
    float* LX = (float*)(P.ws + OFF_LX);
    bf16_t* MIX = (bf16_t*)(P.ws + OFF_HN);
    const int w = tid >> 6, lane = tid & 63;
    const int row = 8 * (w & 3) + 2 * (lane >> 4), ks = lane & 15;
    const bool ident = PASS_A && (rgx >= 2);
    const int vrg = ident ? -1 : rgx;
    const int ch0 = g * RS_CPS;
    __syncthreads();
    f32x4 sA = (f32x4){0.f, 0.f, 0.f, 0.f}, sB = sA;
    if (PASS_A) {
        if (ident) {
            const int ra = 32 * (rgx - 2) + row, rb = ra + 1;
            sA.x = (4 * ks + 0 == ra) ? 1.f : 0.f; sA.y = (4 * ks + 1 == ra) ? 1.f : 0.f; sA.z = (4 * ks + 2 == ra) ? 1.f : 0.f; sA.w = (4 * ks + 3 == ra) ? 1.f : 0.f;
            sB.x = (4 * ks + 0 == rb) ? 1.f : 0.f; sB.y = (4 * ks + 1 == rb) ? 1.f : 0.f; sB.z = (4 * ks + 2 == rb) ? 1.f : 0.f; sB.w = (4 * ks + 3 == rb) ? 1.f : 0.f;
        }
    } else {
        float* Xl = L;
        float* sr = srow + row * 64;
        const int lt = tid - 256;
        float* S0 = (float*)(P.ws + OFF_S0);
        if (!chain_only && g > 0 && w < 4) { const float* Sb = S0 + ((size_t)(g * 4 + h) * 64 + 32 * rgx + row) * 64 + 4 * ks; sA = *(const f32x4*)Sb; sB = *(const f32x4*)(Sb + 64); }
        const int gend = chain_only ? g : 0;
        float* srC = L + 8 * 4096 + row * 64;
        const int nrounds = (gend + 3) >> 2;
        if (gend > 0 && w >= 4) {
            f32x4 xr[4][4];
#pragma unroll
            for (int q = 0; q < 4; ++q)
#pragma unroll
                for (int e = 0; e < 4; ++e)
                    xr[q][e] = (q < gend) ? *(const f32x4*)(LX + ((size_t)(q * 4 + h) * 128 + 64) * 64 + (size_t)(lt + 256 * e) * 4) : (f32x4){0.f, 0.f, 0.f, 0.f};
#pragma unroll
            for (int q = 0; q < 4; ++q)
#pragma unroll
                for (int e = 0; e < 4; ++e) *(f32x4*)(Xl + q * 4096 + (lt + 256 * e) * 4) = xr[q][e];
        }
        if (gend > 0) __syncthreads();
        for (int r = 0; r < nrounds; ++r) {
            const int g0 = 4 * r, nb = (gend - g0 < 4) ? (gend - g0) : 4;
            float* Xc = Xl + (r & 1) * (4 * 4096);
            if (w >= 4) {
                if (r + 1 < nrounds) {
                    float* Xn = Xl + ((r + 1) & 1) * (4 * 4096); const int gn = g0 + 4, nn = (gend - gn < 4) ? (gend - gn) : 4;
                    f32x4 xr[4][4];
#pragma unroll
                    for (int q = 0; q < 4; ++q)
#pragma unroll
                        for (int e = 0; e < 4; ++e)
                            xr[q][e] = (q < nn) ? *(const f32x4*)(LX + ((size_t)((gn + q) * 4 + h) * 128 + 64) * 64 + (size_t)(lt + 256 * e) * 4) : (f32x4){0.f, 0.f, 0.f, 0.f};
#pragma unroll
                    for (int q = 0; q < 4; ++q)
#pragma unroll
                        for (int e = 0; e < 4; ++e) *(f32x4*)(Xn + q * 4096 + (lt + 256 * e) * 4) = xr[q][e];
                }
            } else {
                for (int q = 0; q < nb; ++q) {
                    const float* Xb = Xc + q * 4096 + 4 * ks;
                    const float* Lb = LX + ((size_t)((g0 + q) * 4 + h) * 128 + 32 * rgx + row) * 64 + 4 * ks;
                    f32x4 nA = *(const f32x4*)Lb, nB = *(const f32x4*)(Lb + 64);
                    *(f32x4*)(srC + 4 * ks) = sA; *(f32x4*)(srC + 64 + 4 * ks) = sB;
                    lds_wait();
#pragma unroll 8
                    for (int kp = 0; kp < 64; ++kp) {
                        const float ska = srC[kp], skb = srC[64 + kp]; const f32x4 xv = *(const f32x4*)(Xb + kp * 64);
                        nA.x += ska * xv.x; nA.y += ska * xv.y; nA.z += ska * xv.z; nA.w += ska * xv.w;
                        nB.x += skb * xv.x; nB.y += skb * xv.y; nB.z += skb * xv.z; nB.w += skb * xv.w;
                    }
                    lds_wait();
                    sA = nA; sB = nB;
                    float* dst = S0 + ((size_t)((g0 + q + 1) * 4 + h) * 64 + 32 * rgx + row) * 64 + 4 * ks;
                    *(f32x4*)dst = sA; *(f32x4*)(dst + 64) = sB;
                }
            }
            __syncthreads();
        }
        if (chain_only) return;
    }
    if (w >= 4) rwkv_scan_load(RK, L, ch0, h, vrg, tid - 256);
    __syncthreads();
    float sc0 = 0.f, sc1 = 0.f;
    for (int cc = 0; cc < RS_CPS; ++cc) {
        const int ch = ch0 + cc;
        float* buf = L + (cc & 1) * RS_BUF;
        if (w >= 4) {
            if (cc + 1 < RS_CPS) rwkv_scan_load(RK, L + ((cc + 1) & 1) * RS_BUF, ch + 1, h, vrg, tid - 256);
            if (PASS_A && side_scan && w >= 6) hgrn_scan_slice(P, tid - 384, cc, sc0, sc1);
            if (!PASS_A && side_comb && w >= 6) pb_convert_item(P, layer, (cc * 256 + (int)blockIdx.x) * 128 + (tid - 384));
            if (PASS_A && side_comb && w >= 6) attn_combine(P, tid, (cc * 256 + (int)blockIdx.x) * 128 + (tid - 384), 1 << 30);
        }
        else {
            const unsigned abase = (unsigned)(size_t)(PG8_LAS float*)buf + 16u * (unsigned)ks;
            const unsigned vbase = (unsigned)(size_t)(PG8_LAS float*)buf + (unsigned)(5 * RS_T * 64 + row) * 4u;
            f32x4 w4n, kk4n, b4n, k4n, r4n = (f32x4){0.f, 0.f, 0.f, 0.f}; f32x2v vvn;
#define RS_LD(tn) do { const unsigned _a = abase + (unsigned)(tn) * 256u; \
                asm volatile("ds_read_b128 %0, %1" : "=v"(w4n) : "v"(_a) : "memory"); \
                asm volatile("ds_read_b128 %0, %1 offset:8192" : "=v"(kk4n) : "v"(_a) : "memory"); \
                asm volatile("ds_read_b128 %0, %1 offset:16384" : "=v"(b4n) : "v"(_a) : "memory"); \
                asm volatile("ds_read_b128 %0, %1 offset:24576" : "=v"(k4n) : "v"(_a) : "memory"); \
                if (!PASS_A) asm volatile("ds_read_b128 %0, %1 offset:32768" : "=v"(r4n) : "v"(_a) : "memory"); \
                { const unsigned _v = vbase + (unsigned)(tn) * 128u; asm volatile("ds_read_b64 %0, %1" : "=v"(vvn) : "v"(_v) : "memory"); } } while (0)
            RS_LD(0);
            float ykA = 0.f, ykB = 0.f;
#pragma unroll 4
            for (int tt = 0; tt < RS_T; ++tt) {
                if (PASS_A) asm volatile("s_waitcnt lgkmcnt(0)" : "+v"(w4n), "+v"(kk4n), "+v"(b4n), "+v"(k4n), "+v"(vvn), "+v"(sA), "+v"(sB) :: "memory");
                else asm volatile("s_waitcnt lgkmcnt(0)" : "+v"(w4n), "+v"(kk4n), "+v"(b4n), "+v"(k4n), "+v"(r4n), "+v"(vvn), "+v"(sA), "+v"(sB) :: "memory");
                const f32x4 w4 = w4n, kk4 = kk4n, b4 = b4n, k4 = k4n, r4 = r4n; const f32x2v vv = vvn;
                const int tn = (tt + 1 < RS_T) ? tt + 1 : tt;
                RS_LD(tn);
                const float dA = (sA.x * kk4.x + sA.y * kk4.y) + (sA.z * kk4.z + sA.w * kk4.w);
                const float dB = (sB.x * kk4.x + sB.y * kk4.y) + (sB.z * kk4.z + sB.w * kk4.w);
                const float saA = -sum16(dA), saB = -sum16(dB);
                sA.x = sA.x * w4.x + (saA * b4.x + vv.x * k4.x); sA.y = sA.y * w4.y + (saA * b4.y + vv.x * k4.y);
                sA.z = sA.z * w4.z + (saA * b4.z + vv.x * k4.z); sA.w = sA.w * w4.w + (saA * b4.w + vv.x * k4.w);
                sB.x = sB.x * w4.x + (saB * b4.x + vv.y * k4.x); sB.y = sB.y * w4.y + (saB * b4.y + vv.y * k4.y);
                sB.z = sB.z * w4.z + (saB * b4.z + vv.y * k4.z); sB.w = sB.w * w4.w + (saB * b4.w + vv.y * k4.w);
                if (!PASS_A) {
                    const float yA = sum16((sA.x * r4.x + sA.y * r4.y) + (sA.z * r4.z + sA.w * r4.w));
                    const float yB = sum16((sB.x * r4.x + sB.y * r4.y) + (sB.z * r4.z + sB.w * r4.w));
                    ykA = (ks == (tt & 15)) ? yA : ykA; ykB = (ks == (tt & 15)) ? yB : ykB;
                    if ((tt & 15) == 15) *(unsigned*)(MIX + ((size_t)ch * RS_T + (tt - 15) + ks) * 1024 + 768 + h * 64 + 32 * rgx + row) = pk2(ykA, ykB);
                }
            }
            asm volatile("s_waitcnt lgkmcnt(0)" ::: "memory");
#undef RS_LD
        }
        __syncthreads();
    }
    if (PASS_A && w < 4) {
        float* dst = LX + ((size_t)(g * 4 + h) * 128 + 32 * rgx + row) * 64 + 4 * ks;
        *(f32x4*)dst = sA; *(f32x4*)(dst + 64) = sB;
    }
}

__device__ __forceinline__ void rwkv_post(const Params& P, int layer, int tid) {
    const int wave = tid >> 6, lane = tid & 63;
    const h16* RK = (const h16*)(P.ws + OFF_RK);
    bf16_t* MIX = (bf16_t*)(P.ws + OFF_HN);
    const float* lnw = P.in[I_LNW] + layer * 256; const float* lnb = P.in[I_LNB] + layer * 256; const float* rk = P.in[I_RK] + layer * 256;
    float lw[4], lb[4], rkk[4];
#pragma unroll
    for (int hh = 0; hh < 4; ++hh) { lw[hh] = lnw[hh * 64 + lane]; lb[hh] = lnb[hh * 64 + lane]; rkk[hh] = rk[hh * 64 + lane]; }
    for (int t = blockIdx.x * 8 + wave; t < S_; t += gridDim.x * 8) {
        float y[4], r[4], k[4], v[4], g[4];
#pragma unroll
        for (int hh = 0; hh < 4; ++hh) {
            const int col = hh * 64 + lane; const size_t o = (size_t)t * 256 + col;
            y[hh] = bf2f(MIX[(size_t)t * 1024 + 768 + col]);
            r[hh] = (float)RK[0 * RKSZ + o]; k[hh] = (float)RK[1 * RKSZ + o]; v[hh] = (float)RK[2 * RKSZ + o]; g[hh] = (float)RK[6 * RKSZ + o];
        }
        float m[4], q[4];
#pragma unroll
        for (int hh = 0; hh < 4; ++hh) { m[hh] = y[hh]; q[hh] = r[hh] * k[hh] * rkk[hh]; }
#pragma unroll
        for (int o = 1; o < 64; o <<= 1) {
#pragma unroll
            for (int hh = 0; hh < 4; ++hh) { m[hh] += __shfl_xor(m[hh], o); q[hh] += __shfl_xor(q[hh], o); }
        }
        float dl[4], var[4];
#pragma unroll
        for (int hh = 0; hh < 4; ++hh) { dl[hh] = y[hh] - m[hh] * (1.f / 64.f); var[hh] = dl[hh] * dl[hh]; }
#pragma unroll
        for (int o = 1; o < 64; o <<= 1) {
#pragma unroll
            for (int hh = 0; hh < 4; ++hh) var[hh] += __shfl_xor(var[hh], o);
        }
#pragma unroll
        for (int hh = 0; hh < 4; ++hh) {
            const float yn = dl[hh] * rsqrtf(var[hh] * (1.f / 64.f) + 64e-5f) * lw[hh] + lb[hh];
            MIX[(size_t)t * 1024 + 768 + hh * 64 + lane] = f2bf((yn + q[hh] * v[hh]) * g[hh]);
        }
    }
}

__device__ __forceinline__ void conv_glu(const Params& P, int layer, int hf, int tid) {
    const bf16_t* U = (const bf16_t*)(P.ws + OFF_U);
    bf16_t* ACT = (bf16_t*)(P.ws + OFF_ACT);
    bf16_t* HALO = (bf16_t*)(P.ws + OFF_HALO);
    const float* cw = P.in[I_CW] + (size_t)layer * 3 * 5632; const float* cb = P.in[I_CB] + (size_t)layer * 5632;
    const int gt = blockIdx.x * NTHREADS + tid, nth = gridDim.x * NTHREADS;
    for (int it = gt; it < 352 * 256; it += nth) {
        const int cgp = it % 352, run = it / 352, c = cgp * 8, lt0 = run * 32;
        float wg[3][8], wv[3][8], bg[8], bv[8];
#pragma unroll
        for (int q = 0; q < 8; ++q) {
            bg[q] = cb[c + q]; bv[q] = cb[2816 + c + q];
#pragma unroll
            for (int jx = 0; jx < 3; ++jx) { wg[jx][q] = cw[jx * 5632 + c + q]; wv[jx][q] = cw[jx * 5632 + 2816 + c + q]; }
        }
        u32x4 g2, g1, v2, v1;
        if (lt0 == 0) {
            if (hf == 0) { g2 = (u32x4){0, 0, 0, 0}; g1 = g2; v2 = g2; v1 = g2; }
            else { g2 = *(const u32x4*)(HALO + c); v2 = *(const u32x4*)(HALO + 2816 + c); g1 = *(const u32x4*)(HALO + 5632 + c); v1 = *(const u32x4*)(HALO + 5632 + 2816 + c); }
        } else {
            g2 = *(const u32x4*)(U + (size_t)(lt0 - 2) * 5632 + c); v2 = *(const u32x4*)(U + (size_t)(lt0 - 2) * 5632 + 2816 + c);
            g1 = *(const u32x4*)(U + (size_t)(lt0 - 1) * 5632 + c); v1 = *(const u32x4*)(U + (size_t)(lt0 - 1) * 5632 + 2816 + c);
        }
        for (int i0 = 0; i0 < 32; i0 += 4) {
            u32x4 gl[4], vl[4];
#pragma unroll
            for (int u = 0; u < 4; ++u) { gl[u] = *(const u32x4*)(U + (size_t)(lt0 + i0 + u) * 5632 + c); vl[u] = *(const u32x4*)(U + (size_t)(lt0 + i0 + u) * 5632 + 2816 + c); }
#pragma unroll
            for (int u = 0; u < 4; ++u) {
                const u32x4 g0 = gl[u], v0 = vl[u];
                float res[8];
#pragma unroll
                for (int q = 0; q < 4; ++q) {
                    const unsigned a2 = g2[q], a1 = g1[q], a0 = g0[q], b2 = v2[q], b1 = v1[q], b0 = v0[q];
                    const float glo = bg[2 * q] + wg[0][2 * q] * bflo(a2) + wg[1][2 * q] * bflo(a1) + wg[2][2 * q] * bflo(a0);
                    const float ghi = bg[2 * q + 1] + wg[0][2 * q + 1] * bfhi(a2) + wg[1][2 * q + 1] * bfhi(a1) + wg[2][2 * q + 1] * bfhi(a0);
                    const float vlo = bv[2 * q] + wv[0][2 * q] * bflo(b2) + wv[1][2 * q] * bflo(b1) + wv[2][2 * q] * bflo(b0);
                    const float vhi = bv[2 * q + 1] + wv[0][2 * q + 1] * bfhi(b2) + wv[1][2 * q + 1] * bfhi(b1) + wv[2][2 * q + 1] * bfhi(b0);
                    res[2 * q] = glo * sigm(glo) * vlo; res[2 * q + 1] = ghi * sigm(ghi) * vhi;
                }
                u32x4 o; o.x = pk2(res[0], res[1]); o.y = pk2(res[2], res[3]); o.z = pk2(res[4], res[5]); o.w = pk2(res[6], res[7]);
                *(u32x4*)(ACT + (size_t)(hf * 8192 + lt0 + i0 + u) * 2816 + c) = o;
                g2 = g1; g1 = g0; v2 = v1; v1 = v0;
            }
        }
    }
    if (hf == 0) {
        for (int it = gt; it < 2 * 704; it += nth) { const int r = it / 704, cc = it % 704; *(u32x4*)(HALO + (size_t)r * 5632 + cc * 8) = *(const u32x4*)(U + (size_t)(8190 + r) * 5632 + cc * 8); }
    }
}

__device__ __forceinline__ void run_phase(const Params& P, int ph, unsigned char* smem, int part) {
    const int tid = launder((int)threadIdx.x), wave = tid >> 6, lane = tid & 63;
    const int gw = blockIdx.x * 8 + wave, ngw = gridDim.x * 8;
    bf16_t* WT = (bf16_t*)(P.ws + OFF_WT);
    bf16_t* HN = (bf16_t*)(P.ws + OFF_HN);
    if (PH(16) && ph == 32) {
        const float* g = P.in[I_NFIN];
        for (int row = gw; row < S_; row += ngw) {
            f32x4* xr = (f32x4*)(P.out + (size_t)row * D_) + lane;
            f32x4 v[4]; float s = 0.f;
#pragma unroll
            for (int j = 0; j < 4; ++j) { v[j] = xr[64 * j]; s += (v[j].x * v[j].x + v[j].y * v[j].y) + (v[j].z * v[j].z + v[j].w * v[j].w); }
            s = wave_sum(s);
            const float r = rsqrtf(s * (1.f / 1024.f) + 1e-6f);
#pragma unroll
            for (int j = 0; j < 4; ++j) { const f32x4 gg = ((const f32x4*)g)[lane + 64 * j]; f32x4 o; o.x = v[j].x * r * gg.x; o.y = v[j].y * r * gg.y; o.z = v[j].z * r * gg.z; o.w = v[j].w * r * gg.w; xr[64 * j] = o; }
        }
        return;
    }
    const int layer = ph >> 4, sub = ph & 15;
    if (PH(0) && sub == 0) { phase_prep(P, layer, smem, tid); return; }
    if (PH(1) && sub == 9) {
        EpiConv E; E.act = (bf16_t*)(P.ws + OFF_ACT); E.hl = (bf16_t*)(P.ws + OFF_U + 16 * MiB); E.hf = (bf16_t*)(P.ws + OFF_U + 24 * MiB);
        E.cw = P.in[I_CW] + (size_t)layer * 3 * 5632; E.cb = P.in[I_CB] + (size_t)layer * 5632;
        run_gemm(smem, HN, WT + WT_UP, S_, 5632, 1024, E); return;
    }
    if (PH(1) && sub == 10) {
        conv_fixup(P, layer, tid);
        float* SSQ = (float*)(P.ws + OFF_SSQ);
        for (int it = blockIdx.x * NTHREADS + tid; it < S_; it += gridDim.x * NTHREADS) SSQ[it] = 0.f;
        return;
    }
    if (PH(1) && sub == 1) {
        EpiRoute E; const bf16_t* A; const bf16_t* Bt; int M, N;
        if (sub == 1) { A = HN; Bt = WT + WT_IN; M = S_; N = 3840; E.d0 = (bf16_t*)(P.ws + OFF_ZH); E.ld0 = 2048; E.d1 = (bf16_t*)(P.ws + OFF_ZB); E.ld1 = 768; E.d2 = (bf16_t*)(P.ws + OFF_ZC); E.ld2 = 1024; E.c1 = 2048; E.c2 = 2816; }
        else { const int hf = (sub == 11); A = HN + (size_t)hf * 8192 * 1024; Bt = WT + WT_UP; M = 8192; N = 5632; E.d0 = (bf16_t*)(P.ws + OFF_U); E.ld0 = 5632; E.d1 = E.d0; E.ld1 = 5632; E.d2 = E.d0; E.ld2 = 5632; E.c1 = 1 << 30; E.c2 = 1 << 30; }
        run_gemm(smem, A, Bt, M, N, 1024, E); return;
    }
    if (PH(7) && sub == 13) {
        EpiF32<3> E; E.hin = P.out; E.out = P.out; E.hb = HN; E.ssq = (float*)(P.ws + OFF_SSQ);
        run_gemm(smem, (const bf16_t*)(P.ws + OFF_ACT), WT + WT_DOWN, S_, 1024, 2816, E);
        const float* p = P.in[I_P] + (size_t)layer * S_ * 256; bf16_t* PB = (bf16_t*)(P.ws + OFF_PB);
        for (int it = (gridDim.x == 256) ? (S_ * 256 / 8) : (int)(blockIdx.x * NTHREADS + tid); it < S_ * 256 / 8; it += gridDim.x * NTHREADS) {
            const f32x4 a = ((const f32x4*)p)[2 * it], b = ((const f32x4*)p)[2 * it + 1];
            u32x4 o; o.x = pk2(a.x, a.y); o.y = pk2(a.z, a.w); o.z = pk2(b.x, b.y); o.w = pk2(b.z, b.w);
            ((u32x4*)PB)[it] = o;
        }
        return;
    }
    if (PH(7) && sub == 7) {
        EpiF32<0> E; const bf16_t* A; const bf16_t* Bt; int K;
        if (sub == 7) { A = HN; Bt = WT + WT_OUT; K = 1024; E.hin = (layer == 0) ? P.in[I_X] : P.out; }
        else { A = (const bf16_t*)(P.ws + OFF_ACT); Bt = WT + WT_DOWN; K = 2816; E.hin = P.out; }
        E.out = P.out;
        run_gemm(smem, A, Bt, S_, 1024, K, E); return;
    }
    if (PH(15) && sub == 15) {
        float* PP = (float*)(P.ws + OFF_PP);
        { EpiF32<1> E; E.hin = nullptr; E.out = PP; E.hb = nullptr; E.ssq = nullptr; run_gemm(smem, (const bf16_t*)(P.ws + OFF_PB), WT + WT_PROJ, S_, 1024, 256, E); }
        __syncthreads();
        { EpiF32<4> E; E.hin = PP; E.out = P.out; E.hb = nullptr; E.ssq = (float*)(P.ws + OFF_SSQ); run_gemm(smem, HN, WT + WT_GATE, S_, 1024, 1024, E); }
        return;
    }
    if (PH(2) && sub == 2) { rwkv_prep(P, layer, smem, tid); __syncthreads(); attn_partial(P, smem, tid); return; }
    if (PH(3) && (sub == 3 || sub == 4)) {
        const bool full = (gridDim.x == 256);
        if (sub == 3) { hgrn_pass1(P, layer, smem, tid); if (!full) attn_combine(P, tid); }
        const bool ride = (sub == 4) && full;
        if (sub == 4 && !ride) hgrn_scan(P, tid);
        const int base = (sub == 4) ? RS_G * 8 : 0;
        for (int job = base + blockIdx.x; job < base + RS_G * 8; job += gridDim.x) rwkv_seg_job<true>(P, smem, tid, job >> 4, (job >> 2) & 3, job & 3, false, ride, (sub == 3) && full);
        return;
    }
    if (PH(5) && sub == 5) {
        if (part == 0 && blockIdx.x >= 8) { for (int item = blockIdx.x - 8; item < 1024; item += gridDim.x - 8) hgrn_pass3_item(P, layer, smem, tid, item); return; }
        const bool co = (part == 0);
        for (int job = blockIdx.x; job < (co ? 8 : RS_G * 8); job += gridDim.x)
            rwkv_seg_job<false>(P, smem, tid, co ? RS_G - 1 : (job >> 3), co ? (job >> 1) : ((job >> 1) & 3), job & 1, co, false, !co && gridDim.x == 256, layer);
        return;
    }
    if (PH(6) && sub == 6) { rwkv_post(P, layer, tid); return; }
    if (PH(8) && sub == 8) { rmsnorm_rows_bf16(P.out, P.in[I_NFFN] + layer * 1024, HN, gw, ngw, lane); return; }
    if (PH(14) && sub == 14) {
        rmsnorm_rows_bf16(P.out, P.in[I_NPLE] + layer * 1024, HN, gw, ngw, lane);
        const float* p = P.in[I_P] + (size_t)layer * S_ * 256; bf16_t* PB = (bf16_t*)(P.ws + OFF_PB);
        for (int it = blockIdx.x * NTHREADS + tid; it < S_ * 256 / 8; it += gridDim.x * NTHREADS) {
            const f32x4 a = ((const f32x4*)p)[2 * it], b = ((const f32x4*)p)[2 * it + 1];
            u32x4 o; o.x = pk2(a.x, a.y); o.y = pk2(a.z, a.w); o.z = pk2(b.x, b.y); o.w = pk2(b.z, b.w);
            ((u32x4*)PB)[it] = o;
        }
        return;
    }
}

#define XB_TMO      128
#define XB_XCNT(j)  (256  + 64 * (j))
#define XB_XSUB(j)  (1280 + 64 * (j))
#define XB_XGEN(j)  (2304 + 64 * (j))
#define XB_TOP      3328
#define XB_TOPGEN   3392
#define XCD_BAR_WORDS 3456
#define XB_SPIN_CAP (1u << 18)
#define XB_LAS __attribute__((address_space(3)))

__device__ __forceinline__ unsigned xb_ld(unsigned* p)              { return __hip_atomic_load(p, __ATOMIC_RELAXED, __HIP_MEMORY_SCOPE_AGENT); }
__device__ __forceinline__ unsigned xb_add(unsigned* p, unsigned v) { return __hip_atomic_fetch_add(p, v, __ATOMIC_RELAXED, __HIP_MEMORY_SCOPE_AGENT); }
__device__ __forceinline__ unsigned xb_xcc_id() { return (unsigned)__builtin_amdgcn_s_getreg((3 << 11) | 20) & 0xFu; }
#define XB_SPIN(cond, bar) do { unsigned _sp = 0; while (cond) { __builtin_amdgcn_s_sleep(1); \
    if ((++_sp & 255u) == 0u) { if (xb_ld(&(bar)[XB_TMO])) break; if (_sp > XB_SPIN_CAP) { atomicAdd(&(bar)[XB_TMO], 1u); break; } } } } while (0)
struct XcdBarrier {
    unsigned* bar; unsigned x;
    volatile XB_LAS unsigned* st;
};

__device__ __forceinline__ XcdBarrier xcd_barrier_post(unsigned* bar, volatile XB_LAS unsigned* st) {
    XcdBarrier b; b.bar = bar; b.x = xb_xcc_id(); b.st = st;
    if (threadIdx.x == 0) (void)xb_add(&bar[XB_XCNT(b.x)], 1u);
    return b;
}
__device__ __forceinline__ void xcd_barrier_complete(unsigned* bar, unsigned x, unsigned& nloc, unsigned& nx) {
    const unsigned G = gridDim.x * gridDim.y * gridDim.z;
    unsigned sum, cnt, mine, sp = 0u;
    for (;;) {
        sum = 0u; cnt = 0u; mine = 0u;
#pragma unroll
        for (unsigned j = 0; j < 16; ++j) { const unsigned c = xb_ld(&bar[XB_XCNT(j)]); sum += c; cnt += (c > 0u) ? 1u : 0u; mine = (j == x) ? c : mine; }
        if (sum == G) break;
        __builtin_amdgcn_s_sleep(1);
        if ((++sp & 255u) == 0u) { if (xb_ld(&bar[XB_TMO])) break; if (sp > XB_SPIN_CAP) { atomicAdd(&bar[XB_TMO], 1u); break; } }
    }
    nloc = mine > 0u ? mine : 1u; nx = cnt > 0u ? cnt : 1u;
}

__device__ __forceinline__ void xcd_barrier(const XcdBarrier& b) {
    asm volatile("s_waitcnt vmcnt(0)" ::: "memory");
    __syncthreads();
    if (threadIdx.x == 0) {
        unsigned* bar = b.bar;
        __builtin_amdgcn_s_waitcnt(0);
        unsigned nloc = b.st[0], nx = b.st[1];
        if (nloc == 0u) { xcd_barrier_complete(bar, b.x, nloc, nx); b.st[0] = nloc; b.st[1] = nx; }
        const unsigned old = xb_add(&bar[XB_XSUB(b.x)], 1u);
        const unsigned gen = old / nloc;
        if (old + 1u == (gen + 1u) * nloc) {
            __builtin_amdgcn_fence(__ATOMIC_RELEASE, "agent");
            asm volatile("s_waitcnt vmcnt(0)" ::: "memory");
            const unsigned og = xb_add(&bar[XB_TOP], 1u);
            const unsigned tg = og / nx;
            if (og + 1u == (tg + 1u) * nx) xb_add(&bar[XB_TOPGEN], 1u);
            else XB_SPIN(xb_ld(&bar[XB_TOPGEN]) == tg, bar);
            __builtin_amdgcn_fence(__ATOMIC_ACQUIRE, "agent");
            xb_add(&bar[XB_XGEN(b.x)], 1u);
            asm volatile("s_waitcnt vmcnt(0)" ::: "memory");
        } else {
            XB_SPIN(xb_ld(&bar[XB_XGEN(b.x)]) == gen, bar);
            __builtin_amdgcn_fence(__ATOMIC_ACQUIRE, "agent");
            asm volatile("s_waitcnt vmcnt(0)" ::: "memory");
        }
    }
    __syncthreads();
}

constexpr size_t OFF_BAR = 65536;

#ifndef ONE_LAUNCH
#define ONE_LAUNCH 1
#endif

__global__ __launch_bounds__(512, 2) void mega(Params P, int ph_lo, int ph_hi) {
    extern __shared__ __attribute__((aligned(16))) unsigned char smem[];
    cg::grid_group grid = cg::this_grid();
    if (ph_hi == 0x7fffffff) grid.sync();
    volatile XB_LAS unsigned* st = (volatile XB_LAS unsigned*)(smem + LDS_BYTES - 16);
    if (threadIdx.x == 0) { st[0] = 0u; st[1] = 0u; }
    __syncthreads();
    XcdBarrier xb = xcd_barrier_post((unsigned*)(P.ws + OFF_BAR), st);
#ifdef EXTRA_SYNCS
    for (int i = 0; i < EXTRA_SYNCS; ++i) xcd_barrier(xb);
#endif
    for (int ph = ph_lo; ph < ph_hi; ++ph) {
        if (ph < 32 && ((ph & 15) == 11 || (ph & 15) == 12 || (ph & 15) == 14)) continue;
        if (ph > ph_lo) xcd_barrier(xb);
        const int nparts = (ph < 32 && (ph & 15) == 5) ? 2 : 1;
        for (int part = 0; part < nparts; ++part) { if (part) xcd_barrier(xb); run_phase(P, ph, smem, part); }
#ifdef REP_MASK
        if (ph < 32 && ((REP_MASK >> (ph & 15)) & 1)) { xcd_barrier(xb); run_phase(P, ph, smem, 0); }
#endif
    }
}

extern "C" void kernel_launch(void* const* d_in, const int* in_sizes, int n_in, void* d_out, int out_size, void* d_ws, size_t ws_size, hipStream_t stream) {
    static int grid_blocks = 0;
    if (grid_blocks == 0) {
        int dev = 0, cus = 0, per_cu = 0;
        if (hipGetDevice(&dev) != hipSuccess || hipDeviceGetAttribute(&cus, hipDeviceAttributeMultiprocessorCount, dev) != hipSuccess) { fprintf(stderr, "kernel_launch: device query failed\n"); grid_blocks = -1; return; }
        if (hipFuncSetAttribute((const void*)mega, hipFuncAttributeMaxDynamicSharedMemorySize, LDS_BYTES) != hipSuccess) { fprintf(stderr, "kernel_launch: hipFuncSetAttribute failed\n"); grid_blocks = -1; return; }
        if (hipOccupancyMaxActiveBlocksPerMultiprocessor(&per_cu, (const void*)mega, NTHREADS, LDS_BYTES) != hipSuccess || per_cu < 1) { fprintf(stderr, "kernel_launch: occupancy query gave %d\n", per_cu); per_cu = 1; }
        (void)hipGetLastError();
        grid_blocks = cus * per_cu;
        if (n_in != 30 || ws_size < 256 * MiB) fprintf(stderr, "kernel_launch: unexpected n_in %d / ws_size %zu\n", n_in, ws_size);
    }
    if (grid_blocks < 0) return;
    Params P{};
    for (int i = 0; i < 30; ++i) P.in[i] = (const float*)d_in[i];
    P.out = (float*)d_out; P.ws = (unsigned char*)d_ws;
#if ONE_LAUNCH
    if (hipMemsetAsync((char*)d_ws + OFF_BAR, 0, XCD_BAR_WORDS * sizeof(unsigned), stream) != hipSuccess) { fprintf(stderr, "kernel_launch: memset of the barrier words failed\n"); return; }
    int lo = 0, hi = NPH;
    void* args[] = {&P, &lo, &hi};
    hipError_t e = hipLaunchCooperativeKernel((const void*)mega, dim3(grid_blocks), dim3(NTHREADS), args, LDS_BYTES, stream);
    if (e != hipSuccess) fprintf(stderr, "cooperative launch failed: %s (grid %d)\n", hipGetErrorString(e), grid_blocks);
#else
    for (int ph = 0; ph < NPH; ++ph) hipLaunchKernelGGL(mega, dim3(grid_blocks), dim3(NTHREADS), LDS_BYTES, stream, P, ph, ph + 1);
#endif
}
```

```cpp
#include <hip/hip_runtime.h>
#include <hip/hip_cooperative_groups.h>
#include <cstdio>
#include <cstdint>
namespace cg = cooperative_groups;
namespace pg8 {
#define PG8_LAS __attribute__((address_space(3)))
typedef unsigned short bf16_t;
typedef short bf16x8 __attribute__((ext_vector_type(8)));
typedef float f32x4 __attribute__((ext_vector_type(4)));
typedef unsigned u32x4 __attribute__((ext_vector_type(4)));
constexpr int BM = 256, BK = 64, HALF = 128, HTB = HALF * BK * 2  , STAGE_BYTES = 8 * HTB, NXCD = 8, WGM = 8;

__host__ __device__ __forceinline__ int lds_byte(int r, int c) { const int st = (r >> 4) * 2 + (c >> 5), rr = r & 15, cc = c & 31, ob = rr * 64 + cc * 2; return st * 1024 + (ob ^ (((ob >> 9) & 1) << 5)); }
__host__ __device__ __forceinline__ void stage_rc(int b, int& R, int& C) { const int st = b / 1024, sb = b % 1024, swz = sb ^ (((sb >> 9) & 1) << 5); R = (st >> 1) * 16 + swz / 64; C = (st & 1) * 32 + (swz % 64) / 2; }
__host__ __device__ __forceinline__ int perm32(int rho) { const int n = rho >> 4, i = rho & 15; return 8 * (i >> 2) + 4 * n + (i & 3); }

struct Unit { int pm, pn; };
struct Gemm { const bf16_t* A; const bf16_t* Bt; int M, N, K; };

struct StaticOrder {
    int nM, nN, nwg, G, c;
    __host__ __device__ void init(int M, int N, int G_, int c_) { nM = M / BM; nN = N / BM; nwg = nM * nN; G = G_; c = c_; }
    __host__ __device__ bool next(int i, Unit& u) const {
        const long L = (long)i * G + c; if (L >= nwg) return false;
        int wgid = (int)L; { const int q = nwg / NXCD, r = nwg % NXCD, xcd = wgid % NXCD, off = wgid / NXCD; wgid = (xcd < r ? xcd * (q + 1) : r * (q + 1) + (xcd - r) * q) + off; }
        const int nig = WGM * nN, gid = wgid / nig, fm = gid * WGM, gsz = (nM - fm) < WGM ? (nM - fm) : WGM;
        u.pm = fm + ((wgid % nig) % gsz); u.pn = (wgid % nig) / gsz; return true;
    }
    __device__ __forceinline__ void a_ready(const Unit&) const {}
    __device__ __forceinline__ void done(const Unit&) const {}
};
__device__ __forceinline__ unsigned cvt_pk_bf16(float lo, float hi) { unsigned r; asm volatile("v_cvt_pk_bf16_f32 %0, %1, %2" : "=v"(r) : "v"(lo), "v"(hi)); return r; }
typedef float f32x2 __attribute__((ext_vector_type(2)));
template <class Epi, class Sched, bool STAMP = false>
__device__ __forceinline__ void gemm_phase(PG8_LAS unsigned char* lds, const Gemm g, const Sched& S, const Epi& E, unsigned long long* stamps) {
    int tid_l = threadIdx.x; asm volatile("" : "+v"(tid_l)); const int tid = tid_l, wid = __builtin_amdgcn_readfirstlane(tid >> 6), lane = tid & 63, wr = wid >> 2, wc = wid & 3, fr = lane & 15, fq = lane >> 4;
    const int K = g.K, nt = K / BK;
    int ts_lo = 0, ts_hi = 0, nts = 0; const unsigned long long rt_entry = STAMP ? (unsigned long long)wall_clock64() : 0ull;
#define PG8_STAMP() do { if (STAMP && wid == 0 && nts < 64) { const unsigned long long _c = (unsigned long long)clock64(); \
        ts_lo = (lane == nts) ? (int)(unsigned)_c : ts_lo; ts_hi = (lane == nts) ? (int)(unsigned)(_c >> 32) : ts_hi; ++nts; } } while (0)
    PG8_STAMP();
    unsigned voffA[2], voffB[2];
#pragma unroll
    for (int i = 0; i < 2; ++i) { int R, C; stage_rc(tid * 16 + i * 8192, R, C); const int Rb = Epi::PERM ? ((R & ~31) + perm32(R & 31)) : R;
        voffA[i] = (unsigned)(R * K + C) * 2u; voffB[i] = (unsigned)(Rb * K + C) * 2u; }
    const size_t kstep = (size_t)(BK * 2);
    const size_t hstep = (size_t)HALF * K * 2;
    const size_t tstep = 2 * hstep;
    const unsigned ldsw = (unsigned)wid * 1024u;
    const int aoff = lds_byte(wr * 64 + fr, fq * 8), boff = lds_byte(wc * 32 + fr, fq * 8);
#define PG8_SA(b, h) (((b) * 2 + (h)) * HTB)
#define PG8_SB(b, h) ((4 + (b) * 2 + (h)) * HTB)
#define PG8_STAGE(bufoff, gbase, voff) do { _Pragma("unroll") for (int _i = 0; _i < 2; ++_i) \
        __builtin_amdgcn_global_load_lds((const unsigned*)((const char*)(gbase) + (voff)[_i]), (PG8_LAS unsigned*)(lds + (bufoff) + ldsw + _i * 8192), 16, 0, 0); } while (0)
#define PG8_LDA(dst, b, h) do { _Pragma("unroll") for (int m = 0; m < 4; ++m) _Pragma("unroll") for (int k = 0; k < 2; ++k) dst[m][k] = *(const PG8_LAS bf16x8*)(lds + PG8_SA(b, h) + aoff + m * 2048 + k * 1024); } while (0)
#define PG8_LDB(dst, b, h) do { _Pragma("unroll") for (int n = 0; n < 2; ++n) _Pragma("unroll") for (int k = 0; k < 2; ++k) dst[n][k] = *(const PG8_LAS bf16x8*)(lds + PG8_SB(b, h) + boff + n * 2048 + k * 1024); } while (0)
#define PG8_MMA(ai, bj, At, Bt) do { __builtin_amdgcn_s_setprio(1); _Pragma("unroll") for (int m = 0; m < 4; ++m) _Pragma("unroll") for (int n = 0; n < 2; ++n) _Pragma("unroll") for (int k = 0; k < 2; ++k) \
        acc[ai][bj][m][n] = __builtin_amdgcn_mfma_f32_16x16x32_bf16(Bt[n][k], At[m][k], acc[ai][bj][m][n], 0, 0, 0); __builtin_amdgcn_s_setprio(0); } while (0)
#define PG8_WAIT_V(n) asm volatile("s_waitcnt vmcnt(" #n ")" ::: "memory")
#define PG8_WAIT_L(n) asm volatile("s_waitcnt lgkmcnt(" #n ")" ::: "memory")
#define PG8_BAR __builtin_amdgcn_s_barrier()
#define PG8_SCHED __builtin_amdgcn_sched_barrier(0)
    Unit cur, nxt; int ui = 0;
    if (!S.next(0, cur)) return;
    f32x4 acc[2][2][4][2];
#pragma unroll
    for (int a = 0; a < 2; ++a)
#pragma unroll
        for (int b = 0; b < 2; ++b)
#pragma unroll
            for (int m = 0; m < 4; ++m)
#pragma unroll
                for (int n = 0; n < 2; ++n) acc[a][b][m][n] = (f32x4){0.f, 0.f, 0.f, 0.f};
    bf16x8 At[4][2], B0[2][2], B1[2][2];
    const char* cA = (const char*)g.A + (size_t)cur.pm * tstep; const char* cB = (const char*)g.Bt + (size_t)cur.pn * tstep;
    S.a_ready(cur);
    PG8_STAGE(PG8_SB(0, 0), cB, voffB); PG8_STAGE(PG8_SA(0, 0), cA, voffA); PG8_STAGE(PG8_SB(0, 1), cB + hstep, voffB); PG8_STAGE(PG8_SA(0, 1), cA + hstep, voffA);
    if (wr == 1) PG8_BAR;
    PG8_WAIT_V(4); PG8_BAR;
    PG8_STAGE(PG8_SB(1, 0), cB + kstep, voffB); PG8_STAGE(PG8_SA(1, 0), cA + kstep, voffA); PG8_STAGE(PG8_SB(1, 1), cB + hstep + kstep, voffB);
    PG8_WAIT_V(6); PG8_BAR;
    PG8_STAMP();
    for (;;) {
        const bool has_next = S.next(ui + 1, nxt);
        const char* nA = has_next ? (const char*)g.A + (size_t)nxt.pm * tstep : cA; const char* nB = has_next ? (const char*)g.Bt + (size_t)nxt.pn * tstep : cB;
        for (int t = 0; t < nt; t += 2) {
            const bool last = (t == nt - 2);
            const char* a1 = cA + (size_t)(t + 1) * kstep;
            const char* a2 = last ? nA : cA + (size_t)(t + 2) * kstep; const char* b2 = last ? nB : cB + (size_t)(t + 2) * kstep;
            const char* a3 = a2 + kstep; const char* b3 = b2 + kstep;
            if (last && has_next) S.a_ready(nxt);
            PG8_LDB(B0, 0, 0); PG8_SCHED; PG8_LDA(At, 0, 0); PG8_STAGE(PG8_SA(1, 1), a1 + hstep, voffA);
            PG8_WAIT_L(8); PG8_BAR; PG8_WAIT_L(0); PG8_MMA(0, 0, At, B0); PG8_BAR; PG8_SCHED;
            PG8_LDB(B1, 0, 1); PG8_STAGE(PG8_SB(0, 0), b2, voffB);
            PG8_BAR; PG8_WAIT_L(0); PG8_MMA(0, 1, At, B1); PG8_BAR;
            PG8_LDA(At, 0, 1); PG8_STAGE(PG8_SA(0, 0), a2, voffA);
            PG8_BAR; PG8_WAIT_L(0); PG8_MMA(1, 0, At, B0); PG8_BAR; PG8_SCHED;
            PG8_STAGE(PG8_SB(0, 1), b2 + hstep, voffB);
            PG8_WAIT_V(6); PG8_BAR; PG8_MMA(1, 1, At, B1); PG8_BAR;
            PG8_LDB(B0, 1, 0); PG8_SCHED; PG8_LDA(At, 1, 0); PG8_STAGE(PG8_SA(0, 1), a2 + hstep, voffA);
            PG8_WAIT_L(8); PG8_BAR; PG8_WAIT_L(0); PG8_MMA(0, 0, At, B0); PG8_BAR; PG8_SCHED;
            PG8_LDB(B1, 1, 1); PG8_STAGE(PG8_SB(1, 0), b3, voffB);
            PG8_BAR; PG8_WAIT_L(0); PG8_MMA(0, 1, At, B1); PG8_BAR;
            PG8_LDA(At, 1, 1); PG8_STAGE(PG8_SA(1, 0), a3, voffA);
            PG8_BAR; PG8_WAIT_L(0); PG8_MMA(1, 0, At, B0); PG8_BAR; PG8_SCHED;
            PG8_STAGE(PG8_SB(1, 1), b3 + hstep, voffB);
            PG8_WAIT_V(6); PG8_BAR; PG8_MMA(1, 1, At, B1); PG8_BAR;
        }
        PG8_STAMP();
        if constexpr (!Epi::AFTER_DRAIN) { E(acc, cur, wr, wc, fr, fq); S.done(cur); }
        PG8_STAMP();
        if (!has_next) break;
#pragma unroll
        for (int a = 0; a < 2; ++a)
#pragma unroll
            for (int b = 0; b < 2; ++b)
#pragma unroll
                for (int m = 0; m < 4; ++m)
#pragma unroll
                    for (int n = 0; n < 2; ++n) acc[a][b][m][n] = (f32x4){0.f, 0.f, 0.f, 0.f};
        cur = nxt; cA = nA; cB = nB; ++ui;
    }
    PG8_WAIT_V(0);
    if (wr == 0) PG8_BAR;
    PG8_BAR;
    if constexpr (Epi::AFTER_DRAIN) { E.fused(acc, cur, wr, wc, fr, fq, lds, wid, lane); S.done(cur); }
    PG8_STAMP();
    if (STAMP && wid == 0) { stamps[lane] = lane < nts ? (((unsigned long long)(unsigned)ts_hi << 32) | (unsigned)ts_lo) : 0ull;
        if (lane == 62) stamps[62] = rt_entry; if (lane == 63) stamps[63] = (unsigned long long)wall_clock64(); }
#undef PG8_STAMP
#undef PG8_SA
#undef PG8_SB
#undef PG8_STAGE
#undef PG8_LDA
#undef PG8_LDB
#undef PG8_MMA
#undef PG8_WAIT_V
#undef PG8_WAIT_L
#undef PG8_BAR
#undef PG8_SCHED
}
}

using pg8::bf16_t; using pg8::f32x4; using pg8::u32x4; using pg8::Unit;
typedef _Float16 h16;
typedef _Float16 h16x8 __attribute__((ext_vector_type(8)));
typedef _Float16 h16x2 __attribute__((ext_vector_type(2)));
typedef _Float16 h16x4 __attribute__((ext_vector_type(4)));
typedef float f32x2v __attribute__((ext_vector_type(2)));

constexpr int S_ = 16384, D_ = 1024;
constexpr int NTHREADS = 512;
constexpr int LDS_BYTES = 155648;
constexpr size_t MiB = (size_t)1 << 20;
constexpr size_t OFF_HALO = 0, OFF_WT = 1 * MiB, OFF_VF = 30 * MiB, OFF_LX = 38 * MiB, OFF_S0 = 42 * MiB, OFF_HN = 46 * MiB, OFF_BIG = 78 * MiB;
constexpr size_t OFF_ZH = OFF_BIG, OFF_ZB = OFF_BIG + 64 * MiB, OFF_ZC = OFF_BIG + 88 * MiB, OFF_RK = OFF_BIG + 120 * MiB,
                 OFF_LSE = OFF_BIG + 176 * MiB, OFF_GB = OFF_BIG + 177 * MiB;
constexpr size_t OFF_U = OFF_BIG, OFF_ACT = OFF_BIG + 88 * MiB;
constexpr size_t OFF_PB = OFF_BIG, OFF_PP = OFF_BIG + 8 * MiB;
constexpr size_t OFF_SSQ = OFF_BIG + 80 * MiB;
constexpr size_t WT_IN = 0, WT_OUT = 3932160, WT_UP = 4980736, WT_DOWN = 10747904, WT_GATE = 13631488, WT_PROJ = 14680064,
                 WT_W2 = 14942208, WT_A2 = 14958592, WT_G2 = 14974976, WT_V1 = 15007744;
constexpr size_t RKSZ = (size_t)S_ * 256;

enum { I_X = 0, I_P, I_WIN, I_WOUT, I_NMIX, I_NFFN, I_NPLE, I_NFIN, I_LB, I_GN, I_MU, I_W0, I_W2, I_A0, I_A2, I_G2, I_KK, I_KA, I_RK,
       I_LNW, I_LNB, I_V0, I_V1, I_V2, I_UP, I_CW, I_CB, I_DOWN, I_PROJ, I_GATE, N_IN };

struct Params { const float* in[30]; float* out; unsigned char* ws; };

constexpr int NPH_LAYER = 16, NPH = 33;
#ifndef PHMASK
#define PHMASK 0x1FFFF
#endif
#define PH(x) ((PHMASK >> (x)) & 1)

__device__ __forceinline__ float bf2f(unsigned short b) { return __uint_as_float(((unsigned)b) << 16); }
__device__ __forceinline__ float bflo(unsigned u) { return __uint_as_float(u << 16); }
__device__ __forceinline__ float bfhi(unsigned u) { return __uint_as_float(u & 0xffff0000u); }
__device__ __forceinline__ unsigned pk2(float lo, float hi) { return pg8::cvt_pk_bf16(lo, hi); }
__device__ __forceinline__ unsigned pk2_sw(float lo, float hi) { unsigned a = __float_as_uint(lo), b = __float_as_uint(hi); a += 0x7fffu + ((a >> 16) & 1u); b += 0x7fffu + ((b >> 16) & 1u); return (a >> 16) | (b & 0xffff0000u); }
__device__ __forceinline__ unsigned short f2bf(float f) { return (unsigned short)(pk2(f, 0.f) & 0xffffu); }
__device__ __forceinline__ float wave_sum(float v) {
#pragma unroll
    for (int o = 1; o < 64; o <<= 1) v += __shfl_xor(v, o);
    return v;
}
__device__ __forceinline__ float sigm(float x) { return __builtin_amdgcn_rcpf(1.f + __expf(-x)); }
__device__ __forceinline__ int launder(int x) { asm volatile("" : "+v"(x)); return x; }
__device__ __forceinline__ void lds_wait() { asm volatile("s_waitcnt lgkmcnt(0)" ::: "memory"); }

__device__ __forceinline__ void transpose_item(const float* __restrict__ W, int K, int N, bf16_t* __restrict__ WT, float* scr, int item, int lane, bool perm_up = false, const float* __restrict__ kscale = nullptr) {
    const int nblk = N / 32, kb = item / nblk, nb = item % nblk, k0 = 64 * kb, n0 = 32 * nb;
    const int d0 = !perm_up ? n0 : ((n0 < 2816) ? (256 * (n0 >> 7) + (n0 & 127)) : (256 * ((n0 - 2816) >> 7) + 128 + ((n0 - 2816) & 127)));
#pragma unroll 8
    for (int i = 0; i < 32; ++i) { const int kk = 2 * i + (lane >> 5); float x = W[(size_t)(k0 + kk) * N + n0 + (lane & 31)]; if (kscale) x *= kscale[k0 + kk]; scr[kk * 33 + (lane & 31)] = x; }
    lds_wait();
    const int c = lane & 7;
#pragma unroll
    for (int j = 0; j < 4; ++j) {
        const int n = (lane >> 3) + 8 * j; const float* s = scr + (8 * c) * 33 + n;
        u32x4 o; o.x = pk2(s[0 * 33], s[1 * 33]); o.y = pk2(s[2 * 33], s[3 * 33]); o.z = pk2(s[4 * 33], s[5 * 33]); o.w = pk2(s[6 * 33], s[7 * 33]);
        *(u32x4*)(WT + (size_t)(d0 + n) * K + k0 + 8 * c) = o;
    }
    lds_wait();
}

__device__ __forceinline__ void rmsnorm_rows_bf16(const float* __restrict__ h, const float* __restrict__ g, bf16_t* __restrict__ out, int gw, int ngw, int lane) {
    f32x4 gg[4];
#pragma unroll
    for (int j = 0; j < 4; ++j) gg[j] = ((const f32x4*)g)[lane + 64 * j];
    for (int row = gw; row < S_; row += 4 * ngw) {
        f32x4 v[4][4]; float sq[4];
#pragma unroll
        for (int q = 0; q < 4; ++q) {
            const f32x4* x = (const f32x4*)(h + (size_t)(row + q * ngw) * D_) + lane;
#pragma unroll
            for (int j = 0; j < 4; ++j) v[q][j] = x[64 * j];
        }
#pragma unroll
        for (int q = 0; q < 4; ++q) {
            sq[q] = 0.f;
#pragma unroll
            for (int j = 0; j < 4; ++j) sq[q] += (v[q][j].x * v[q][j].x + v[q][j].y * v[q][j].y) + (v[q][j].z * v[q][j].z + v[q][j].w * v[q][j].w);
        }
#pragma unroll
        for (int o = 1; o < 64; o <<= 1) {
#pragma unroll
            for (int q = 0; q < 4; ++q) sq[q] += __shfl_xor(sq[q], o);
        }
#pragma unroll
        for (int q = 0; q < 4; ++q) {
            const float r = rsqrtf(sq[q] * (1.f / 1024.f) + 1e-6f);
            unsigned long long* o8 = (unsigned long long*)(out + (size_t)(row + q * ngw) * D_) + lane;
#pragma unroll
            for (int j = 0; j < 4; ++j)
                o8[64 * j] = (unsigned long long)pk2(v[q][j].x * r * gg[j].x, v[q][j].y * r * gg[j].y) | ((unsigned long long)pk2(v[q][j].z * r * gg[j].z, v[q][j].w * r * gg[j].w) << 32);
        }
    }
}

__device__ __forceinline__ void phase_prep(const Params& P, int layer, unsigned char* smem, int tid) {
    const int wave = tid >> 6, lane = tid & 63;
    const int gw = blockIdx.x * 8 + wave, ngw = gridDim.x * 8;
    float* scr = (float*)smem + wave * (64 * 33);
    bf16_t* WT = (bf16_t*)(P.ws + OFF_WT);
    constexpr int I0 = 16 * 120, I1 = 16 * 32, I2 = 16 * 176, I3 = 44 * 32, I4 = 16 * 32, I5 = 4 * 32, I6 = 8, I7 = 8, I8 = 16, I9 = 4;
    constexpr int NIT = I0 + I1 + I2 + I3 + I4 + I5 + I6 + I7 + I8 + I9;
    for (int it = gw; it < NIT; it += ngw) {
        int r = it;
        if (r < I0) { transpose_item(P.in[I_WIN] + (size_t)layer * 1024 * 3840, 1024, 3840, WT + WT_IN, scr, r, lane); continue; } r -= I0;
        if (r < I1) { transpose_item(P.in[I_WOUT] + (size_t)layer * 1024 * 1024, 1024, 1024, WT + WT_OUT, scr, r, lane); continue; } r -= I1;
        if (r < I2) { transpose_item(P.in[I_UP] + (size_t)layer * 1024 * 5632, 1024, 5632, WT + WT_UP, scr, r, lane, true); continue; } r -= I2;
        if (r < I3) { transpose_item(P.in[I_DOWN] + (size_t)layer * 2816 * 1024, 2816, 1024, WT + WT_DOWN, scr, r, lane); continue; } r -= I3;
        if (r < I4) { transpose_item(P.in[I_GATE] + (size_t)layer * 1024 * 1024, 1024, 1024, WT + WT_GATE, scr, r, lane, false, P.in[I_NPLE] + layer * 1024); continue; } r -= I4;
        if (r < I5) { transpose_item(P.in[I_PROJ] + (size_t)layer * 256 * 1024, 256, 1024, WT + WT_PROJ, scr, r, lane); continue; } r -= I5;
        if (r < I6) { transpose_item(P.in[I_W2] + (size_t)layer * 64 * 256, 64, 256, WT + WT_W2, scr, r, lane); continue; } r -= I6;
        if (r < I7) { transpose_item(P.in[I_A2] + (size_t)layer * 64 * 256, 64, 256, WT + WT_A2, scr, r, lane); continue; } r -= I7;
        if (r < I8) { transpose_item(P.in[I_G2] + (size_t)layer * 128 * 256, 128, 256, WT + WT_G2, scr, r, lane); continue; } r -= I8;
        transpose_item(P.in[I_V1], 256, 32, WT + WT_V1, scr, r, lane);
    }
    const float* h = (layer == 0) ? P.in[I_X] : P.out;
    rmsnorm_rows_bf16(h, P.in[I_NMIX] + layer * 1024, (bf16_t*)(P.ws + OFF_HN), gw, ngw, lane);
}

struct EpiRoute {
    static constexpr bool PERM = true, AFTER_DRAIN = false;
    bf16_t* d0; bf16_t* d1; bf16_t* d2; int ld0, ld1, ld2, c1, c2;
    __device__ __forceinline__ void operator()(const f32x4 (&acc)[2][2][4][2], const Unit& u, int wr, int wc, int fr, int fq) const {
        int colt = u.pn * 256; bf16_t* base; int ld;
        if (colt < c1) { base = d0; ld = ld0; } else if (colt < c2) { base = d1; ld = ld1; colt -= c1; } else { base = d2; ld = ld2; colt -= c2; }
        const int row0 = u.pm * 256 + wr * 64 + fr, col0 = colt + wc * 32 + 8 * fq;
#pragma unroll
        for (int ai = 0; ai < 2; ++ai)
#pragma unroll
            for (int m = 0; m < 4; ++m) {
                bf16_t* rowp = base + (size_t)(row0 + ai * 128 + m * 16) * ld + col0;
#pragma unroll
                for (int bj = 0; bj < 2; ++bj) {
                    const f32x4 v0 = acc[ai][bj][m][0], v1 = acc[ai][bj][m][1];
                    u32x4 w; w.x = pk2(v0[0], v0[1]); w.y = pk2(v0[2], v0[3]); w.z = pk2(v1[0], v1[1]); w.w = pk2(v1[2], v1[3]);
                    *(u32x4*)(rowp + bj * 128) = w;
                }
            }
    }
};
template <int MODE  > struct EpiF32 {
    static constexpr bool PERM = false, AFTER_DRAIN = false;
    const float* hin; float* out; bf16_t* hb; float* ssq;
    __device__ __forceinline__ void operator()(const f32x4 (&acc)[2][2][4][2], const Unit& u, int wr, int wc, int fr, int fq) const {
        const int row0 = u.pm * 256 + wr * 64 + fr, col0 = u.pn * 256 + wc * 32 + 4 * fq;
#pragma unroll
        for (int ai = 0; ai < 2; ++ai)
#pragma unroll
            for (int m = 0; m < 4; ++m) {
                const int row = row0 + ai * 128 + m * 16;
                const size_t ro = (size_t)row * 1024 + col0;
                float sq = 0.f, rs = 1.f;
                if (MODE == 4) rs = rsqrtf(ssq[row] * (1.f / 1024.f) + 1e-6f);
#pragma unroll
                for (int bj = 0; bj < 2; ++bj)
#pragma unroll
                    for (int n = 0; n < 2; ++n) {
                        const size_t off = ro + bj * 128 + n * 16;
                        const f32x4 a = acc[ai][bj][m][n];
                        if (MODE == 0) { *(f32x4*)(out + off) = *(const f32x4*)(hin + off) + a; }
                        else if (MODE == 1) { *(f32x4*)(out + off) = a; }
                        else if (MODE == 3) {
                            const f32x4 o = *(const f32x4*)(hin + off) + a; *(f32x4*)(out + off) = o;
                            sq += (o.x * o.x + o.y * o.y) + (o.z * o.z + o.w * o.w);
                            *(unsigned long long*)(hb + off) = (unsigned long long)pk2(o.x, o.y) | ((unsigned long long)pk2(o.z, o.w) << 32);
                        }
                        else { const f32x4 pp = *(const f32x4*)(hin + off); f32x4 hv = *(f32x4*)(out + off);
                               hv.x += sigm(a.x * rs) * pp.x; hv.y += sigm(a.y * rs) * pp.y; hv.z += sigm(a.z * rs) * pp.z; hv.w += sigm(a.w * rs) * pp.w; *(f32x4*)(out + off) = hv; }
                    }
                if (MODE == 3) { sq += __shfl_xor(sq, 16); sq += __shfl_xor(sq, 32); if (fq == 0) atomicAdd(ssq + row, sq); }
            }
    }
};

__device__ __forceinline__ float dpp_ror1(float x) { return __int_as_float(__builtin_amdgcn_update_dpp(0, __float_as_int(x), 0x121, 0xF, 0xF, true)); }
__device__ __forceinline__ float dpp_ror2(float x) { return __int_as_float(__builtin_amdgcn_update_dpp(0, __float_as_int(x), 0x122, 0xF, 0xF, true)); }
__device__ __forceinline__ unsigned long long pk4(float a, float b, float c, float d) { return (unsigned long long)pk2_sw(a, b) | ((unsigned long long)pk2_sw(c, d) << 32); }
struct EpiConv {
    static constexpr bool PERM = true, AFTER_DRAIN = false;
    bf16_t* act; bf16_t* hl; bf16_t* hf; const float* cw; const float* cb;
    __device__ __forceinline__ void operator()(const f32x4 (&acc)[2][2][4][2], const Unit& u, int wr, int wc, int fr, int fq) const {
        const int cg0 = 128 * u.pn + 32 * wc + 8 * fq;
#pragma unroll
        for (int n = 0; n < 2; ++n) {
            const int cg = cg0 + 4 * n;
            const f32x4 bg = *(const f32x4*)(cb + cg), bv = *(const f32x4*)(cb + 2816 + cg);
            const f32x4 g0 = *(const f32x4*)(cw + cg), g1 = *(const f32x4*)(cw + 5632 + cg), g2 = *(const f32x4*)(cw + 11264 + cg);
            const f32x4 v0 = *(const f32x4*)(cw + 2816 + cg), v1 = *(const f32x4*)(cw + 5632 + 2816 + cg), v2 = *(const f32x4*)(cw + 11264 + 2816 + cg);
#pragma unroll
            for (int ai = 0; ai < 2; ++ai) {
                const int rbase = 256 * u.pm + 128 * ai + 64 * wr, grp = rbase >> 6;
#pragma unroll
                for (int m = 0; m < 4; ++m) {
                    const f32x4 xg = acc[ai][0][m][n], xv = acc[ai][1][m][n];
                    const f32x4 yg = acc[ai][0][m > 0 ? m - 1 : 0][n], yv = acc[ai][1][m > 0 ? m - 1 : 0][n];
                    f32x4 gt, vl;
#pragma unroll
                    for (int e = 0; e < 4; ++e) {
                        const float u1 = dpp_ror1((fr == 15) ? yg[e] : xg[e]), u2 = dpp_ror2((fr >= 14) ? yg[e] : xg[e]);
                        gt[e] = bg[e] + g0[e] * u2 + g1[e] * u1 + g2[e] * xg[e];
                    }
#pragma unroll
                    for (int e = 0; e < 4; ++e) {
                        const float u1 = dpp_ror1((fr == 15) ? yv[e] : xv[e]), u2 = dpp_ror2((fr >= 14) ? yv[e] : xv[e]);
                        vl[e] = bv[e] + v0[e] * u2 + v1[e] * u1 + v2[e] * xv[e];
                    }
                    const size_t r = (size_t)(rbase + 16 * m + fr);
                    if (m > 0 || fr >= 2)
                        *(unsigned long long*)(act + r * 2816 + cg) = (unsigned long long)pk2(gt[0] * sigm(gt[0]) * vl[0], gt[1] * sigm(gt[1]) * vl[1]) | ((unsigned long long)pk2(gt[2] * sigm(gt[2]) * vl[2], gt[3] * sigm(gt[3]) * vl[3]) << 32);
                    if (m == 0 && fr < 2) {
                        bf16_t* d = hf + (size_t)(grp * 2 + fr) * 5632 + cg;
                        *(unsigned long long*)d = pk4(xg[0], xg[1], xg[2], xg[3]); *(unsigned long long*)(d + 2816) = pk4(xv[0], xv[1], xv[2], xv[3]);
                    }
                    if (m == 3 && fr >= 14) {
                        bf16_t* d = hl + (size_t)(grp * 2 + (fr - 14)) * 5632 + cg;
                        *(unsigned long long*)d = pk4(xg[0], xg[1], xg[2], xg[3]); *(unsigned long long*)(d + 2816) = pk4(xv[0], xv[1], xv[2], xv[3]);
                    }
                }
            }
        }
    }
};
__device__ __forceinline__ void conv_fixup(const Params& P, int layer, int tid) {
    const bf16_t* hl = (const bf16_t*)(P.ws + OFF_U + 16 * MiB); const bf16_t* hf = (const bf16_t*)(P.ws + OFF_U + 24 * MiB);
    bf16_t* ACT = (bf16_t*)(P.ws + OFF_ACT);
    const float* cw = P.in[I_CW] + (size_t)layer * 3 * 5632; const float* cb = P.in[I_CB] + (size_t)layer * 5632;
    for (int it = blockIdx.x * NTHREADS + tid; it < 256 * 2 * 352; it += gridDim.x * NTHREADS) {
        const int cgp = it % 352, rs = it / 352, j = rs >> 1, sidx = rs & 1, c = cgp * 8;
        u32x4 a2[2], a1[2], a0[2];
#pragma unroll
        for (int q = 0; q < 2; ++q) {
            const int off = q * 2816 + c;
            const u32x4 z = (u32x4){0u, 0u, 0u, 0u};
            const u32x4 l0 = (j > 0) ? *(const u32x4*)(hl + (size_t)((j - 1) * 2 + 0) * 5632 + off) : z;
            const u32x4 l1 = (j > 0) ? *(const u32x4*)(hl + (size_t)((j - 1) * 2 + 1) * 5632 + off) : z;
            const u32x4 f0 = *(const u32x4*)(hf + (size_t)(j * 2 + 0) * 5632 + off), f1 = *(const u32x4*)(hf + (size_t)(j * 2 + 1) * 5632 + off);
            if (sidx == 0) { a2[q] = l0; a1[q] = l1; a0[q] = f0; } else { a2[q] = l1; a1[q] = f0; a0[q] = f1; }
        }
        float res[8];
#pragma unroll
        for (int q = 0; q < 4; ++q) {
#pragma unroll
            for (int hh = 0; hh < 2; ++hh) {
                const int cc = c + 2 * q + hh;
                const float ug2 = hh ? bfhi(a2[0][q]) : bflo(a2[0][q]), ug1 = hh ? bfhi(a1[0][q]) : bflo(a1[0][q]), ug0 = hh ? bfhi(a0[0][q]) : bflo(a0[0][q]);
                const float uv2 = hh ? bfhi(a2[1][q]) : bflo(a2[1][q]), uv1 = hh ? bfhi(a1[1][q]) : bflo(a1[1][q]), uv0 = hh ? bfhi(a0[1][q]) : bflo(a0[1][q]);
                const float gt = cb[cc] + cw[cc] * ug2 + cw[5632 + cc] * ug1 + cw[11264 + cc] * ug0;
                const float vl = cb[2816 + cc] + cw[2816 + cc] * uv2 + cw[5632 + 2816 + cc] * uv1 + cw[11264 + 2816 + cc] * uv0;
                res[2 * q + hh] = gt * sigm(gt) * vl;
            }
        }
        u32x4 o; o.x = pk2(res[0], res[1]); o.y = pk2(res[2], res[3]); o.z = pk2(res[4], res[5]); o.w = pk2(res[6], res[7]);
        *(u32x4*)(ACT + (size_t)(64 * j + sidx) * 2816 + c) = o;
    }
}

template <class Epi> __device__ __forceinline__ void run_gemm(unsigned char* smem, const bf16_t* A, const bf16_t* Bt, int M, int N, int K, const Epi& E) {
    pg8::Gemm g; g.A = A; g.Bt = Bt; g.M = M; g.N = N; g.K = K;
    pg8::StaticOrder So; So.init(M, N, (int)gridDim.x, (int)blockIdx.x);
    pg8::gemm_phase<Epi, pg8::StaticOrder, false>((PG8_LAS unsigned char*)smem, g, So, E, nullptr);
}

constexpr int CMS = 1028;
__device__ __forceinline__ pg8::bf16x8 lds_f32x8_to_bf16(const float* p) {
    const f32x4 a = *(const f32x4*)p, b = *(const f32x4*)(p + 4);
    u32x4 w; w.x = pk2(a.x, a.y); w.y = pk2(a.z, a.w); w.z = pk2(b.x, b.y); w.w = pk2(b.z, b.w);
    return __builtin_bit_cast(pg8::bf16x8, w);
}
__device__ __forceinline__ void rwkv_prep(const Params& P, int layer, unsigned char* smem, int tid) {
    using pg8::bf16x8;
    float* cmL = (float*)smem;
    float* loraL = cmL + 16 * CMS;
    float* uL = loraL + 16 * 768;
    const bf16_t* ZC = (const bf16_t*)(P.ws + OFF_ZC);
    const bf16_t* WT = (const bf16_t*)(P.ws + OFF_WT);
    h16* VF = (h16*)(P.ws + OFF_VF);
    h16* RK = (h16*)(P.ws + OFF_RK);
    const float* mu = P.in[I_MU] + layer * 1024;
    const int j = tid & 255, th = tid >> 8, tb = th * 8;
    const int w = tid >> 6, lane = tid & 63, lr = lane & 15, lq = lane >> 4;
    const float w0j = P.in[I_W0][layer * 256 + j], a0j = P.in[I_A0][layer * 256 + j], kkj = P.in[I_KK][layer * 256 + j], kaj = P.in[I_KA][layer * 256 + j];
    const float v0j = (layer > 0) ? P.in[I_V0][j] : 0.f;
    float v2c[32];
#pragma unroll
    for (int m = 0; m < 32; ++m) v2c[m] = (layer > 0) ? P.in[I_V2][m * 256 + j] : 0.f;
    const int c2 = tid * 2;
    const float mu0 = mu[c2], mu1 = mu[c2 + 1];
    for (int tile = blockIdx.x; tile < S_ / 16; tile += gridDim.x) {
        const int t0 = tile * 16;
        __syncthreads();
        {
            unsigned cu[17];
            cu[0] = (t0 > 0) ? *(const unsigned*)(ZC + (size_t)(t0 - 1) * 1024 + c2) : 0u;
#pragma unroll
            for (int i = 0; i < 16; ++i) cu[i + 1] = *(const unsigned*)(ZC + (size_t)(t0 + i) * 1024 + c2);
#pragma unroll
            for (int i = 0; i < 16; ++i) {
                const float p0 = bflo(cu[i]), p1 = bfhi(cu[i]), c0 = bflo(cu[i + 1]), c1 = bfhi(cu[i + 1]);
                float m0 = c0 + (p0 - c0) * mu0, m1 = c1 + (p1 - c1) * mu1;
                if (c2 >= 768 && c2 < 832) { m0 = tanhf(m0); m1 = tanhf(m1); }
                else if (c2 >= 896) { m0 = sigm(m0); m1 = sigm(m1); }
                f32x2v mm; mm.x = m0; mm.y = m1;
                *(f32x2v*)(cmL + i * CMS + c2) = mm;
            }
        }
        __syncthreads();
        {
#pragma unroll 2
            for (int i = 0; i < 6; ++i) {
                const int nt = 6 * w + i, seg = nt >> 4, n0 = (nt & 15) * 16;
                const int cmoff = (seg == 0) ? 768 : (seg == 1 ? 832 : 896);
                f32x4 acc = (f32x4){0.f, 0.f, 0.f, 0.f};
                if (seg == 2) {
                    const bf16_t* Wp = WT + WT_G2 + (size_t)(n0 + lr) * 128 + 8 * lq;
                    bf16x8 bq[4];
#pragma unroll
                    for (int ks = 0; ks < 4; ++ks) bq[ks] = *(const bf16x8*)(Wp + 32 * ks);
#pragma unroll
                    for (int ks = 0; ks < 4; ++ks) acc = __builtin_amdgcn_mfma_f32_16x16x32_bf16(lds_f32x8_to_bf16(cmL + lr * CMS + cmoff + 32 * ks + 8 * lq), bq[ks], acc, 0, 0, 0);
                } else {
                    const bf16_t* Wp = WT + ((seg == 0) ? WT_W2 : WT_A2) + (size_t)(n0 + lr) * 64 + 8 * lq;
                    bf16x8 bq[2];
#pragma unroll
                    for (int ks = 0; ks < 2; ++ks) bq[ks] = *(const bf16x8*)(Wp + 32 * ks);
#pragma unroll
                    for (int ks = 0; ks < 2; ++ks) acc = __builtin_amdgcn_mfma_f32_16x16x32_bf16(lds_f32x8_to_bf16(cmL + lr * CMS + cmoff + 32 * ks + 8 * lq), bq[ks], acc, 0, 0, 0);
                }
#pragma unroll
                for (int e = 0; e < 4; ++e) loraL[(4 * lq + e) * 768 + seg * 256 + n0 + lr] = acc[e];
            }
            if (layer > 0 && w < 2) {
                f32x4 acc = (f32x4){0.f, 0.f, 0.f, 0.f};
                const bf16_t* Vp = WT + WT_V1 + (size_t)(16 * w + lr) * 256 + 8 * lq;
#pragma unroll
                for (int ks = 0; ks < 8; ++ks) {
                    const bf16x8 b = *(const bf16x8*)(Vp + 32 * ks);
                    const bf16x8 a = lds_f32x8_to_bf16(cmL + lr * CMS + 512 + 32 * ks + 8 * lq);
                    acc = __builtin_amdgcn_mfma_f32_16x16x32_bf16(a, b, acc, 0, 0, 0);
                }
#pragma unroll
                for (int e = 0; e < 4; ++e) uL[(4 * lq + e) * 32 + 16 * w + lr] = acc[e];
            }
        }
        __syncthreads();
#pragma unroll
        for (int tt = 0; tt < 8; ++tt) {
            const int t = t0 + tb + tt; const float* cr = cmL + (tb + tt) * CMS; const float* lo = loraL + (tb + tt) * 768;
            const float r = cr[j], k = cr[256 + j]; float v = cr[512 + j];
            const float x = -(w0j + lo[j]);
            const float sp = fmaxf(x, 0.f) + log1pf(__expf(-fabsf(x)));
            const float e = __expf(-sp - 0.5f);
            const float a = sigm(a0j + lo[256 + j]);
            const float g = lo[512 + j];
            if (layer == 0) { VF[(size_t)t * 256 + j] = (h16)v; }
            else {
                float acc = v0j;
#pragma unroll
                for (int m = 0; m < 32; ++m) acc += uL[(tb + tt) * 32 + m] * v2c[m];
                const float vf = (float)VF[(size_t)t * 256 + j];
                v = v + (vf - v) * sigm(acc);
            }
            float kk = k * kkj; const float ss = wave_sum(kk * kk); kk = kk / fmaxf(sqrtf(ss), 1e-12f);
            const float k2 = k * (1.f + (a - 1.f) * kaj);
            const size_t o = (size_t)t * 256 + j;
            RK[0 * RKSZ + o] = (h16)r; RK[1 * RKSZ + o] = (h16)k2; RK[2 * RKSZ + o] = (h16)v; RK[3 * RKSZ + o] = (h16)kk;
            RK[4 * RKSZ + o] = (h16)(kk * a); RK[5 * RKSZ + o] = (h16)e; RK[6 * RKSZ + o] = (h16)g;
        }
    }
}

constexpr int AT_VS = 280;
__device__ __forceinline__ void attn_partial(const Params& P, unsigned char* smem, int tid) {
    using pg8::bf16x8;
    const bf16_t* ZB = (const bf16_t*)(P.ws + OFF_ZB);
    bf16_t* MIX = (bf16_t*)(P.ws + OFF_HN);
    float* LSE = (float*)(P.ws + OFF_LSE);
    bf16_t* Vt = (bf16_t*)smem;
    const int w = tid >> 6, lane = tid & 63, lr = lane & 15, lq = lane >> 4;
    for (int item = blockIdx.x; item < 1536; item += gridDim.x) {
        const int p = item >> 9, rem = item & 511, h = rem & 3, rest = rem >> 2;
        const int d = (p == 0) ? 1 : (p == 1 ? 4 : 16);
        const int nqb = 128 / d, r = rest / nqb, qb = rest % nqb;
        const int L0 = qb * 128, l0 = L0 + 16 * w;
        __syncthreads();
        {
            const int kl = tid & 255, hf = tid >> 8, kidx = L0 - 128 + kl;
            u32x4 x[4];
            if (kidx >= 0) {
                const u32x4* src = (const u32x4*)(ZB + (size_t)(kidx * d + r) * 768 + 512 + h * 64 + 32 * hf);
#pragma unroll
                for (int c = 0; c < 4; ++c) x[c] = src[c];
            } else {
#pragma unroll
                for (int c = 0; c < 4; ++c) x[c] = (u32x4){0u, 0u, 0u, 0u};
            }
#pragma unroll
            for (int c = 0; c < 4; ++c)
#pragma unroll
                for (int e = 0; e < 4; ++e) {
                    const unsigned u = x[c][e];
                    Vt[(32 * hf + 8 * c + 2 * e) * AT_VS + kl] = (bf16_t)(u & 0xffffu);
                    Vt[(32 * hf + 8 * c + 2 * e + 1) * AT_VS + kl] = (bf16_t)(u >> 16);
                }
            *(unsigned*)(Vt + (tid >> 3) * AT_VS + 256 + (tid & 7) * 2) = 0u;
        }
        __syncthreads();
        const size_t qtok = (size_t)((l0 + lr) * d + r);
        bf16x8 qf[2];
#pragma unroll
        for (int ks = 0; ks < 2; ++ks) qf[ks] = *(const bf16x8*)(ZB + qtok * 768 + h * 64 + 32 * ks + 8 * lq);
        f32x4 sc[9];
#pragma unroll
        for (int kt = 0; kt < 9; ++kt) {
            const int kbase = l0 - 128 + 16 * kt;
            sc[kt] = (f32x4){0.f, 0.f, 0.f, 0.f};
            if (kbase >= 0) {
                const bf16_t* kp = ZB + (size_t)((kbase + lr) * d + r) * 768 + 256 + h * 64 + 8 * lq;
                const bf16x8 a0 = *(const bf16x8*)kp, a1 = *(const bf16x8*)(kp + 32);
                sc[kt] = __builtin_amdgcn_mfma_f32_16x16x32_bf16(a0, qf[0], sc[kt], 0, 0, 0);
                sc[kt] = __builtin_amdgcn_mfma_f32_16x16x32_bf16(a1, qf[1], sc[kt], 0, 0, 0);
            }
        }
        const int qidx = l0 + lr;
        float m = -1e30f;
#pragma unroll
        for (int kt = 0; kt < 9; ++kt)
#pragma unroll
            for (int e = 0; e < 4; ++e) {
                const int kidx = l0 - 128 + 16 * kt + 4 * lq + e;
                const bool valid = (kidx >= 0) && (kidx <= qidx) && (kidx >= qidx - 128);
                const float sv = valid ? sc[kt][e] * 0.125f : -1e30f;
                sc[kt][e] = sv; m = fmaxf(m, sv);
            }
        m = fmaxf(m, __shfl_xor(m, 16)); m = fmaxf(m, __shfl_xor(m, 32));
        float sum = 0.f;
#pragma unroll
        for (int kt = 0; kt < 9; ++kt)
#pragma unroll
            for (int e = 0; e < 4; ++e) {
                const float sv = sc[kt][e];
                const float pv = (sv > -1e29f) ? __expf(sv - m) : 0.f;
                sc[kt][e] = pv; sum += pv;
            }
        sum += __shfl_xor(sum, 16); sum += __shfl_xor(sum, 32);
        f32x4 acc[4];
#pragma unroll
        for (int n = 0; n < 4; ++n) acc[n] = (f32x4){0.f, 0.f, 0.f, 0.f};
#pragma unroll
        for (int s5 = 0; s5 < 5; ++s5) {
            u32x4 pw;
            pw.x = pk2(sc[2 * s5][0], sc[2 * s5][1]); pw.y = pk2(sc[2 * s5][2], sc[2 * s5][3]);
            if (s5 < 4) { pw.z = pk2(sc[2 * s5 + 1][0], sc[2 * s5 + 1][1]); pw.w = pk2(sc[2 * s5 + 1][2], sc[2 * s5 + 1][3]); } else { pw.z = 0u; pw.w = 0u; }
            const bf16x8 pf = __builtin_bit_cast(bf16x8, pw);
#pragma unroll
            for (int n = 0; n < 4; ++n) {
                const bf16_t* vp = Vt + (16 * n + lr) * AT_VS + 16 * w + 32 * s5 + 4 * lq;
                const f32x2v lo = *(const f32x2v*)vp, hi = *(const f32x2v*)(vp + 16);
                f32x4 vv; vv.x = lo.x; vv.y = lo.y; vv.z = hi.x; vv.w = hi.y;
                const bf16x8 vf = __builtin_bit_cast(bf16x8, vv);
                acc[n] = __builtin_amdgcn_mfma_f32_16x16x32_bf16(vf, pf, acc[n], 0, 0, 0);
            }
        }
        const float inv = 1.f / sum;
        const int slot = ((p == 0) ? 0 : (p == 1 ? 256 : 768)) + h * 64;
        bf16_t* orow = MIX + qtok * 1024 + slot + 4 * lq;
#pragma unroll
        for (int n = 0; n < 4; ++n) {
            const unsigned long long o8 = (unsigned long long)pk2(acc[n][0] * inv, acc[n][1] * inv) | ((unsigned long long)pk2(acc[n][2] * inv, acc[n][3] * inv) << 32);
            *(unsigned long long*)(orow + 16 * n) = o8;
        }
        if (lq == 0) LSE[((size_t)p * S_ + qtok) * 4 + h] = m + __logf(sum);
    }
}

__device__ __forceinline__ void attn_combine(const Params& P, int tid, int first = -1, int step = 0) {
    bf16_t* MIX = (bf16_t*)(P.ws + OFF_HN);
    const float* LSE = (const float*)(P.ws + OFF_LSE);
    const int total = S_ * 4 * 8;
    for (int it = (first >= 0 ? first : (int)(blockIdx.x * NTHREADS + tid)); it < total; it += (first >= 0 ? step : (int)(gridDim.x * NTHREADS))) {
        const int c8 = it & 7, h = (it >> 3) & 3, t = it >> 5;
        const float l0 = LSE[((size_t)0 * S_ + t) * 4 + h], l1 = LSE[((size_t)1 * S_ + t) * 4 + h], l2 = LSE[((size_t)2 * S_ + t) * 4 + h];
        const float mx = fmaxf(l0, fmaxf(l1, l2));
        float w0 = __expf(l0 - mx), w1 = __expf(l1 - mx), w2 = __expf(l2 - mx);
        const float inv = 1.f / (w0 + w1 + w2); w0 *= inv; w1 *= inv; w2 *= inv;
        const size_t rb = (size_t)t * 1024 + h * 64 + c8 * 8;
        const u32x4 a = *(const u32x4*)(MIX + rb), b = *(const u32x4*)(MIX + rb + 256), c = *(const u32x4*)(MIX + rb + 768);
        u32x4 o;
        o.x = pk2(w0 * bflo(a.x) + w1 * bflo(b.x) + w2 * bflo(c.x), w0 * bfhi(a.x) + w1 * bfhi(b.x) + w2 * bfhi(c.x));
        o.y = pk2(w0 * bflo(a.y) + w1 * bflo(b.y) + w2 * bflo(c.y), w0 * bfhi(a.y) + w1 * bfhi(b.y) + w2 * bfhi(c.y));
        o.z = pk2(w0 * bflo(a.z) + w1 * bflo(b.z) + w2 * bflo(c.z), w0 * bfhi(a.z) + w1 * bfhi(b.z) + w2 * bfhi(c.z));
        o.w = pk2(w0 * bflo(a.w) + w1 * bflo(b.w) + w2 * bflo(c.w), w0 * bfhi(a.w) + w1 * bfhi(b.w) + w2 * bfhi(c.w));
        *(u32x4*)(MIX + rb + 512) = o;
    }
}

__device__ __forceinline__ float hgrn_lb(const Params& P, int layer, int idx) {
    if (layer == 0) return 0.f;
    return sigm(P.in[I_LB][512 + idx] - P.in[I_LB][idx]);
}

__device__ __forceinline__ void hgrn_pass1(const Params& P, int layer, unsigned char* smem, int tid) {
    using pg8::bf16x8;
    bf16_t* Vt = (bf16_t*)smem;
    bf16_t* KhT = Vt + 128 * 72;
    float* tot = (float*)(KhT + 128 * 72);
    bf16_t* Rf = (bf16_t*)(tot + 512);
    bf16_t* Ri = Rf + 64 * 128;
    const bf16_t* ZH = (const bf16_t*)(P.ws + OFF_ZH);
    bf16_t* NC = (bf16_t*)(P.ws + OFF_ZC);
    float* GB = (float*)(P.ws + OFF_GB);
    const int k = tid & 127, qd = tid >> 7;
    const int w = tid >> 6, lane = tid & 63, lr = lane & 15, lq = lane >> 4;
    for (int item = blockIdx.x; item < 1024; item += gridDim.x) {
        const int c = item >> 2, h = item & 3, t0 = c * 64;
        const float lbv = hgrn_lb(P, layer, h * 128 + k);
        __syncthreads();
        {
            u32x4 rv[4];
#pragma unroll
            for (int e = 0; e < 4; ++e) { const int ch = tid + 512 * (e & 1), row = ch >> 4, c8 = (ch & 15) * 8;
                rv[e] = *(const u32x4*)(ZH + (size_t)(t0 + row) * 2048 + ((e < 2) ? 512 : 1024) + h * 128 + c8); }
#pragma unroll
            for (int e = 0; e < 4; ++e) { const int ch = tid + 512 * (e & 1), row = ch >> 4, c8 = (ch & 15) * 8;
                *(u32x4*)(((e < 2) ? Rf : Ri) + row * 128 + c8) = rv[e]; }
        }
        __syncthreads();
        float fl[16], bl[16]; float run = 0.f;
#pragma unroll
        for (int i = 0; i < 16; ++i) {
            const float fr = bf2f(Rf[(16 * qd + i) * 128 + k]);
            const float f = lbv + (1.f - lbv) * sigm(fr);
            fl[i] = f; run += __logf(f); bl[i] = run;
            Vt[k * 72 + 16 * qd + i] = Ri[(16 * qd + i) * 128 + k];
        }
        tot[qd * 128 + k] = run;
        __syncthreads();
        float pre = 0.f, all = 0.f;
#pragma unroll
        for (int q = 0; q < 4; ++q) { const float x = tot[q * 128 + k]; if (q < qd) pre += x; all += x; }
        {
            float kh[16];
#pragma unroll
            for (int i = 0; i < 16; ++i) kh[i] = (1.f - fl[i]) * __expf(all - (pre + bl[i]));
            u32x4 w0, w1;
            w0.x = pk2(kh[0], kh[1]); w0.y = pk2(kh[2], kh[3]); w0.z = pk2(kh[4], kh[5]); w0.w = pk2(kh[6], kh[7]);
            w1.x = pk2(kh[8], kh[9]); w1.y = pk2(kh[10], kh[11]); w1.z = pk2(kh[12], kh[13]); w1.w = pk2(kh[14], kh[15]);
            *(u32x4*)(KhT + k * 72 + 16 * qd) = w0; *(u32x4*)(KhT + k * 72 + 16 * qd + 8) = w1;
        }
        if (qd == 0) GB[(size_t)(c * 4 + h) * 128 + k] = __expf(all);
        __syncthreads();
        bf16x8 af[2];
#pragma unroll
        for (int ks = 0; ks < 2; ++ks) af[ks] = *(const bf16x8*)(KhT + (16 * w + lr) * 72 + 32 * ks + 8 * lq);
#pragma unroll
        for (int vt = 0; vt < 8; ++vt) {
            f32x4 acc = (f32x4){0.f, 0.f, 0.f, 0.f};
#pragma unroll
            for (int ks = 0; ks < 2; ++ks) {
                const bf16x8 b = *(const bf16x8*)(Vt + (16 * vt + lr) * 72 + 32 * ks + 8 * lq);
                acc = __builtin_amdgcn_mfma_f32_16x16x32_bf16(af[ks], b, acc, 0, 0, 0);
            }
            *(unsigned long long*)(NC + ((size_t)(c * 4 + h) * 128 + 16 * vt + lr) * 128 + 16 * w + 4 * lq) = (unsigned long long)pk2_sw(acc[0], acc[1]) | ((unsigned long long)pk2_sw(acc[2], acc[3]) << 32);
        }
    }
}

__device__ __forceinline__ void hgrn_scan(const Params& P, int tid) {
    bf16_t* NC = (bf16_t*)(P.ws + OFF_ZC);
    const float* GB = (const float*)(P.ws + OFF_GB);
    if (tid >= 128) return;
    for (int e = blockIdx.x * 128 + tid; e < 32768; e += gridDim.x * 128) {
        const int h = e >> 13, vr = (e >> 6) & 127, k2 = e & 63;
        float s0 = 0.f, s1 = 0.f;
        for (int c0 = 0; c0 < 256; c0 += 32) {
            unsigned n[32]; f32x2v g[32];
#pragma unroll
            for (int u = 0; u < 32; ++u) {
                n[u] = *(const unsigned*)(NC + ((size_t)((c0 + u) * 4 + h) * 128 + vr) * 128 + 2 * k2);
                g[u] = *(const f32x2v*)(GB + (size_t)((c0 + u) * 4 + h) * 128 + 2 * k2);
            }
#pragma unroll
            for (int u = 0; u < 32; ++u) {
                *(unsigned*)(NC + ((size_t)((c0 + u) * 4 + h) * 128 + vr) * 128 + 2 * k2) = pk2(s0, s1);
                s0 = g[u].x * s0 + bflo(n[u]); s1 = g[u].y * s1 + bfhi(n[u]);
            }
        }
    }
}

constexpr int H3_QS = 136, H3_VS = 72;
__device__ __forceinline__ void hgrn_pass3_item(const Params& P, int layer, unsigned char* smem, int tid, int item) {
    using pg8::bf16x8;
    bf16_t* Qt = (bf16_t*)smem;
    bf16_t* Kt = Qt + 64 * H3_QS;
    bf16_t* Qh = Kt + 64 * H3_QS;
    bf16_t* Vt = Qh + 64 * H3_QS;
    float* tot = (float*)(Vt + 128 * H3_VS);
    float* ssq = tot + 512;
    bf16_t* Rq = (bf16_t*)(ssq + 128);
    const bf16_t* ZH = (const bf16_t*)(P.ws + OFF_ZH);
    const bf16_t* NC = (const bf16_t*)(P.ws + OFF_ZC);
    bf16_t* MIX = (bf16_t*)(P.ws + OFF_HN);
    const int c = item >> 2, h = item & 3, t0 = c * 64;
    const int w3 = tid >> 6, lr3 = tid & 15, lq3 = (tid & 63) >> 4;
    bf16x8 sfr[4][4]; unsigned long long graw[4];
    {
        const int k = tid & 127, qd = tid >> 7;
        const float lbv = hgrn_lb(P, layer, h * 128 + k);
        __syncthreads();
        {
            u32x4 rv[6];
#pragma unroll
            for (int e = 0; e < 6; ++e) { const int ch = tid + 512 * (e & 1), row = ch >> 4, c8 = (ch & 15) * 8;
                rv[e] = *(const u32x4*)(ZH + (size_t)(t0 + row) * 2048 + 512 * (e >> 1) + h * 128 + c8); }
#pragma unroll
            for (int e = 0; e < 6; ++e) { const int ch = tid + 512 * (e & 1), row = ch >> 4, c8 = (ch & 15) * 8;
                *(u32x4*)(Rq + (e >> 1) * (64 * 128) + row * 128 + c8) = rv[e]; }
        }
        __syncthreads();
        const bf16_t* Rf = Rq + 64 * 128; const bf16_t* Ri = Rf + 64 * 128;
        float fl[16], bl[16], qv[16]; float run = 0.f;
#pragma unroll
        for (int i = 0; i < 16; ++i) {
            const float qr = bf2f(Rq[(16 * qd + i) * 128 + k]);
            const float fr = bf2f(Rf[(16 * qd + i) * 128 + k]);
            const float f = lbv + (1.f - lbv) * sigm(fr);
            fl[i] = f; run += __logf(f); bl[i] = run; qv[i] = qr * sigm(qr);
            Vt[k * H3_VS + 16 * qd + i] = Ri[(16 * qd + i) * 128 + k];
        }
        tot[qd * 128 + k] = run;
        __syncthreads();
        float pre = 0.f;
#pragma unroll
        for (int q = 0; q < 4; ++q) { const float x = tot[q * 128 + k]; if (q < qd) pre += x; }
        const float rho = tot[k] + tot[128 + k];
#pragma unroll
        for (int i = 0; i < 16; ++i) {
            const float b = pre + bl[i]; const int row = 16 * qd + i;
            Qt[row * H3_QS + k] = f2bf(qv[i] * __expf(b - rho));
            Kt[row * H3_QS + k] = f2bf((1.f - fl[i]) * __expf(rho - b));
            Qh[row * H3_QS + k] = f2bf(qv[i] * __expf(b));
        }
#pragma unroll
        for (int vt = 0; vt < 4; ++vt) {
            const bf16_t* Sr = NC + ((size_t)(c * 4 + h) * 128 + 64 * (w3 >> 2) + 16 * vt + lr3) * 128 + 8 * lq3;
#pragma unroll
            for (int ks = 0; ks < 4; ++ks) sfr[vt][ks] = *(const bf16x8*)(Sr + 32 * ks);
            graw[vt] = *(const unsigned long long*)(ZH + (size_t)(t0 + 16 * (w3 & 3) + lr3) * 2048 + 1536 + h * 128 + 64 * (w3 >> 2) + 16 * vt + 4 * lq3);
        }
        __syncthreads();
    }
    const int w = tid >> 6, lane = tid & 63, lr = lane & 15, lq = lane >> 4, ti = w & 3, vh = w >> 2;
    f32x4 sc[4];
#pragma unroll
    for (int jt = 0; jt < 4; ++jt) {
        sc[jt] = (f32x4){0.f, 0.f, 0.f, 0.f};
        if (jt <= ti) {
#pragma unroll
            for (int ks = 0; ks < 4; ++ks) {
                const bf16x8 a = *(const bf16x8*)(Kt + (16 * jt + lr) * H3_QS + 32 * ks + 8 * lq);
                const bf16x8 b = *(const bf16x8*)(Qt + (16 * ti + lr) * H3_QS + 32 * ks + 8 * lq);
                sc[jt] = __builtin_amdgcn_mfma_f32_16x16x32_bf16(a, b, sc[jt], 0, 0, 0);
            }
            if (jt == ti) {
#pragma unroll
                for (int e = 0; e < 4; ++e) if (4 * lq + e > lr) sc[jt][e] = 0.f;
            }
        }
    }
    bf16x8 pf[2];
#pragma unroll
    for (int s2 = 0; s2 < 2; ++s2) {
        u32x4 pw; pw.x = pk2_sw(sc[2 * s2][0], sc[2 * s2][1]); pw.y = pk2_sw(sc[2 * s2][2], sc[2 * s2][3]); pw.z = pk2_sw(sc[2 * s2 + 1][0], sc[2 * s2 + 1][1]); pw.w = pk2_sw(sc[2 * s2 + 1][2], sc[2 * s2 + 1][3]);
        pf[s2] = __builtin_bit_cast(bf16x8, pw);
    }
    bf16x8 qh[4];
#pragma unroll
    for (int ks = 0; ks < 4; ++ks) qh[ks] = *(const bf16x8*)(Qh + (16 * ti + lr) * H3_QS + 32 * ks + 8 * lq);
    f32x4 acc[4]; float ss = 0.f;
#pragma unroll
    for (int vt = 0; vt < 4; ++vt) {
        const int v0 = 64 * vh + 16 * vt;
        acc[vt] = (f32x4){0.f, 0.f, 0.f, 0.f};
#pragma unroll
        for (int ks = 0; ks < 4; ++ks) acc[vt] = __builtin_amdgcn_mfma_f32_16x16x32_bf16(sfr[vt][ks], qh[ks], acc[vt], 0, 0, 0);
#pragma unroll
        for (int s2 = 0; s2 < 2; ++s2) {
            const bf16_t* vp = Vt + (v0 + lr) * H3_VS + 32 * s2 + 4 * lq;
            const f32x2v lo = *(const f32x2v*)vp, hi = *(const f32x2v*)(vp + 16);
            f32x4 vv; vv.x = lo.x; vv.y = lo.y; vv.z = hi.x; vv.w = hi.y;
            acc[vt] = __builtin_amdgcn_mfma_f32_16x16x32_bf16(__builtin_bit_cast(bf16x8, vv), pf[s2], acc[vt], 0, 0, 0);
        }
        ss += (acc[vt][0] * acc[vt][0] + acc[vt][1] * acc[vt][1]) + (acc[vt][2] * acc[vt][2] + acc[vt][3] * acc[vt][3]);
    }
    ss += __shfl_xor(ss, 16); ss += __shfl_xor(ss, 32);
    if (lq == 0) ssq[vh * 64 + 16 * ti + lr] = ss;
    __syncthreads();
    const float rinv = rsqrtf((ssq[16 * ti + lr] + ssq[64 + 16 * ti + lr]) * (1.f / 128.f) + 1e-6f);
    const size_t t = (size_t)(t0 + 16 * ti + lr);
#pragma unroll
    for (int vt = 0; vt < 4; ++vt) {
        const int v = 64 * vh + 16 * vt + 4 * lq;
        const f32x4 gn = *(const f32x4*)(P.in[I_GN] + layer * 512 + h * 128 + v);
        const unsigned long long gr8 = graw[vt];
        const float g0 = bflo((unsigned)gr8), g1 = bfhi((unsigned)gr8), g2 = bflo((unsigned)(gr8 >> 32)), g3 = bfhi((unsigned)(gr8 >> 32));
        const float o0 = acc[vt][0] * rinv * gn.x * g0 * sigm(g0), o1 = acc[vt][1] * rinv * gn.y * g1 * sigm(g1);
        const float o2 = acc[vt][2] * rinv * gn.z * g2 * sigm(g2), o3 = acc[vt][3] * rinv * gn.w * g3 * sigm(g3);
        *(unsigned long long*)(MIX + t * 1024 + h * 128 + v) = (unsigned long long)pk2(o0, o1) | ((unsigned long long)pk2(o2, o3) << 32);
    }
}

__device__ __forceinline__ float dpp_f(float x, const int ctrl_sel) {
    const int xi = __float_as_int(x); int r;
    if (ctrl_sel == 0) r = __builtin_amdgcn_update_dpp(0, xi, 0xB1, 0xF, 0xF, true);
    else if (ctrl_sel == 1) r = __builtin_amdgcn_update_dpp(0, xi, 0x4E, 0xF, 0xF, true);
    else if (ctrl_sel == 2) r = __builtin_amdgcn_update_dpp(0, xi, 0x141, 0xF, 0xF, true);
    else r = __builtin_amdgcn_update_dpp(0, xi, 0x140, 0xF, 0xF, true);
    return __int_as_float(r);
}
__device__ __forceinline__ float sum16(float x) { x += dpp_f(x, 0); x += dpp_f(x, 1); x += dpp_f(x, 2); x += dpp_f(x, 3); return x; }

constexpr int RS_T = 32;
constexpr int RS_BUF = 5 * RS_T * 64 + RS_T * 32;
constexpr int RS_G = 32, RS_LS = S_ / RS_G, RS_CPS = RS_LS / RS_T;
__device__ __forceinline__ void rwkv_scan_load(const h16* RK, float* buf, int ch, int h, int vrg, int lt) {
    const int tok = lt >> 3, col = (lt & 7) * 8; const size_t t = (size_t)ch * RS_T + tok;
    const size_t go = t * 256 + h * 64 + col;
    const h16x8 hv0 = *(const h16x8*)(RK + (size_t)5 * RKSZ + go);
    const h16x8 hv1 = *(const h16x8*)(RK + (size_t)3 * RKSZ + go);
    const h16x8 hv2 = *(const h16x8*)(RK + (size_t)4 * RKSZ + go);
    const h16x8 hv3 = *(const h16x8*)(RK + (size_t)1 * RKSZ + go);
    const h16x8 hv4 = *(const h16x8*)(RK + (size_t)0 * RKSZ + go);
    h16x4 vh; vh[0] = (h16)0.f; vh[1] = (h16)0.f; vh[2] = (h16)0.f; vh[3] = (h16)0.f;
    if (vrg >= 0) vh = *(const h16x4*)(RK + (size_t)2 * RKSZ + t * 256 + h * 64 + 32 * vrg + 4 * (lt & 7));
    const h16x8 hvs[5] = {hv0, hv1, hv2, hv3, hv4};
#pragma unroll
    for (int a = 0; a < 5; ++a) {
        const h16x8 hv = hvs[a];
        f32x4 lo, hi;
        lo.x = (float)hv[0]; lo.y = (float)hv[1]; lo.z = (float)hv[2]; lo.w = (float)hv[3]; hi.x = (float)hv[4]; hi.y = (float)hv[5]; hi.z = (float)hv[6]; hi.w = (float)hv[7];
        if (a == 0) { lo.x = __expf(-lo.x); lo.y = __expf(-lo.y); lo.z = __expf(-lo.z); lo.w = __expf(-lo.w); hi.x = __expf(-hi.x); hi.y = __expf(-hi.y); hi.z = __expf(-hi.z); hi.w = __expf(-hi.w); }
        float* d = buf + a * (RS_T * 64) + tok * 64 + col;
        *(f32x4*)d = lo; *(f32x4*)(d + 4) = hi;
    }
    f32x4 vf; vf.x = (float)vh[0]; vf.y = (float)vh[1]; vf.z = (float)vh[2]; vf.w = (float)vh[3];
    *(f32x4*)(buf + 5 * RS_T * 64 + tok * 32 + 4 * (lt & 7)) = vf;
}
__device__ __forceinline__ void hgrn_scan_slice(const Params& P, int t, int slice, float& s0, float& s1) {
    bf16_t* NC = (bf16_t*)(P.ws + OFF_ZC);
    const float* GB = (const float*)(P.ws + OFF_GB);
    const int e = blockIdx.x * 128 + t;
    const int h = e >> 13, vr = (e >> 6) & 127, k2 = e & 63;
    const int c0 = 16 * slice;
    unsigned n[16]; f32x2v g[16];
#pragma unroll
    for (int u = 0; u < 16; ++u) {
        n[u] = *(const unsigned*)(NC + ((size_t)((c0 + u) * 4 + h) * 128 + vr) * 128 + 2 * k2);
        g[u] = *(const f32x2v*)(GB + (size_t)((c0 + u) * 4 + h) * 128 + 2 * k2);
    }
#pragma unroll
    for (int u = 0; u < 16; ++u) {
        *(unsigned*)(NC + ((size_t)((c0 + u) * 4 + h) * 128 + vr) * 128 + 2 * k2) = pk2(s0, s1);
        s0 = g[u].x * s0 + bflo(n[u]); s1 = g[u].y * s1 + bfhi(n[u]);
    }
}
__device__ __forceinline__ void pb_convert_item(const Params& P, int layer, int it) {
    const float* p = P.in[I_P] + (size_t)layer * S_ * 256; bf16_t* PB = (bf16_t*)(P.ws + OFF_PB);
    const f32x4 a = ((const f32x4*)p)[2 * it], b = ((const f32x4*)p)[2 * it + 1];
    u32x4 o; o.x = pk2(a.x, a.y); o.y = pk2(a.z, a.w); o.z = pk2(b.x, b.y); o.w = pk2(b.z, b.w);
    ((u32x4*)PB)[it] = o;
}
template <bool PASS_A> __device__ __forceinline__ void rwkv_seg_job(const Params& P, unsigned char* smem, int tid, int g, int h, int rgx, bool chain_only = false, bool side_scan = false, bool side_comb = false, int layer = 0) {
    float* L = (float*)smem;
    float* srow = L + 2 * RS_BUF;
    const h16* RK = (const h16*)(P.ws + OFF_RK);
    float* LX = (float*)(P.ws + OFF_LX);
    bf16_t* MIX = (bf16_t*)(P.ws + OFF_HN);
    const int w = tid >> 6, lane = tid & 63;
    const int row = 8 * (w & 3) + 2 * (lane >> 4), ks = lane & 15;
    const bool ident = PASS_A && (rgx >= 2);
    const int vrg = ident ? -1 : rgx;
    const int ch0 = g * RS_CPS;
    __syncthreads();
    f32x4 sA = (f32x4){0.f, 0.f, 0.f, 0.f}, sB = sA;
    if (PASS_A) {
        if (ident) {
            const int ra = 32 * (rgx - 2) + row, rb = ra + 1;
            sA.x = (4 * ks + 0 == ra) ? 1.f : 0.f; sA.y = (4 * ks + 1 == ra) ? 1.f : 0.f; sA.z = (4 * ks + 2 == ra) ? 1.f : 0.f; sA.w = (4 * ks + 3 == ra) ? 1.f : 0.f;
            sB.x = (4 * ks + 0 == rb) ? 1.f : 0.f; sB.y = (4 * ks + 1 == rb) ? 1.f : 0.f; sB.z = (4 * ks + 2 == rb) ? 1.f : 0.f; sB.w = (4 * ks + 3 == rb) ? 1.f : 0.f;
        }
    } else {
        float* Xl = L;
        float* sr = srow + row * 64;
        const int lt = tid - 256;
        float* S0 = (float*)(P.ws + OFF_S0);
        if (!chain_only && g > 0 && w < 4) { const float* Sb = S0 + ((size_t)(g * 4 + h) * 64 + 32 * rgx + row) * 64 + 4 * ks; sA = *(const f32x4*)Sb; sB = *(const f32x4*)(Sb + 64); }
        const int gend = chain_only ? g : 0;
        float* srC = L + 8 * 4096 + row * 64;
        const int nrounds = (gend + 3) >> 2;
        if (gend > 0 && w >= 4) {
            f32x4 xr[4][4];
#pragma unroll
            for (int q = 0; q < 4; ++q)
#pragma unroll
                for (int e = 0; e < 4; ++e)
                    xr[q][e] = (q < gend) ? *(const f32x4*)(LX + ((size_t)(q * 4 + h) * 128 + 64) * 64 + (size_t)(lt + 256 * e) * 4) : (f32x4){0.f, 0.f, 0.f, 0.f};
#pragma unroll
            for (int q = 0; q < 4; ++q)
#pragma unroll
                for (int e = 0; e < 4; ++e) *(f32x4*)(Xl + q * 4096 + (lt + 256 * e) * 4) = xr[q][e];
        }
        if (gend > 0) __syncthreads();
        for (int r = 0; r < nrounds; ++r) {
            const int g0 = 4 * r, nb = (gend - g0 < 4) ? (gend - g0) : 4;
            float* Xc = Xl + (r & 1) * (4 * 4096);
            if (w >= 4) {
                if (r + 1 < nrounds) {
                    float* Xn = Xl + ((r + 1) & 1) * (4 * 4096); const int gn = g0 + 4, nn = (gend - gn < 4) ? (gend - gn) : 4;
                    f32x4 xr[4][4];
#pragma unroll
                    for (int q = 0; q < 4; ++q)
#pragma unroll
                        for (int e = 0; e < 4; ++e)
                            xr[q][e] = (q < nn) ? *(const f32x4*)(LX + ((size_t)((gn + q) * 4 + h) * 128 + 64) * 64 + (size_t)(lt + 256 * e) * 4) : (f32x4){0.f, 0.f, 0.f, 0.f};
#pragma unroll
                    for (int q = 0; q < 4; ++q)
#pragma unroll
                        for (int e = 0; e < 4; ++e) *(f32x4*)(Xn + q * 4096 + (lt + 256 * e) * 4) = xr[q][e];
                }
            } else {
                for (int q = 0; q < nb; ++q) {
                    const float* Xb = Xc + q * 4096 + 4 * ks;
                    const float* Lb = LX + ((size_t)((g0 + q) * 4 + h) * 128 + 32 * rgx + row) * 64 + 4 * ks;
                    f32x4 nA = *(const f32x4*)Lb, nB = *(const f32x4*)(Lb + 64);
                    *(f32x4*)(srC + 4 * ks) = sA; *(f32x4*)(srC + 64 + 4 * ks) = sB;
                    lds_wait();
#pragma unroll 8
                    for (int kp = 0; kp < 64; ++kp) {
                        const float ska = srC[kp], skb = srC[64 + kp]; const f32x4 xv = *(const f32x4*)(Xb + kp * 64);
                        nA.x += ska * xv.x; nA.y += ska * xv.y; nA.z += ska * xv.z; nA.w += ska * xv.w;
                        nB.x += skb * xv.x; nB.y += skb * xv.y; nB.z += skb * xv.z; nB.w += skb * xv.w;
                    }
                    lds_wait();
                    sA = nA; sB = nB;
                    float* dst = S0 + ((size_t)((g0 + q + 1) * 4 + h) * 64 + 32 * rgx + row) * 64 + 4 * ks;
                    *(f32x4*)dst = sA; *(f32x4*)(dst + 64) = sB;
                }
            }
            __syncthreads();
        }
        if (chain_only) return;
    }
    if (w >= 4) rwkv_scan_load(RK, L, ch0, h, vrg, tid - 256);
    __syncthreads();
    float sc0 = 0.f, sc1 = 0.f;
    for (int cc = 0; cc < RS_CPS; ++cc) {
        const int ch = ch0 + cc;
        float* buf = L + (cc & 1) * RS_BUF;
        if (w >= 4) {
            if (cc + 1 < RS_CPS) rwkv_scan_load(RK, L + ((cc + 1) & 1) * RS_BUF, ch + 1, h, vrg, tid - 256);
            if (PASS_A && side_scan && w >= 6) hgrn_scan_slice(P, tid - 384, cc, sc0, sc1);
            if (!PASS_A && side_comb && w >= 6) pb_convert_item(P, layer, (cc * 256 + (int)blockIdx.x) * 128 + (tid - 384));
            if (PASS_A && side_comb && w >= 6) attn_combine(P, tid, (cc * 256 + (int)blockIdx.x) * 128 + (tid - 384), 1 << 30);
        }
        else {
            const unsigned abase = (unsigned)(size_t)(PG8_LAS float*)buf + 16u * (unsigned)ks;
            const unsigned vbase = (unsigned)(size_t)(PG8_LAS float*)buf + (unsigned)(5 * RS_T * 64 + row) * 4u;
            f32x4 w4n, kk4n, b4n, k4n, r4n = (f32x4){0.f, 0.f, 0.f, 0.f}; f32x2v vvn;
#define RS_LD(tn) do { const unsigned _a = abase + (unsigned)(tn) * 256u; \
                asm volatile("ds_read_b128 %0, %1" : "=v"(w4n) : "v"(_a) : "memory"); \
                asm volatile("ds_read_b128 %0, %1 offset:8192" : "=v"(kk4n) : "v"(_a) : "memory"); \
                asm volatile("ds_read_b128 %0, %1 offset:16384" : "=v"(b4n) : "v"(_a) : "memory"); \
                asm volatile("ds_read_b128 %0, %1 offset:24576" : "=v"(k4n) : "v"(_a) : "memory"); \
                if (!PASS_A) asm volatile("ds_read_b128 %0, %1 offset:32768" : "=v"(r4n) : "v"(_a) : "memory"); \
                { const unsigned _v = vbase + (unsigned)(tn) * 128u; asm volatile("ds_read_b64 %0, %1" : "=v"(vvn) : "v"(_v) : "memory"); } } while (0)
            RS_LD(0);
            float ykA = 0.f, ykB = 0.f;
#pragma unroll 4
            for (int tt = 0; tt < RS_T; ++tt) {
                if (PASS_A) asm volatile("s_waitcnt lgkmcnt(0)" : "+v"(w4n), "+v"(kk4n), "+v"(b4n), "+v"(k4n), "+v"(vvn), "+v"(sA), "+v"(sB) :: "memory");
                else asm volatile("s_waitcnt lgkmcnt(0)" : "+v"(w4n), "+v"(kk4n), "+v"(b4n), "+v"(k4n), "+v"(r4n), "+v"(vvn), "+v"(sA), "+v"(sB) :: "memory");
                const f32x4 w4 = w4n, kk4 = kk4n, b4 = b4n, k4 = k4n, r4 = r4n; const f32x2v vv = vvn;
                const int tn = (tt + 1 < RS_T) ? tt + 1 : tt;
                RS_LD(tn);
                const float dA = (sA.x * kk4.x + sA.y * kk4.y) + (sA.z * kk4.z + sA.w * kk4.w);
                const float dB = (sB.x * kk4.x + sB.y * kk4.y) + (sB.z * kk4.z + sB.w * kk4.w);
                const float saA = -sum16(dA), saB = -sum16(dB);
                sA.x = sA.x * w4.x + (saA * b4.x + vv.x * k4.x); sA.y = sA.y * w4.y + (saA * b4.y + vv.x * k4.y);
                sA.z = sA.z * w4.z + (saA * b4.z + vv.x * k4.z); sA.w = sA.w * w4.w + (saA * b4.w + vv.x * k4.w);
                sB.x = sB.x * w4.x + (saB * b4.x + vv.y * k4.x); sB.y = sB.y * w4.y + (saB * b4.y + vv.y * k4.y);
                sB.z = sB.z * w4.z + (saB * b4.z + vv.y * k4.z); sB.w = sB.w * w4.w + (saB * b4.w + vv.y * k4.w);
                if (!PASS_A) {
                    const float yA = sum16((sA.x * r4.x + sA.y * r4.y) + (sA.z * r4.z + sA.w * r4.w));
                    const float yB = sum16((sB.x * r4.x + sB.y * r4.y) + (sB.z * r4.z + sB.w * r4.w));
                    ykA = (ks == (tt & 15)) ? yA : ykA; ykB = (ks == (tt & 15)) ? yB : ykB;
                    if ((tt & 15) == 15) *(unsigned*)(MIX + ((size_t)ch * RS_T + (tt - 15) + ks) * 1024 + 768 + h * 64 + 32 * rgx + row) = pk2(ykA, ykB);
                }
            }
            asm volatile("s_waitcnt lgkmcnt(0)" ::: "memory");
#undef RS_LD
        }
        __syncthreads();
    }
    if (PASS_A && w < 4) {
        float* dst = LX + ((size_t)(g * 4 + h) * 128 + 32 * rgx + row) * 64 + 4 * ks;
        *(f32x4*)dst = sA; *(f32x4*)(dst + 64) = sB;
    }
}

__device__ __forceinline__ void rwkv_post(const Params& P, int layer, int tid) {
    const int wave = tid >> 6, lane = tid & 63;
    const h16* RK = (const h16*)(P.ws + OFF_RK);
    bf16_t* MIX = (bf16_t*)(P.ws + OFF_HN);
    const float* lnw = P.in[I_LNW] + layer * 256; const float* lnb = P.in[I_LNB] + layer * 256; const float* rk = P.in[I_RK] + layer * 256;
    float lw[4], lb[4], rkk[4];
#pragma unroll
    for (int hh = 0; hh < 4; ++hh) { lw[hh] = lnw[hh * 64 + lane]; lb[hh] = lnb[hh * 64 + lane]; rkk[hh] = rk[hh * 64 + lane]; }
    for (int t = blockIdx.x * 8 + wave; t < S_; t += gridDim.x * 8) {
        float y[4], r[4], k[4], v[4], g[4];
#pragma unroll
        for (int hh = 0; hh < 4; ++hh) {
            const int col = hh * 64 + lane; const size_t o = (size_t)t * 256 + col;
            y[hh] = bf2f(MIX[(size_t)t * 1024 + 768 + col]);
            r[hh] = (float)RK[0 * RKSZ + o]; k[hh] = (float)RK[1 * RKSZ + o]; v[hh] = (float)RK[2 * RKSZ + o]; g[hh] = (float)RK[6 * RKSZ + o];
        }
        float m[4], q[4];
#pragma unroll
        for (int hh = 0; hh < 4; ++hh) { m[hh] = y[hh]; q[hh] = r[hh] * k[hh] * rkk[hh]; }
#pragma unroll
        for (int o = 1; o < 64; o <<= 1) {
#pragma unroll
            for (int hh = 0; hh < 4; ++hh) { m[hh] += __shfl_xor(m[hh], o); q[hh] += __shfl_xor(q[hh], o); }
        }
        float dl[4], var[4];
#pragma unroll
        for (int hh = 0; hh < 4; ++hh) { dl[hh] = y[hh] - m[hh] * (1.f / 64.f); var[hh] = dl[hh] * dl[hh]; }
#pragma unroll
        for (int o = 1; o < 64; o <<= 1) {
#pragma unroll
            for (int hh = 0; hh < 4; ++hh) var[hh] += __shfl_xor(var[hh], o);
        }
#pragma unroll
        for (int hh = 0; hh < 4; ++hh) {
            const float yn = dl[hh] * rsqrtf(var[hh] * (1.f / 64.f) + 64e-5f) * lw[hh] + lb[hh];
            MIX[(size_t)t * 1024 + 768 + hh * 64 + lane] = f2bf((yn + q[hh] * v[hh]) * g[hh]);
        }
    }
}

__device__ __forceinline__ void conv_glu(const Params& P, int layer, int hf, int tid) {
    const bf16_t* U = (const bf16_t*)(P.ws + OFF_U);
    bf16_t* ACT = (bf16_t*)(P.ws + OFF_ACT);
    bf16_t* HALO = (bf16_t*)(P.ws + OFF_HALO);
    const float* cw = P.in[I_CW] + (size_t)layer * 3 * 5632; const float* cb = P.in[I_CB] + (size_t)layer * 5632;
    const int gt = blockIdx.x * NTHREADS + tid, nth = gridDim.x * NTHREADS;
    for (int it = gt; it < 352 * 256; it += nth) {
        const int cgp = it % 352, run = it / 352, c = cgp * 8, lt0 = run * 32;
        float wg[3][8], wv[3][8], bg[8], bv[8];
#pragma unroll
        for (int q = 0; q < 8; ++q) {
            bg[q] = cb[c + q]; bv[q] = cb[2816 + c + q];
#pragma unroll
            for (int jx = 0; jx < 3; ++jx) { wg[jx][q] = cw[jx * 5632 + c + q]; wv[jx][q] = cw[jx * 5632 + 2816 + c + q]; }
        }
        u32x4 g2, g1, v2, v1;
        if (lt0 == 0) {
            if (hf == 0) { g2 = (u32x4){0, 0, 0, 0}; g1 = g2; v2 = g2; v1 = g2; }
            else { g2 = *(const u32x4*)(HALO + c); v2 = *(const u32x4*)(HALO + 2816 + c); g1 = *(const u32x4*)(HALO + 5632 + c); v1 = *(const u32x4*)(HALO + 5632 + 2816 + c); }
        } else {
            g2 = *(const u32x4*)(U + (size_t)(lt0 - 2) * 5632 + c); v2 = *(const u32x4*)(U + (size_t)(lt0 - 2) * 5632 + 2816 + c);
            g1 = *(const u32x4*)(U + (size_t)(lt0 - 1) * 5632 + c); v1 = *(const u32x4*)(U + (size_t)(lt0 - 1) * 5632 + 2816 + c);
        }
        for (int i0 = 0; i0 < 32; i0 += 4) {
            u32x4 gl[4], vl[4];
#pragma unroll
            for (int u = 0; u < 4; ++u) { gl[u] = *(const u32x4*)(U + (size_t)(lt0 + i0 + u) * 5632 + c); vl[u] = *(const u32x4*)(U + (size_t)(lt0 + i0 + u) * 5632 + 2816 + c); }
#pragma unroll
            for (int u = 0; u < 4; ++u) {
                const u32x4 g0 = gl[u], v0 = vl[u];
                float res[8];
#pragma unroll
                for (int q = 0; q < 4; ++q) {
                    const unsigned a2 = g2[q], a1 = g1[q], a0 = g0[q], b2 = v2[q], b1 = v1[q], b0 = v0[q];
                    const float glo = bg[2 * q] + wg[0][2 * q] * bflo(a2) + wg[1][2 * q] * bflo(a1) + wg[2][2 * q] * bflo(a0);
                    const float ghi = bg[2 * q + 1] + wg[0][2 * q + 1] * bfhi(a2) + wg[1][2 * q + 1] * bfhi(a1) + wg[2][2 * q + 1] * bfhi(a0);
                    const float vlo = bv[2 * q] + wv[0][2 * q] * bflo(b2) + wv[1][2 * q] * bflo(b1) + wv[2][2 * q] * bflo(b0);
                    const float vhi = bv[2 * q + 1] + wv[0][2 * q + 1] * bfhi(b2) + wv[1][2 * q + 1] * bfhi(b1) + wv[2][2 * q + 1] * bfhi(b0);
                    res[2 * q] = glo * sigm(glo) * vlo; res[2 * q + 1] = ghi * sigm(ghi) * vhi;
                }
                u32x4 o; o.x = pk2(res[0], res[1]); o.y = pk2(res[2], res[3]); o.z = pk2(res[4], res[5]); o.w = pk2(res[6], res[7]);
                *(u32x4*)(ACT + (size_t)(hf * 8192 + lt0 + i0 + u) * 2816 + c) = o;
                g2 = g1; g1 = g0; v2 = v1; v1 = v0;
            }
        }
    }
    if (hf == 0) {
        for (int it = gt; it < 2 * 704; it += nth) { const int r = it / 704, cc = it % 704; *(u32x4*)(HALO + (size_t)r * 5632 + cc * 8) = *(const u32x4*)(U + (size_t)(8190 + r) * 5632 + cc * 8); }
    }
}

__device__ __forceinline__ void run_phase(const Params& P, int ph, unsigned char* smem, int part) {
    const int tid = launder((int)threadIdx.x), wave = tid >> 6, lane = tid & 63;
    const int gw = blockIdx.x * 8 + wave, ngw = gridDim.x * 8;
    bf16_t* WT = (bf16_t*)(P.ws + OFF_WT);
    bf16_t* HN = (bf16_t*)(P.ws + OFF_HN);
    if (PH(16) && ph == 32) {
        const float* g = P.in[I_NFIN];
        for (int row = gw; row < S_; row += ngw) {
            f32x4* xr = (f32x4*)(P.out + (size_t)row * D_) + lane;
            f32x4 v[4]; float s = 0.f;
#pragma unroll
            for (int j = 0; j < 4; ++j) { v[j] = xr[64 * j]; s += (v[j].x * v[j].x + v[j].y * v[j].y) + (v[j].z * v[j].z + v[j].w * v[j].w); }
            s = wave_sum(s);
            const float r = rsqrtf(s * (1.f / 1024.f) + 1e-6f);
#pragma unroll
            for (int j = 0; j < 4; ++j) { const f32x4 gg = ((const f32x4*)g)[lane + 64 * j]; f32x4 o; o.x = v[j].x * r * gg.x; o.y = v[j].y * r * gg.y; o.z = v[j].z * r * gg.z; o.w = v[j].w * r * gg.w; xr[64 * j] = o; }
        }
        return;
    }
    const int layer = ph >> 4, sub = ph & 15;
    if (PH(0) && sub == 0) { phase_prep(P, layer, smem, tid); return; }
    if (PH(1) && sub == 9) {
        EpiConv E; E.act = (bf16_t*)(P.ws + OFF_ACT); E.hl = (bf16_t*)(P.ws + OFF_U + 16 * MiB); E.hf = (bf16_t*)(P.ws + OFF_U + 24 * MiB);
        E.cw = P.in[I_CW] + (size_t)layer * 3 * 5632; E.cb = P.in[I_CB] + (size_t)layer * 5632;
        run_gemm(smem, HN, WT + WT_UP, S_, 5632, 1024, E); return;
    }
    if (PH(1) && sub == 10) {
        conv_fixup(P, layer, tid);
        float* SSQ = (float*)(P.ws + OFF_SSQ);
        for (int it = blockIdx.x * NTHREADS + tid; it < S_; it += gridDim.x * NTHREADS) SSQ[it] = 0.f;
        return;
    }
    if (PH(1) && sub == 1) {
        EpiRoute E; const bf16_t* A; const bf16_t* Bt; int M, N;
        if (sub == 1) { A = HN; Bt = WT + WT_IN; M = S_; N = 3840; E.d0 = (bf16_t*)(P.ws + OFF_ZH); E.ld0 = 2048; E.d1 = (bf16_t*)(P.ws + OFF_ZB); E.ld1 = 768; E.d2 = (bf16_t*)(P.ws + OFF_ZC); E.ld2 = 1024; E.c1 = 2048; E.c2 = 2816; }
        else { const int hf = (sub == 11); A = HN + (size_t)hf * 8192 * 1024; Bt = WT + WT_UP; M = 8192; N = 5632; E.d0 = (bf16_t*)(P.ws + OFF_U); E.ld0 = 5632; E.d1 = E.d0; E.ld1 = 5632; E.d2 = E.d0; E.ld2 = 5632; E.c1 = 1 << 30; E.c2 = 1 << 30; }
        run_gemm(smem, A, Bt, M, N, 1024, E); return;
    }
    if (PH(7) && sub == 13) {
        EpiF32<3> E; E.hin = P.out; E.out = P.out; E.hb = HN; E.ssq = (float*)(P.ws + OFF_SSQ);
        run_gemm(smem, (const bf16_t*)(P.ws + OFF_ACT), WT + WT_DOWN, S_, 1024, 2816, E);
        const float* p = P.in[I_P] + (size_t)layer * S_ * 256; bf16_t* PB = (bf16_t*)(P.ws + OFF_PB);
        for (int it = (gridDim.x == 256) ? (S_ * 256 / 8) : (int)(blockIdx.x * NTHREADS + tid); it < S_ * 256 / 8; it += gridDim.x * NTHREADS) {
            const f32x4 a = ((const f32x4*)p)[2 * it], b = ((const f32x4*)p)[2 * it + 1];
            u32x4 o; o.x = pk2(a.x, a.y); o.y = pk2(a.z, a.w); o.z = pk2(b.x, b.y); o.w = pk2(b.z, b.w);
            ((u32x4*)PB)[it] = o;
        }
        return;
    }
    if (PH(7) && sub == 7) {
        EpiF32<0> E; const bf16_t* A; const bf16_t* Bt; int K;
        if (sub == 7) { A = HN; Bt = WT + WT_OUT; K = 1024; E.hin = (layer == 0) ? P.in[I_X] : P.out; }
        else { A = (const bf16_t*)(P.ws + OFF_ACT); Bt = WT + WT_DOWN; K = 2816; E.hin = P.out; }
        E.out = P.out;
        run_gemm(smem, A, Bt, S_, 1024, K, E); return;
    }
    if (PH(15) && sub == 15) {
        float* PP = (float*)(P.ws + OFF_PP);
        { EpiF32<1> E; E.hin = nullptr; E.out = PP; E.hb = nullptr; E.ssq = nullptr; run_gemm(smem, (const bf16_t*)(P.ws + OFF_PB), WT + WT_PROJ, S_, 1024, 256, E); }
        __syncthreads();
        { EpiF32<4> E; E.hin = PP; E.out = P.out; E.hb = nullptr; E.ssq = (float*)(P.ws + OFF_SSQ); run_gemm(smem, HN, WT + WT_GATE, S_, 1024, 1024, E); }
        return;
    }
    if (PH(2) && sub == 2) { rwkv_prep(P, layer, smem, tid); __syncthreads(); attn_partial(P, smem, tid); return; }
    if (PH(3) && (sub == 3 || sub == 4)) {
        const bool full = (gridDim.x == 256);
        if (sub == 3) { hgrn_pass1(P, layer, smem, tid); if (!full) attn_combine(P, tid); }
        const bool ride = (sub == 4) && full;
        if (sub == 4 && !ride) hgrn_scan(P, tid);
        const int base = (sub == 4) ? RS_G * 8 : 0;
        for (int job = base + blockIdx.x; job < base + RS_G * 8; job += gridDim.x) rwkv_seg_job<true>(P, smem, tid, job >> 4, (job >> 2) & 3, job & 3, false, ride, (sub == 3) && full);
        return;
    }
    if (PH(5) && sub == 5) {
        if (part == 0 && blockIdx.x >= 8) { for (int item = blockIdx.x - 8; item < 1024; item += gridDim.x - 8) hgrn_pass3_item(P, layer, smem, tid, item); return; }
        const bool co = (part == 0);
        for (int job = blockIdx.x; job < (co ? 8 : RS_G * 8); job += gridDim.x)
            rwkv_seg_job<false>(P, smem, tid, co ? RS_G - 1 : (job >> 3), co ? (job >> 1) : ((job >> 1) & 3), job & 1, co, false, !co && gridDim.x == 256, layer);
        return;
    }
    if (PH(6) && sub == 6) { rwkv_post(P, layer, tid); return; }
    if (PH(8) && sub == 8) { rmsnorm_rows_bf16(P.out, P.in[I_NFFN] + layer * 1024, HN, gw, ngw, lane); return; }
    if (PH(14) && sub == 14) {
        rmsnorm_rows_bf16(P.out, P.in[I_NPLE] + layer * 1024, HN, gw, ngw, lane);
        const float* p = P.in[I_P] + (size_t)layer * S_ * 256; bf16_t* PB = (bf16_t*)(P.ws + OFF_PB);
        for (int it = blockIdx.x * NTHREADS + tid; it < S_ * 256 / 8; it += gridDim.x * NTHREADS) {
            const f32x4 a = ((const f32x4*)p)[2 * it], b = ((const f32x4*)p)[2 * it + 1];
            u32x4 o; o.x = pk2(a.x, a.y); o.y = pk2(a.z, a.w); o.z = pk2(b.x, b.y); o.w = pk2(b.z, b.w);
            ((u32x4*)PB)[it] = o;
        }
        return;
    }
}

#define XB_TMO      128
#define XB_XCNT(j)  (256  + 64 * (j))
#define XB_XSUB(j)  (1280 + 64 * (j))
#define XB_XGEN(j)  (2304 + 64 * (j))
#define XB_TOP      3328
#define XB_TOPGEN   3392
#define XCD_BAR_WORDS 3456
#define XB_SPIN_CAP (1u << 18)
#define XB_LAS __attribute__((address_space(3)))

__device__ __forceinline__ unsigned xb_ld(unsigned* p)              { return __hip_atomic_load(p, __ATOMIC_RELAXED, __HIP_MEMORY_SCOPE_AGENT); }
__device__ __forceinline__ unsigned xb_add(unsigned* p, unsigned v) { return __hip_atomic_fetch_add(p, v, __ATOMIC_RELAXED, __HIP_MEMORY_SCOPE_AGENT); }
__device__ __forceinline__ unsigned xb_xcc_id() { return (unsigned)__builtin_amdgcn_s_getreg((3 << 11) | 20) & 0xFu; }
#define XB_SPIN(cond, bar) do { unsigned _sp = 0; while (cond) { __builtin_amdgcn_s_sleep(1); \
    if ((++_sp & 255u) == 0u) { if (xb_ld(&(bar)[XB_TMO])) break; if (_sp > XB_SPIN_CAP) { atomicAdd(&(bar)[XB_TMO], 1u); break; } } } } while (0)
struct XcdBarrier {
    unsigned* bar; unsigned x;
    volatile XB_LAS unsigned* st;
};

__device__ __forceinline__ XcdBarrier xcd_barrier_post(unsigned* bar, volatile XB_LAS unsigned* st) {
    XcdBarrier b; b.bar = bar; b.x = xb_xcc_id(); b.st = st;
    if (threadIdx.x == 0) (void)xb_add(&bar[XB_XCNT(b.x)], 1u);
    return b;
}
__device__ __forceinline__ void xcd_barrier_complete(unsigned* bar, unsigned x, unsigned& nloc, unsigned& nx) {
    const unsigned G = gridDim.x * gridDim.y * gridDim.z;
    unsigned sum, cnt, mine, sp = 0u;
    for (;;) {
        sum = 0u; cnt = 0u; mine = 0u;
#pragma unroll
        for (unsigned j = 0; j < 16; ++j) { const unsigned c = xb_ld(&bar[XB_XCNT(j)]); sum += c; cnt += (c > 0u) ? 1u : 0u; mine = (j == x) ? c : mine; }
        if (sum == G) break;
        __builtin_amdgcn_s_sleep(1);
        if ((++sp & 255u) == 0u) { if (xb_ld(&bar[XB_TMO])) break; if (sp > XB_SPIN_CAP) { atomicAdd(&bar[XB_TMO], 1u); break; } }
    }
    nloc = mine > 0u ? mine : 1u; nx = cnt > 0u ? cnt : 1u;
}

__device__ __forceinline__ void xcd_barrier(const XcdBarrier& b) {
    asm volatile("s_waitcnt vmcnt(0)" ::: "memory");
    __syncthreads();
    if (threadIdx.x == 0) {
        unsigned* bar = b.bar;
        __builtin_amdgcn_s_waitcnt(0);
        unsigned nloc = b.st[0], nx = b.st[1];
        if (nloc == 0u) { xcd_barrier_complete(bar, b.x, nloc, nx); b.st[0] = nloc; b.st[1] = nx; }
        const unsigned old = xb_add(&bar[XB_XSUB(b.x)], 1u);
        const unsigned gen = old / nloc;
        if (old + 1u == (gen + 1u) * nloc) {
            __builtin_amdgcn_fence(__ATOMIC_RELEASE, "agent");
            asm volatile("s_waitcnt vmcnt(0)" ::: "memory");
            const unsigned og = xb_add(&bar[XB_TOP], 1u);
            const unsigned tg = og / nx;
            if (og + 1u == (tg + 1u) * nx) xb_add(&bar[XB_TOPGEN], 1u);
            else XB_SPIN(xb_ld(&bar[XB_TOPGEN]) == tg, bar);
            __builtin_amdgcn_fence(__ATOMIC_ACQUIRE, "agent");
            xb_add(&bar[XB_XGEN(b.x)], 1u);
            asm volatile("s_waitcnt vmcnt(0)" ::: "memory");
        } else {
            XB_SPIN(xb_ld(&bar[XB_XGEN(b.x)]) == gen, bar);
            __builtin_amdgcn_fence(__ATOMIC_ACQUIRE, "agent");
            asm volatile("s_waitcnt vmcnt(0)" ::: "memory");
        }
    }
    __syncthreads();
}

constexpr size_t OFF_BAR = 65536;

#ifndef ONE_LAUNCH
#define ONE_LAUNCH 1
#endif

__global__ __launch_bounds__(512, 2) void mega(Params P, int ph_lo, int ph_hi) {
    extern __shared__ __attribute__((aligned(16))) unsigned char smem[];
    cg::grid_group grid = cg::this_grid();
    if (ph_hi == 0x7fffffff) grid.sync();
    volatile XB_LAS unsigned* st = (volatile XB_LAS unsigned*)(smem + LDS_BYTES - 16);
    if (threadIdx.x == 0) { st[0] = 0u; st[1] = 0u; }
    __syncthreads();
    XcdBarrier xb = xcd_barrier_post((unsigned*)(P.ws + OFF_BAR), st);
#ifdef EXTRA_SYNCS
    for (int i = 0; i < EXTRA_SYNCS; ++i) xcd_barrier(xb);
#endif
    for (int ph = ph_lo; ph < ph_hi; ++ph) {
        if (ph < 32 && ((ph & 15) == 11 || (ph & 15) == 12 || (ph & 15) == 14)) continue;
        if (ph > ph_lo) xcd_barrier(xb);
        const int nparts = (ph < 32 && (ph & 15) == 5) ? 2 : 1;
        for (int part = 0; part < nparts; ++part) { if (part) xcd_barrier(xb); run_phase(P, ph, smem, part); }
#ifdef REP_MASK
        if (ph < 32 && ((REP_MASK >> (ph & 15)) & 1)) { xcd_barrier(xb); run_phase(P, ph, smem, 0); }
#endif
    }
}

extern "C" void kernel_launch(void* const* d_in, const int* in_sizes, int n_in, void* d_out, int out_size, void* d_ws, size_t ws_size, hipStream_t stream) {
    static int grid_blocks = 0;
    if (grid_blocks == 0) {
        int dev = 0, cus = 0, per_cu = 0;
        if (hipGetDevice(&dev) != hipSuccess || hipDeviceGetAttribute(&cus, hipDeviceAttributeMultiprocessorCount, dev) != hipSuccess) { fprintf(stderr, "kernel_launch: device query failed\n"); grid_blocks = -1; return; }
        if (hipFuncSetAttribute((const void*)mega, hipFuncAttributeMaxDynamicSharedMemorySize, LDS_BYTES) != hipSuccess) { fprintf(stderr, "kernel_launch: hipFuncSetAttribute failed\n"); grid_blocks = -1; return; }
        if (hipOccupancyMaxActiveBlocksPerMultiprocessor(&per_cu, (const void*)mega, NTHREADS, LDS_BYTES) != hipSuccess || per_cu < 1) { fprintf(stderr, "kernel_launch: occupancy query gave %d\n", per_cu); per_cu = 1; }
        (void)hipGetLastError();
        grid_blocks = cus * per_cu;
        if (n_in != 30 || ws_size < 256 * MiB) fprintf(stderr, "kernel_launch: unexpected n_in %d / ws_size %zu\n", n_in, ws_size);
    }
    if (grid_blocks < 0) return;
    Params P{};
    for (int i = 0; i < 30; ++i) P.in[i] = (const float*)d_in[i];
    P.out = (float*)d_out; P.ws = (unsigned char*)d_ws;
#if ONE_LAUNCH
    if (hipMemsetAsync((char*)d_ws + OFF_BAR, 0, XCD_BAR_WORDS * sizeof(unsigned), stream) != hipSuccess) { fprintf(stderr, "kernel_launch: memset of the barrier words failed\n"); return; }
    int lo = 0, hi = NPH;
    void* args[] = {&P, &lo, &hi};
    hipError_t e = hipLaunchCooperativeKernel((const void*)mega, dim3(grid_blocks), dim3(NTHREADS), args, LDS_BYTES, stream);
    if (e != hipSuccess) fprintf(stderr, "cooperative launch failed: %s (grid %d)\n", hipGetErrorString(e), grid_blocks);
#else
    for (int ph = 0; ph < NPH; ++ph) hipLaunchKernelGGL(mega, dim3(grid_blocks), dim3(NTHREADS), LDS_BYTES, stream, P, ph, ph + 1);
#endif
}
```
